# Optimizing an MI355X kernel written in HIP

```python
import math
import jax, jax.numpy as jnp
from jax import lax
import numpy as np

D_MODEL = 1024
BATCH = 1
SEQ = 16384
DEPTH = 4

GRID_W = 64
CTX_LEN = 256
EPS = 1e-6
N_MOD = 6
D_MIX = D_MODEL
D_GROUP = D_MIX // 4
HY_WIDTH = D_GROUP
HY_ORDER = 2
HY_SHORT = 3
HY_FREQS = 16
HY_EMB = 1 + 2 * HY_FREQS
HY_FFN = 64
HY_SIN_FREQ = 1.0
HY_DECAY_MIN = 3.07
HY_DECAY_MAX = 15.35
S5_WIDTH = D_GROUP
S5_H = 16
S5_G = S5_WIDTH // S5_H
S5_P = 64
S5_DT_MIN = 0.001
S5_DT_MAX = 0.1
POOL_WIDTH = D_GROUP
POOL_WINDOWS = (2, 4, 8, 16)
POOL_GC = POOL_WIDTH // len(POOL_WINDOWS)
ATT_HEAD_DIM = 64
ATT_Q_HEADS = D_GROUP // ATT_HEAD_DIM
ATT_KV_HEADS = 2
ATT_Q_PER_KV = ATT_Q_HEADS // ATT_KV_HEADS
ATT_SCALE = 1.0 / math.sqrt(ATT_HEAD_DIM)
ROPE_AXIS_DIM = ATT_HEAD_DIM // 2
ROPE_THETA = 10000.0
Q_BLOCK = 128
D_FF = 4 * D_MODEL
IN_COLS = 3 * HY_WIDTH + S5_WIDTH + POOL_WIDTH + ATT_Q_HEADS * ATT_HEAD_DIM + 2 * ATT_KV_HEADS * ATT_HEAD_DIM
SPLIT_IDX = (3 * HY_WIDTH,
             3 * HY_WIDTH + S5_WIDTH,
             3 * HY_WIDTH + S5_WIDTH + POOL_WIDTH,
             3 * HY_WIDTH + S5_WIDTH + POOL_WIDTH + ATT_Q_HEADS * ATT_HEAD_DIM,
             3 * HY_WIDTH + S5_WIDTH + POOL_WIDTH + (ATT_Q_HEADS + ATT_KV_HEADS) * ATT_HEAD_DIM)

kernel_name = "hybrid_parallel_heads_diffusion_block"


def rmsnorm(x, g):
    xf = x.astype(jnp.float32)
    y = xf * lax.rsqrt(jnp.mean(xf * xf, axis=-1, keepdims=True) + EPS)
    return (y * g.astype(jnp.float32)).astype(x.dtype)


def modulate(h, shift, scale):
    return h * (1 + scale) + shift


def short_conv(u, w, b):
    L = u.shape[1]
    pad = HY_SHORT // 2
    up = jnp.pad(u, ((0, 0), (pad, pad), (0, 0)))
    y = b
    for k in range(HY_SHORT):
        y = y + w[k] * up[:, k:k + L]
    return y


def hyena_kernel_spectra(L, w1, b1, w2, b2, w3, decay):
    f32 = jnp.float32
    t = jnp.arange(L, dtype=f32) / L
    freqs = jnp.arange(1, HY_FREQS + 1, dtype=f32)
    ang = 2.0 * math.pi * t[:, None] * freqs[None, :]
    feats = jnp.concatenate([t[:, None], jnp.cos(ang), jnp.sin(ang)], axis=-1)
    h = jnp.sin(HY_SIN_FREQ * (feats @ w1.astype(f32) + b1.astype(f32)))
    h = jnp.sin(HY_SIN_FREQ * (h @ w2.astype(f32) + b2.astype(f32)))
    h = (h @ w3.astype(f32)).reshape(L, HY_ORDER, 2, HY_WIDTH)
    h = h * jnp.exp(-t[:, None, None, None] * jnp.abs(decay.astype(f32))[None])
    h_fwd, h_bwd = h[:, :, 0], h[:, :, 1]
    kern = jnp.concatenate([h_fwd, jnp.zeros((1, HY_ORDER, HY_WIDTH), f32), h_bwd[:L - 1][::-1]], axis=0)
    return jnp.fft.rfft(kern, axis=0)


def fft_long_conv(z, kern_f):
    L = z.shape[1]
    Z = jnp.fft.rfft(z.astype(jnp.float32), n=2 * L, axis=1)
    return jnp.fft.irfft(Z * kern_f[None], n=2 * L, axis=1)[:, :L]


def hyena_mix(u3, conv_w, conv_b, w1, b1, w2, b2, w3, decay, fbias):
    L = u3.shape[1]
    kern_f = hyena_kernel_spectra(L, w1, b1, w2, b2, w3, decay)
    v, x1, x2 = jnp.split(short_conv(u3, conv_w, conv_b), 3, axis=-1)
    z = v.astype(jnp.float32)
    for o, gate in enumerate((x1, x2)):
        z = gate.astype(jnp.float32) * (fft_long_conv(z, kern_f[:, o]) + fbias[o].astype(jnp.float32) * z)
    return z.astype(u3.dtype)


def s5_zoh(a_re, a_im, log_dt, b_re, b_im):
    f32 = jnp.float32
    a_re, a_im = a_re.astype(f32), a_im.astype(f32)
    dt = jnp.exp(log_dt.astype(f32))[:, None]
    mag = jnp.exp(a_re * dt)
    lam_re, lam_im = mag * jnp.cos(a_im * dt), mag * jnp.sin(a_im * dt)
    den = a_re * a_re + a_im * a_im
    nr, ni = lam_re - 1.0, lam_im
    cr = (nr * a_re + ni * a_im) / den
    ci = (ni * a_re - nr * a_im) / den
    b_re, b_im = b_re.astype(f32), b_im.astype(f32)
    bb_re = cr[..., None] * b_re - ci[..., None] * b_im
    bb_im = cr[..., None] * b_im + ci[..., None] * b_re
    return lam_re, lam_im, bb_re, bb_im


def _complex_affine_combine(e1, e2):
    a1r, a1i, b1r, b1i = e1
    a2r, a2i, b2r, b2i = e2
    return (a2r * a1r - a2i * a1i,
            a2r * a1i + a2i * a1r,
            a2r * b1r - a2i * b1i + b2r,
            a2r * b1i + a2i * b1r + b2i)


def diag_scan(lam_re, lam_im, bu_re, bu_im, h0_re, h0_im, reverse):
    if h0_re is not None:
        edge = -1 if reverse else 0
        bu_re = bu_re.at[:, edge].add(lam_re * h0_re - lam_im * h0_im)
        bu_im = bu_im.at[:, edge].add(lam_re * h0_im + lam_im * h0_re)
    a_re = jnp.broadcast_to(lam_re, bu_re.shape)
    a_im = jnp.broadcast_to(lam_im, bu_im.shape)
    _, _, h_re, h_im = lax.associative_scan(_complex_affine_combine, (a_re, a_im, bu_re, bu_im), reverse=reverse, axis=1)
    return h_re, h_im


def s5_readout(h_re, h_im, c_re, c_im):
    B, L = h_re.shape[:2]
    y = jnp.einsum('blgp,ghp->blgh', h_re, c_re.astype(jnp.float32)) - jnp.einsum('blgp,ghp->blgh', h_im, c_im.astype(jnp.float32))
    return y.reshape(B, L, S5_WIDTH)


def s5_glu(y, w, b):
    g = jax.nn.gelu(y)
    return g * jax.nn.sigmoid(g @ w.astype(jnp.float32) + b.astype(jnp.float32))


def s5_mix(u_l, u_c, a_re, a_im, log_dt, b_re, b_im, c_re, c_im, d, glu_w, glu_b, need_ctx_out):
    B, L, _ = u_l.shape
    Lc = u_c.shape[1]
    ul = u_l.astype(jnp.float32)
    uc = u_c.astype(jnp.float32)
    ulg = ul.reshape(B, L, S5_G, S5_H)
    ucg = uc.reshape(B, Lc, S5_G, S5_H)
    dd = d.astype(jnp.float32)
    y_l = dd * ul
    y_c = dd * uc
    for direction in range(2):
        rev = direction == 1
        lam_re, lam_im, bb_re, bb_im = s5_zoh(a_re[direction], a_im[direction], log_dt[direction], b_re[direction], b_im[direction])
        hc_re, hc_im = diag_scan(lam_re, lam_im,
                                 jnp.einsum('blgh,gph->blgp', ucg, bb_re), jnp.einsum('blgh,gph->blgp', ucg, bb_im),
                                 None, None, rev)
        edge = 0 if rev else -1
        hl_re, hl_im = diag_scan(lam_re, lam_im,
                                 jnp.einsum('blgh,gph->blgp', ulg, bb_re), jnp.einsum('blgh,gph->blgp', ulg, bb_im),
                                 hc_re[:, edge], hc_im[:, edge], rev)
        y_l = y_l + s5_readout(hl_re, hl_im, c_re[direction], c_im[direction])
        if need_ctx_out:
            y_c = y_c + s5_readout(hc_re, hc_im, c_re[direction], c_im[direction])
    out_l = s5_glu(y_l, glu_w, glu_b).astype(u_l.dtype)
    out_c = s5_glu(y_c, glu_w, glu_b).astype(u_c.dtype) if need_ctx_out else None
    return out_l, out_c


def pool_mix(u, w, scale):
    B, L, W = u.shape
    uf = u.astype(jnp.float32)
    cs = jnp.concatenate([jnp.zeros((B, 1, W), jnp.float32), jnp.cumsum(uf, axis=1)], axis=1)
    t = jnp.arange(L)
    outs = []
    for g, win in enumerate(POOL_WINDOWS):
        csg = cs[..., g * POOL_GC:(g + 1) * POOL_GC]
        lo = jnp.clip(t - win // 2, 0, L)
        hi = jnp.clip(t + win // 2, 0, L)
        mean = (jnp.take(csg, hi, axis=1) - jnp.take(csg, lo, axis=1)) / (hi - lo).astype(jnp.float32)[None, :, None]
        outs.append(mean - uf[..., g * POOL_GC:(g + 1) * POOL_GC])
    pooled = jnp.stack(outs, axis=2)
    mixed = jnp.einsum('blgc,gcd->blgd', pooled, w.astype(jnp.float32)).reshape(B, L, W)
    return (mixed * scale.astype(jnp.float32)).astype(u.dtype)


def axial_rope_tables(rows, cols):
    inv = ROPE_THETA ** (-jnp.arange(0, ROPE_AXIS_DIM, 2, dtype=jnp.float32) / ROPE_AXIS_DIM)
    ang = jnp.concatenate([rows.astype(jnp.float32)[:, None] * inv[None, :],
                           cols.astype(jnp.float32)[:, None] * inv[None, :]], axis=-1)
    return jnp.cos(ang), jnp.sin(ang)


def apply_rope(x, cos, sin):
    xp = x.astype(jnp.float32).reshape(*x.shape[:-1], ATT_HEAD_DIM // 2, 2)
    x0, x1 = xp[..., 0], xp[..., 1]
    c = cos[None, :, None, :]
    s = sin[None, :, None, :]
    return jnp.stack([x0 * c - x1 * s, x0 * s + x1 * c], axis=-1).reshape(x.shape).astype(x.dtype)


def gqa_softmax(q, k, v):
    s = jnp.einsum('bqkgd,bskd->bkgqs', q, k).astype(jnp.float32) * ATT_SCALE
    p = jax.nn.softmax(s, axis=-1).astype(v.dtype)
    return jnp.einsum('bkgqs,bskd->bqkgd', p, v)


def attention_mix(q_l, k_l, v_l, q_c, k_c, v_c, q_gain, k_gain, rope_cos, rope_sin, need_ctx_out):
    B, L, _ = q_l.shape
    Lc = k_c.shape[1]
    heads = lambda t, h: t.reshape(t.shape[0], t.shape[1], h, ATT_HEAD_DIM)
    ql = apply_rope(rmsnorm(heads(q_l, ATT_Q_HEADS), q_gain), rope_cos, rope_sin)
    kl = apply_rope(rmsnorm(heads(k_l, ATT_KV_HEADS), k_gain), rope_cos, rope_sin)
    kc = rmsnorm(heads(k_c, ATT_KV_HEADS), k_gain)
    vl, vc = heads(v_l, ATT_KV_HEADS), heads(v_c, ATT_KV_HEADS)
    k_all = jnp.concatenate([kl, kc], axis=1)
    v_all = jnp.concatenate([vl, vc], axis=1)
    qb = ql.reshape(B, L // Q_BLOCK, Q_BLOCK, ATT_KV_HEADS, ATT_Q_PER_KV, ATT_HEAD_DIM).transpose(1, 0, 2, 3, 4, 5)
    ob = lax.map(lambda q: gqa_softmax(q, k_all, v_all), qb)
    y_l = ob.transpose(1, 0, 2, 3, 4, 5).reshape(B, L, ATT_Q_HEADS * ATT_HEAD_DIM)
    y_c = None
    if need_ctx_out:
        qc = rmsnorm(heads(q_c, ATT_Q_HEADS), q_gain).reshape(B, Lc, ATT_KV_HEADS, ATT_Q_PER_KV, ATT_HEAD_DIM)
        y_c = gqa_softmax(qc, kc, vc).reshape(B, Lc, ATT_Q_HEADS * ATT_HEAD_DIM)
    return y_l, y_c


def sq_relu_mlp(h, w1, w2):
    return jnp.square(jax.nn.relu(h @ w1)) @ w2


def token_mix_one_stream(a, s5_y, p, att_y, lp):
    y_hy = hyena_mix(a, lp["hy_conv_w"], lp["hy_conv_b"], lp["hy_ffn_w1"], lp["hy_ffn_b1"],
                     lp["hy_ffn_w2"], lp["hy_ffn_b2"], lp["hy_ffn_w3"], lp["hy_decay"], lp["hy_bias"])
    y_pool = pool_mix(p, lp["pool_w"], lp["pool_scale"])
    merged = jnp.concatenate([y_hy.astype(a.dtype), s5_y.astype(a.dtype), y_pool.astype(a.dtype), att_y.astype(a.dtype)], axis=-1)
    return merged @ lp["w_out"]


def layer(xl, xc, c, c_ctx, rope_cos, rope_sin, lp, need_ctx_out):
    mod_l = jnp.split((jax.nn.silu(c) @ lp["mod_w"] + lp["mod_b"])[:, None, :], N_MOD, axis=-1)
    mod_c = jnp.split(jax.nn.silu(c_ctx) @ lp["mod_w"] + lp["mod_b"], N_MOD, axis=-1)
    hl = modulate(rmsnorm(xl, lp["norm_pre_mix"]), mod_l[0], mod_l[1])
    hc = modulate(rmsnorm(xc, lp["norm_pre_mix"]), mod_c[0], mod_c[1])
    a_l, s_l, p_l, q_l, k_l, v_l = jnp.split(hl @ lp["w_in"], SPLIT_IDX, axis=-1)
    a_c, s_c, p_c, q_c, k_c, v_c = jnp.split(hc @ lp["w_in"], SPLIT_IDX, axis=-1)
    y_s5_l, y_s5_c = s5_mix(s_l, s_c, lp["s5_a_re"], lp["s5_a_im"], lp["s5_log_dt"], lp["s5_b_re"], lp["s5_b_im"],
                            lp["s5_c_re"], lp["s5_c_im"], lp["s5_d"], lp["s5_glu_w"], lp["s5_glu_b"], need_ctx_out)
    y_att_l, y_att_c = attention_mix(q_l, k_l, v_l, q_c, k_c, v_c, lp["att_q_norm"], lp["att_k_norm"],
                                     rope_cos, rope_sin, need_ctx_out)
    ol = token_mix_one_stream(a_l, y_s5_l, p_l, y_att_l, lp)
    xl = xl + mod_l[2] * rmsnorm(ol, lp["norm_post_mix"])
    fl = sq_relu_mlp(modulate(rmsnorm(xl, lp["norm_pre_mlp"]), mod_l[3], mod_l[4]), lp["mlp_w1"], lp["mlp_w2"])
    xl = xl + mod_l[5] * rmsnorm(fl, lp["norm_post_mlp"])
    if not need_ctx_out:
        return xl, xc
    oc = token_mix_one_stream(a_c, y_s5_c, p_c, y_att_c, lp)
    xc = xc + mod_c[2] * rmsnorm(oc, lp["norm_post_mix"])
    fc = sq_relu_mlp(modulate(rmsnorm(xc, lp["norm_pre_mlp"]), mod_c[3], mod_c[4]), lp["mlp_w1"], lp["mlp_w2"])
    xc = xc + mod_c[5] * rmsnorm(fc, lp["norm_post_mlp"])
    return xl, xc


def setup_inputs(seed: int = 0) -> dict:
    key = jax.random.key(seed)
    ks = iter(jax.random.split(key, 64))
    f32 = jnp.float32

    def nrm(shape, scale):
        return scale * jax.random.normal(next(ks), shape, f32)

    def gain(shape):
        return 1.0 + nrm(shape, 0.05)

    x = nrm((BATCH, SEQ, D_MODEL), 1.0)
    c = nrm((BATCH, D_MODEL), 1.0)
    ctx = nrm((BATCH, CTX_LEN, D_MODEL), 1.0)
    c_ctx = nrm((D_MODEL,), 1.0)
    mod_w = nrm((DEPTH, D_MODEL, N_MOD * D_MODEL), 0.5 * D_MODEL ** -0.5)
    mod_b = nrm((DEPTH, N_MOD * D_MODEL), 0.02)
    norm_pre_mix = gain((DEPTH, D_MODEL))
    norm_post_mix = gain((DEPTH, D_MODEL))
    norm_pre_mlp = gain((DEPTH, D_MODEL))
    norm_post_mlp = gain((DEPTH, D_MODEL))
    w_in = nrm((DEPTH, D_MODEL, IN_COLS), D_MODEL ** -0.5)
    w_out = nrm((DEPTH, D_MIX, D_MODEL), D_MIX ** -0.5)
    hy_conv_w = nrm((DEPTH, HY_SHORT, 3 * HY_WIDTH), HY_SHORT ** -0.5)
    hy_conv_b = nrm((DEPTH, 3 * HY_WIDTH), 0.02)
    hy_ffn_w1 = nrm((DEPTH, HY_EMB, HY_FFN), HY_EMB ** -0.5)
    hy_ffn_b1 = nrm((DEPTH, HY_FFN), 0.1)
    hy_ffn_w2 = nrm((DEPTH, HY_FFN, HY_FFN), HY_FFN ** -0.5)
    hy_ffn_b2 = nrm((DEPTH, HY_FFN), 0.1)
    hy_ffn_w3 = nrm((DEPTH, HY_FFN, HY_ORDER * 2 * HY_WIDTH), 0.05 * HY_FFN ** -0.5)
    hy_decay = jnp.linspace(HY_DECAY_MIN, HY_DECAY_MAX, HY_WIDTH, dtype=f32)[None, None, None, :] + nrm((DEPTH, HY_ORDER, 2, HY_WIDTH), 0.1)
    hy_bias = nrm((DEPTH, HY_ORDER, HY_WIDTH), 0.1)
    s5_a_re = -0.5 + nrm((DEPTH, 2, S5_G, S5_P), 0.01)
    s5_a_im = math.pi * jnp.arange(S5_P, dtype=f32)[None, None, None, :] + nrm((DEPTH, 2, S5_G, S5_P), 0.01)
    s5_log_dt = math.log(S5_DT_MIN) + jax.random.uniform(next(ks), (DEPTH, 2, S5_G), f32) * (math.log(S5_DT_MAX) - math.log(S5_DT_MIN))
    s5_b_re = nrm((DEPTH, 2, S5_G, S5_P, S5_H), (2 * S5_H) ** -0.5)
    s5_b_im = nrm((DEPTH, 2, S5_G, S5_P, S5_H), (2 * S5_H) ** -0.5)
    s5_c_re = nrm((DEPTH, 2, S5_G, S5_H, S5_P), (2 * S5_P) ** -0.5)
    s5_c_im = nrm((DEPTH, 2, S5_G, S5_H, S5_P), (2 * S5_P) ** -0.5)
    s5_d = nrm((DEPTH, S5_WIDTH), 0.5)
    s5_glu_w = nrm((DEPTH, S5_WIDTH, S5_WIDTH), S5_WIDTH ** -0.5)
    s5_glu_b = nrm((DEPTH, S5_WIDTH), 0.02)
    pool_w = nrm((DEPTH, len(POOL_WINDOWS), POOL_GC, POOL_GC), POOL_GC ** -0.5)
    pool_scale = 1.0 + nrm((DEPTH, POOL_WIDTH), 0.1)
    att_q_norm = gain((DEPTH, ATT_HEAD_DIM))
    att_k_norm = gain((DEPTH, ATT_HEAD_DIM))
    mlp_w1 = nrm((DEPTH, D_MODEL, D_FF), D_MODEL ** -0.5)
    mlp_w2 = nrm((DEPTH, D_FF, D_MODEL), D_FF ** -0.5)
    return {"x": x, "c": c, "ctx": ctx, "c_ctx": c_ctx, "mod_w": mod_w, "mod_b": mod_b,
            "norm_pre_mix": norm_pre_mix, "norm_post_mix": norm_post_mix,
            "norm_pre_mlp": norm_pre_mlp, "norm_post_mlp": norm_post_mlp,
            "w_in": w_in, "w_out": w_out, "hy_conv_w": hy_conv_w, "hy_conv_b": hy_conv_b,
            "hy_ffn_w1": hy_ffn_w1, "hy_ffn_b1": hy_ffn_b1, "hy_ffn_w2": hy_ffn_w2, "hy_ffn_b2": hy_ffn_b2,
            "hy_ffn_w3": hy_ffn_w3, "hy_decay": hy_decay, "hy_bias": hy_bias,
            "s5_a_re": s5_a_re, "s5_a_im": s5_a_im, "s5_log_dt": s5_log_dt,
            "s5_b_re": s5_b_re, "s5_b_im": s5_b_im, "s5_c_re": s5_c_re, "s5_c_im": s5_c_im,
            "s5_d": s5_d, "s5_glu_w": s5_glu_w, "s5_glu_b": s5_glu_b,
            "pool_w": pool_w, "pool_scale": pool_scale, "att_q_norm": att_q_norm, "att_k_norm": att_k_norm,
            "mlp_w1": mlp_w1, "mlp_w2": mlp_w2}


def reference(x, c, ctx, c_ctx, mod_w, mod_b, norm_pre_mix, norm_post_mix, norm_pre_mlp, norm_post_mlp,
              w_in, w_out, hy_conv_w, hy_conv_b, hy_ffn_w1, hy_ffn_b1, hy_ffn_w2, hy_ffn_b2, hy_ffn_w3,
              hy_decay, hy_bias, s5_a_re, s5_a_im, s5_log_dt, s5_b_re, s5_b_im, s5_c_re, s5_c_im, s5_d,
              s5_glu_w, s5_glu_b, pool_w, pool_scale, att_q_norm, att_k_norm, mlp_w1, mlp_w2):
    L = x.shape[1]
    ROWS = L // GRID_W
    rows = jnp.repeat(jnp.arange(ROWS, dtype=jnp.int32), GRID_W)
    cols = jnp.tile(jnp.arange(GRID_W, dtype=jnp.int32), ROWS)
    rope_cos, rope_sin = axial_rope_tables(rows, cols)
    xl, xc = x, ctx
    for i in range(DEPTH):
        lp = {"mod_w": mod_w[i], "mod_b": mod_b[i],
              "norm_pre_mix": norm_pre_mix[i], "norm_post_mix": norm_post_mix[i],
              "norm_pre_mlp": norm_pre_mlp[i], "norm_post_mlp": norm_post_mlp[i],
              "w_in": w_in[i], "w_out": w_out[i], "hy_conv_w": hy_conv_w[i], "hy_conv_b": hy_conv_b[i],
              "hy_ffn_w1": hy_ffn_w1[i], "hy_ffn_b1": hy_ffn_b1[i], "hy_ffn_w2": hy_ffn_w2[i],
              "hy_ffn_b2": hy_ffn_b2[i], "hy_ffn_w3": hy_ffn_w3[i], "hy_decay": hy_decay[i], "hy_bias": hy_bias[i],
              "s5_a_re": s5_a_re[i], "s5_a_im": s5_a_im[i], "s5_log_dt": s5_log_dt[i],
              "s5_b_re": s5_b_re[i], "s5_b_im": s5_b_im[i], "s5_c_re": s5_c_re[i], "s5_c_im": s5_c_im[i],
              "s5_d": s5_d[i], "s5_glu_w": s5_glu_w[i], "s5_glu_b": s5_glu_b[i],
              "pool_w": pool_w[i], "pool_scale": pool_scale[i],
              "att_q_norm": att_q_norm[i], "att_k_norm": att_k_norm[i],
              "mlp_w1": mlp_w1[i], "mlp_w2": mlp_w2[i]}
        xl, xc = layer(xl, xc, c, c_ctx, rope_cos, rope_sin, lp, i < DEPTH - 1)
    return xl
```

```cpp
#include <hip/hip_runtime.h>
#include <hip/hip_cooperative_groups.h>
#include <cstdio>
#include <cstdint>
namespace cg = cooperative_groups;

__device__ __forceinline__ int lndv(int i) { asm volatile("" : "+v"(i)); return i; }
__device__ __forceinline__ int lnds(int i) { asm volatile("" : "+v"(i)); return __builtin_amdgcn_readfirstlane(i); }
__device__ __forceinline__ int tid_of(int wave_s) { int z = 0; asm volatile("" : "+v"(z)); return (wave_s << 6) + (int)__builtin_amdgcn_mbcnt_hi(~0u, __builtin_amdgcn_mbcnt_lo(~0u, (unsigned)z)); }
namespace pg8 {
#define PG8_LAS __attribute__((address_space(3)))
typedef unsigned short bf16_t;
typedef short bf16x8 __attribute__((ext_vector_type(8)));
typedef float f32x4 __attribute__((ext_vector_type(4)));
typedef unsigned u32x4 __attribute__((ext_vector_type(4)));
constexpr int BM = 256, BK = 64, HALF = 128, HTB = HALF * BK * 2  , STAGE_BYTES = 8 * HTB, NXCD = 8, WGM = 8;

__host__ __device__ __forceinline__ int lds_byte(int r, int c) { const int st = (r >> 4) * 2 + (c >> 5), rr = r & 15, cc = c & 31, ob = rr * 64 + cc * 2; return st * 1024 + (ob ^ (((ob >> 9) & 1) << 5)); }
__host__ __device__ __forceinline__ void stage_rc(int b, int& R, int& C) { const int st = b / 1024, sb = b % 1024, swz = sb ^ (((sb >> 9) & 1) << 5); R = (st >> 1) * 16 + swz / 64; C = (st & 1) * 32 + (swz % 64) / 2; }
__host__ __device__ __forceinline__ int perm32(int rho) { const int n = rho >> 4, i = rho & 15; return 8 * (i >> 2) + 4 * n + (i & 3); }

struct Unit { int pm, pn; };
struct Gemm { const bf16_t* A; const bf16_t* Bt; int M, N, K, tid; };

struct StaticOrder {
    int nM, nN, nwg, G, c;
    __host__ __device__ void init(int M, int N, int G_, int c_) { nM = M / BM; nN = N / BM; nwg = nM * nN; G = G_; c = c_; }
    __host__ __device__ bool next(int i, Unit& u) const {
        const long L = (long)i * G + c; if (L >= nwg) return false;
        int wgid = (int)L; { const int q = nwg / NXCD, r = nwg % NXCD, xcd = wgid % NXCD, off = wgid / NXCD; wgid = (xcd < r ? xcd * (q + 1) : r * (q + 1) + (xcd - r) * q) + off; }
        const int nig = WGM * nN, gid = wgid / nig, fm = gid * WGM, gsz = (nM - fm) < WGM ? (nM - fm) : WGM;
        u.pm = fm + ((wgid % nig) % gsz); u.pn = (wgid % nig) / gsz; return true;
    }
    __device__ __forceinline__ void a_ready(const Unit&) const {}
    __device__ __forceinline__ void done(const Unit&) const {}
};

__device__ __forceinline__ unsigned cvt_pk_bf16(float lo, float hi) { unsigned r; asm volatile("v_cvt_pk_bf16_f32 %0, %1, %2" : "=v"(r) : "v"(lo), "v"(hi)); return r; }

template <int ACT> struct EpiBf16 {
    static constexpr bool PERM = true, AFTER_DRAIN = false;
    bf16_t* O; int ldc;
    __device__ __forceinline__ void operator()(const f32x4 (&acc)[2][2][4][2], const Unit& u, int wr, int wc, int fr, int fq) const {
        const int row0 = u.pm * BM + wr * 64 + fr, col0 = u.pn * BM + wc * 32 + 8 * fq;
#pragma unroll
        for (int ai = 0; ai < 2; ++ai)
#pragma unroll
            for (int m = 0; m < 4; ++m) { bf16_t* rowp = O + (size_t)(row0 + ai * HALF + m * 16) * ldc + col0;
#pragma unroll
                for (int bj = 0; bj < 2; ++bj) { f32x4 v0 = acc[ai][bj][m][0], v1 = acc[ai][bj][m][1];
                    if (ACT == 1) {
#pragma unroll
                        for (int e = 0; e < 4; ++e) { float a = v0[e] > 0.f ? v0[e] : 0.f; v0[e] = a * a; float b = v1[e] > 0.f ? v1[e] : 0.f; v1[e] = b * b; } }
                    u32x4 w; w.x = cvt_pk_bf16(v0[0], v0[1]); w.y = cvt_pk_bf16(v0[2], v0[3]); w.z = cvt_pk_bf16(v1[0], v1[1]); w.w = cvt_pk_bf16(v1[2], v1[3]);
                    *(u32x4*)(rowp + bj * HALF) = w; } }
    }
};
struct EpiSumsq {
    static constexpr bool PERM = true, AFTER_DRAIN = false;
    bf16_t* O; int ldc; float* ss;
    __device__ __forceinline__ void operator()(const f32x4 (&acc)[2][2][4][2], const Unit& u, int wr, int wc, int fr, int fq) const {
        const int row0 = u.pm * BM + wr * 64 + fr, col0 = u.pn * BM + wc * 32 + 8 * fq;
#pragma unroll
        for (int ai = 0; ai < 2; ++ai)
#pragma unroll
            for (int m = 0; m < 4; ++m) { const int row = row0 + ai * HALF + m * 16; bf16_t* rowp = O + (size_t)row * ldc + col0; float s = 0.f;
#pragma unroll
                for (int bj = 0; bj < 2; ++bj) { const f32x4 v0 = acc[ai][bj][m][0], v1 = acc[ai][bj][m][1];
                    s += (v0[0] * v0[0] + v0[1] * v0[1]) + (v0[2] * v0[2] + v0[3] * v0[3]) + (v1[0] * v1[0] + v1[1] * v1[1]) + (v1[2] * v1[2] + v1[3] * v1[3]);
                    u32x4 w; w.x = cvt_pk_bf16(v0[0], v0[1]); w.y = cvt_pk_bf16(v0[2], v0[3]); w.z = cvt_pk_bf16(v1[0], v1[1]); w.w = cvt_pk_bf16(v1[2], v1[3]);
                    *(u32x4*)(rowp + bj * HALF) = w; }
                s += __shfl_xor(s, 16); s += __shfl_xor(s, 32);
                if (fq == 0) atomicAdd(ss + row, s); }
    }
};
struct EpiFilt {
    static constexpr bool PERM = false, AFTER_DRAIN = false;
    float* F; const float* decay;
    __device__ __forceinline__ void operator()(const f32x4 (&acc)[2][2][4][2], const Unit& u, int wr, int wc, int fr, int fq) const {
        const int row0 = u.pm * BM + wr * 64 + fr, col0 = u.pn * BM + wc * 32 + 4 * fq;
#pragma unroll
        for (int bj = 0; bj < 2; ++bj)
#pragma unroll
            for (int n = 0; n < 2; ++n) {
                const int cb = col0 + bj * HALF + n * 16;
                const f32x4 dc = *(const f32x4*)(decay + cb);
#pragma unroll
                for (int e = 0; e < 4; ++e) { const int col = cb + e; const float ad = __builtin_fabsf(dc[e]);
                    float* fp = F + (size_t)((((col & 255) * 2 + (col >> 9)) * 2) + ((col >> 8) & 1)) * 16384;
#pragma unroll
                    for (int ai = 0; ai < 2; ++ai)
#pragma unroll
                        for (int m = 0; m < 4; ++m) { const int r = row0 + ai * HALF + m * 16; const float t = (float)r * (1.0f / 16384.0f);
                            fp[r] = acc[ai][bj][m][n][e] * expf(-t * ad); } } }
    }
};

template <class Epi, class Sched, bool ALIGN_EPI = false, bool SP2 = false>
__device__ __forceinline__ void gemm_phase(PG8_LAS unsigned char* lds, const Gemm g, const Sched& S, const Epi& E) {
    const int tid = g.tid, wid = __builtin_amdgcn_readfirstlane(tid >> 6), lane = tid & 63, wr = wid >> 2, wc = wid & 3, fr = lane & 15, fq = lane >> 4;
    const int K = g.K, nt = K / BK;
    unsigned voffA[2], voffB[2];
#pragma unroll
    for (int i = 0; i < 2; ++i) { int R, C; stage_rc(tid * 16 + i * 8192, R, C); const int Rb = Epi::PERM ? ((R & ~31) + perm32(R & 31)) : R;
        voffA[i] = (unsigned)(R * K + C) * 2u; voffB[i] = (unsigned)(Rb * K + C) * 2u; }
    const size_t kstep = (size_t)(BK * 2);
    const size_t hstep = (size_t)HALF * K * 2;
    const size_t tstep = 2 * hstep;
    const unsigned ldsw = (unsigned)wid * 1024u;
    const int aoff = lds_byte(wr * 64 + fr, fq * 8), boff = lds_byte(wc * 32 + fr, fq * 8);
#define PG8_SA(b, h) (((b) * 2 + (h)) * HTB)
#define PG8_SB(b, h) ((4 + (b) * 2 + (h)) * HTB)
#define PG8_STAGE(bufoff, gbase, voff) do { _Pragma("unroll") for (int _i = 0; _i < 2; ++_i) \
        __builtin_amdgcn_global_load_lds((const unsigned*)((const char*)(gbase) + (voff)[_i]), (PG8_LAS unsigned*)(lds + (bufoff) + ldsw + _i * 8192), 16, 0, 0); } while (0)
#define PG8_LDA(dst, b, h) do { _Pragma("unroll") for (int m = 0; m < 4; ++m) _Pragma("unroll") for (int k = 0; k < 2; ++k) dst[m][k] = *(const PG8_LAS bf16x8*)(lds + PG8_SA(b, h) + aoff + m * 2048 + k * 1024); } while (0)
#define PG8_LDB(dst, b, h) do { _Pragma("unroll") for (int n = 0; n < 2; ++n) _Pragma("unroll") for (int k = 0; k < 2; ++k) dst[n][k] = *(const PG8_LAS bf16x8*)(lds + PG8_SB(b, h) + boff + n * 2048 + k * 1024); } while (0)
#define PG8_MMA(ai, bj, At, Bt) do { __builtin_amdgcn_s_setprio(1); _Pragma("unroll") for (int m = 0; m < 4; ++m) _Pragma("unroll") for (int n = 0; n < 2; ++n) _Pragma("unroll") for (int k = 0; k < 2; ++k) \
        acc[ai][bj][m][n] = __builtin_amdgcn_mfma_f32_16x16x32_bf16(Bt[n][k], At[m][k], acc[ai][bj][m][n], 0, 0, 0); __builtin_amdgcn_s_setprio(0); } while (0)
#define PG8_WAIT_V(n) asm volatile("s_waitcnt vmcnt(" #n ")" ::: "memory")
#define PG8_WAIT_L(n) asm volatile("s_waitcnt lgkmcnt(" #n ")" ::: "memory")
#define PG8_BAR __builtin_amdgcn_s_barrier()
#define PG8_SCHED __builtin_amdgcn_sched_barrier(0)
    Unit cur, nxt; int ui = 0;
    if (!S.next(0, cur)) return;
    f32x4 acc[2][2][4][2];
#pragma unroll
    for (int a = 0; a < 2; ++a)
#pragma unroll
        for (int b = 0; b < 2; ++b)
#pragma unroll
            for (int m = 0; m < 4; ++m)
#pragma unroll
                for (int n = 0; n < 2; ++n) acc[a][b][m][n] = (f32x4){0.f, 0.f, 0.f, 0.f};
    bf16x8 At[4][2], B0[2][2], B1[2][2];
    const char* cA = (const char*)g.A + (size_t)cur.pm * tstep; const char* cB = (const char*)g.Bt + (size_t)cur.pn * tstep;
    S.a_ready(cur);
    if constexpr (SP2) {
        PG8_STAGE(PG8_SB(0, 0), cB, voffB); PG8_STAGE(PG8_SB(0, 1), cB + hstep, voffB); PG8_STAGE(PG8_SA(0, 0), cA, voffA); PG8_STAGE(PG8_SA(0, 1), cA + hstep, voffA);
        if (wr == 1) PG8_BAR;
        PG8_WAIT_V(2); PG8_BAR;
        PG8_STAGE(PG8_SB(1, 0), cB + kstep, voffB); PG8_STAGE(PG8_SA(1, 0), cA + kstep, voffA); PG8_STAGE(PG8_SB(1, 1), cB + hstep + kstep, voffB);
        PG8_WAIT_V(6); PG8_BAR;
    } else {
        PG8_STAGE(PG8_SB(0, 0), cB, voffB); PG8_STAGE(PG8_SA(0, 0), cA, voffA); PG8_STAGE(PG8_SB(0, 1), cB + hstep, voffB); PG8_STAGE(PG8_SA(0, 1), cA + hstep, voffA);
        if (wr == 1) PG8_BAR;
        PG8_WAIT_V(4); PG8_BAR;
        PG8_STAGE(PG8_SB(1, 0), cB + kstep, voffB); PG8_STAGE(PG8_SA(1, 0), cA + kstep, voffA); PG8_STAGE(PG8_SB(1, 1), cB + hstep + kstep, voffB);
        PG8_WAIT_V(6); PG8_BAR;
    }
    for (;;) {
        const bool has_next = S.next(ui + 1, nxt);
        const char* nA = has_next ? (const char*)g.A + (size_t)nxt.pm * tstep : cA; const char* nB = has_next ? (const char*)g.Bt + (size_t)nxt.pn * tstep : cB;
        for (int t = 0; t < nt; t += 2) {
            const bool last = (t == nt - 2);
            const char* a1 = cA + (size_t)(t + 1) * kstep;
            const char* a2 = last ? nA : cA + (size_t)(t + 2) * kstep; const char* b2 = last ? nB : cB + (size_t)(t + 2) * kstep;
            const char* a3 = a2 + kstep; const char* b3 = b2 + kstep;
            if (last && has_next) S.a_ready(nxt);
            if constexpr (SP2) {
            PG8_LDB(B0, 0, 0); PG8_LDB(B1, 0, 1); PG8_SCHED; PG8_LDA(At, 0, 0); PG8_STAGE(PG8_SA(1, 1), a1 + hstep, voffA);
            PG8_WAIT_V(8); PG8_WAIT_L(0); PG8_BAR; PG8_MMA(0, 0, At, B0); PG8_MMA(0, 1, At, B1); PG8_BAR; PG8_SCHED;
            PG8_LDA(At, 0, 1); PG8_STAGE(PG8_SB(0, 0), b2, voffB); PG8_STAGE(PG8_SB(0, 1), b2 + hstep, voffB); PG8_STAGE(PG8_SA(0, 0), a2, voffA);
            PG8_WAIT_V(8); PG8_WAIT_L(0); PG8_BAR; PG8_MMA(1, 0, At, B0); PG8_MMA(1, 1, At, B1); PG8_BAR; PG8_SCHED;
            PG8_LDB(B0, 1, 0); PG8_LDB(B1, 1, 1); PG8_SCHED; PG8_LDA(At, 1, 0); PG8_STAGE(PG8_SA(0, 1), a2 + hstep, voffA);
            PG8_WAIT_V(8); PG8_WAIT_L(0); PG8_BAR; PG8_MMA(0, 0, At, B0); PG8_MMA(0, 1, At, B1); PG8_BAR; PG8_SCHED;
            PG8_LDA(At, 1, 1); PG8_STAGE(PG8_SB(1, 0), b3, voffB); PG8_STAGE(PG8_SB(1, 1), b3 + hstep, voffB); PG8_STAGE(PG8_SA(1, 0), a3, voffA);
            PG8_WAIT_V(8); PG8_WAIT_L(0); PG8_BAR; PG8_MMA(1, 0, At, B0); PG8_MMA(1, 1, At, B1); PG8_BAR; PG8_SCHED;
            } else {
            PG8_LDB(B0, 0, 0); PG8_SCHED; PG8_LDA(At, 0, 0); PG8_STAGE(PG8_SA(1, 1), a1 + hstep, voffA);
            PG8_WAIT_L(8); PG8_BAR; PG8_WAIT_L(0); PG8_MMA(0, 0, At, B0); PG8_BAR; PG8_SCHED;
            PG8_LDB(B1, 0, 1); PG8_STAGE(PG8_SB(0, 0), b2, voffB);
            PG8_BAR; PG8_WAIT_L(0); PG8_MMA(0, 1, At, B1); PG8_BAR;
            PG8_LDA(At, 0, 1); PG8_STAGE(PG8_SA(0, 0), a2, voffA);
            PG8_BAR; PG8_WAIT_L(0); PG8_MMA(1, 0, At, B0); PG8_BAR; PG8_SCHED;
            PG8_STAGE(PG8_SB(0, 1), b2 + hstep, voffB);
            PG8_WAIT_V(6); PG8_BAR; PG8_MMA(1, 1, At, B1); PG8_BAR;
            PG8_LDB(B0, 1, 0); PG8_SCHED; PG8_LDA(At, 1, 0); PG8_STAGE(PG8_SA(0, 1), a2 + hstep, voffA);
            PG8_WAIT_L(8); PG8_BAR; PG8_WAIT_L(0); PG8_MMA(0, 0, At, B0); PG8_BAR; PG8_SCHED;
            PG8_LDB(B1, 1, 1); PG8_STAGE(PG8_SB(1, 0), b3, voffB);
            PG8_BAR; PG8_WAIT_L(0); PG8_MMA(0, 1, At, B1); PG8_BAR;
            PG8_LDA(At, 1, 1); PG8_STAGE(PG8_SA(1, 0), a3, voffA);
            PG8_BAR; PG8_WAIT_L(0); PG8_MMA(1, 0, At, B0); PG8_BAR; PG8_SCHED;
            PG8_STAGE(PG8_SB(1, 1), b3 + hstep, voffB);
            PG8_WAIT_V(6); PG8_BAR; PG8_MMA(1, 1, At, B1); PG8_BAR;
            }
        }
        if constexpr (ALIGN_EPI) { if (wr == 0) PG8_BAR; }
        if constexpr (!Epi::AFTER_DRAIN) { E(acc, cur, wr, wc, fr, fq); S.done(cur); }
        if (!has_next) break;
#pragma unroll
        for (int a = 0; a < 2; ++a)
#pragma unroll
            for (int b = 0; b < 2; ++b)
#pragma unroll
                for (int m = 0; m < 4; ++m)
#pragma unroll
                    for (int n = 0; n < 2; ++n) acc[a][b][m][n] = (f32x4){0.f, 0.f, 0.f, 0.f};
        cur = nxt; cA = nA; cB = nB; ++ui;
        if constexpr (ALIGN_EPI) { if (wr == 1) PG8_BAR; }
    }
    PG8_WAIT_V(0);
    if constexpr (!ALIGN_EPI) { if (wr == 0) PG8_BAR; }
    PG8_BAR;
    if constexpr (Epi::AFTER_DRAIN) { E.fused(acc, cur, wr, wc, fr, fq, lds, wid, lane); S.done(cur); }
#undef PG8_SA
#undef PG8_SB
#undef PG8_STAGE
#undef PG8_LDA
#undef PG8_LDB
#undef PG8_MMA
#undef PG8_WAIT_V
#undef PG8_WAIT_L
#undef PG8_BAR
#undef PG8_SCHED
}
}
#define LAS __attribute__((address_space(3)))
typedef unsigned short bf16_t;
typedef short bf16x8 __attribute__((ext_vector_type(8)));
typedef float f32x4 __attribute__((ext_vector_type(4)));
typedef float f32x2 __attribute__((ext_vector_type(2)));
typedef float f32x16 __attribute__((ext_vector_type(16)));
typedef unsigned u32x4 __attribute__((ext_vector_type(4)));
typedef unsigned u32x2 __attribute__((ext_vector_type(2)));

constexpr int LCTX = 256, LSEQ = 16384, R = LCTX + LSEQ;
constexpr int DM = 1024, NIN = 1792, FF = 4096, NLAYER = 4;
constexpr int NFFT = 16384;
constexpr int NCH = R / 16;
constexpr float EPS = 1e-6f;
constexpr float QSCALE = 0.125f * 1.4426950408889634f;
constexpr size_t KiB = 1024, MiB = 1024 * 1024;
constexpr size_t WS_SS1 = 0, WS_SS2 = 128 * KiB, WS_MODV = 256 * KiB, WS_TW = 512 * KiB, WS_LAMT = 640 * KiB, WS_H2C = 704 * KiB;
constexpr size_t WS_BAR = 768 * KiB;
constexpr size_t WS_XC = 1 * MiB;
constexpr size_t WS_WIN = 2 * MiB, WS_WOUT = 6 * MiB, WS_W1 = 8 * MiB, WS_W2 = 16 * MiB, WS_W3T = 24 * MiB, WS_GLUT = 24 * MiB + 512 * KiB;
constexpr size_t WS_S5M = 25 * MiB;
constexpr size_t WS_H2L = 34 * MiB;
constexpr size_t WS_H = 38 * MiB;
constexpr size_t WS_VXT = 38 * MiB, WS_Z2T = 62 * MiB;
constexpr size_t WS_OL = 71 * MiB;
constexpr size_t WS_SC = 71 * MiB, WS_HIN = WS_SC + (size_t)32 * NCH * 128 * 4;
constexpr size_t WS_U = 104 * MiB, WS_MERGED = 161 * MiB, WS_QN = 194 * MiB, WS_GBUF = WS_QN, WS_KN = 203 * MiB, WS_FILT = 208 * MiB, WS_Z1 = 272 * MiB;
constexpr size_t WS_HID = 104 * MiB;
constexpr size_t WS_ROPE = 288 * MiB;
constexpr size_t WS_END = 292 * MiB;
constexpr int LDS_BYTES = 132 * 1024;

struct P { const float* in[37]; float* out; unsigned char* ws; int lo, hi; };
__device__ __forceinline__ int lnd(int i) { asm volatile("" : "+v"(i)); return __builtin_amdgcn_readfirstlane(i); }
#define PIN(i) (p.in[lnd(i)])
__device__ __forceinline__ unsigned char* lndp(unsigned char* q) { unsigned lo = (unsigned)(uintptr_t)q, hi = (unsigned)((uintptr_t)q >> 32); asm volatile("" : "+v"(lo), "+v"(hi)); lo = __builtin_amdgcn_readfirstlane(lo); hi = __builtin_amdgcn_readfirstlane(hi); return (unsigned char*)(((uintptr_t)hi << 32) | (uintptr_t)lo); }


__device__ __forceinline__ unsigned f2bf(float f) { unsigned u = __builtin_bit_cast(unsigned, f); return (u + 0x7fffu + ((u >> 16) & 1u)) >> 16; }
__device__ __forceinline__ unsigned pk2(float lo, float hi) { return f2bf(lo) | (f2bf(hi) << 16); }
__device__ __forceinline__ float bflo(unsigned w) { return __builtin_bit_cast(float, w << 16); }
__device__ __forceinline__ float bfhi(unsigned w) { return __builtin_bit_cast(float, w & 0xffff0000u); }
__device__ __forceinline__ float bf1(bf16_t b) { return __builtin_bit_cast(float, (unsigned)b << 16); }
__device__ __forceinline__ float wave_sum(float v) {
#pragma unroll
    for (int o = 1; o < 64; o <<= 1) v += __shfl_xor(v, o);
    return v;
}
__device__ __forceinline__ f32x2 cmul(f32x2 a, f32x2 b) { return (f32x2){a.x * b.x - a.y * b.y, a.x * b.y + a.y * b.x}; }
__device__ __forceinline__ f32x2 cmulc(f32x2 a, f32x2 b) { return (f32x2){a.x * b.x + a.y * b.y, a.y * b.x - a.x * b.y}; }
__device__ __forceinline__ f32x2 cconj(f32x2 a) { return (f32x2){a.x, -a.y}; }

__device__ __forceinline__ void pro_mod(const int wave_s_, const P& p, LAS unsigned char* lds) { unsigned char* const wsb = lndp(p.ws); const int tidx_ = tid_of(wave_s_); const int bidx_ = lnds((int)blockIdx.x);
    const float* c = PIN(1); const float* cc = PIN(3); const float* mw = PIN(4); const float* mb = PIN(5);
    float* modv = (float*)(wsb + WS_MODV);
    LAS float* red = (LAS float*)lds;
    const int tid = tidx_, cq = tid & 15, ks = tid >> 4;
    for (int item = bidx_; item < 4 * 96; item += gridDim.x) {
        const int layer = item / 96, n0 = (item % 96) * 64;
        f32x4 aL = {0.f, 0.f, 0.f, 0.f}, aC = {0.f, 0.f, 0.f, 0.f};
        const float* wp = mw + ((size_t)layer * 1024 + ks * 32) * 6144 + n0 + 4 * cq;
        for (int k = 0; k < 32; ++k) {
            const float cv = c[ks * 32 + k], xv = cc[ks * 32 + k];
            const float sl = cv / (1.f + expf(-cv)), sc = xv / (1.f + expf(-xv));
            const f32x4 w = *(const f32x4*)(wp + (size_t)k * 6144);
            aL += w * sl; aC += w * sc;
        }
        LAS float* r = red + (ks * 16 + cq) * 8;
        r[0] = aL[0]; r[1] = aL[1]; r[2] = aL[2]; r[3] = aL[3]; r[4] = aC[0]; r[5] = aC[1]; r[6] = aC[2]; r[7] = aC[3];
        __syncthreads();
        if (tid < 128) { const int cq2 = tid & 15, j = tid >> 4; float s = 0.f;
            for (int k2 = 0; k2 < 32; ++k2) s += red[(k2 * 16 + cq2) * 8 + j];
            const int n = n0 + 4 * cq2 + (j & 3), stream = j >> 2;
            modv[(layer * 2 + stream) * 6144 + n] = s + mb[layer * 6144 + n]; }
        __syncthreads();
    }
}
__device__ __forceinline__ void pro_tables(const int wave_s_, const P& p) { unsigned char* const wsb = lndp(p.ws); const int tidx_ = tid_of(wave_s_); const int bidx_ = lnds((int)blockIdx.x);
    const int gt = bidx_ * 512 + tidx_, GT = gridDim.x * 512;
    f32x2* tw = (f32x2*)(wsb + WS_TW);
    for (int t = gt; t <= 8192; t += GT) { float s, c; sincospif((float)t * (1.0f / 8192.0f), &s, &c); tw[t] = (f32x2){c, -s}; }
    f32x2* rope = (f32x2*)(wsb + WS_ROPE);
    for (int i = gt; i < LSEQ * 32; i += GT) { const int t = i >> 5, j = i & 31; const int pos = j < 16 ? (t >> 6) : (t & 63);
        const float inv = powf(10000.0f, -(float)(2 * (j & 15)) / 32.0f); const float ang = (float)pos * inv; float s, c; sincosf(ang, &s, &c); rope[i] = (f32x2){c, s}; }
}
__device__ __forceinline__ void ew_phase(const int wave_s_, const P& p, int mode, int layer) { unsigned char* const wsb = lndp(p.ws); const int tidx_ = tid_of(wave_s_); const int bidx_ = lnds((int)blockIdx.x);
    const int lane = tidx_ & 63, wave = tidx_ >> 6;
    const int gw = bidx_ * 8 + wave, NGW = gridDim.x * 8;
    const float* modv = (const float*)(wsb + WS_MODV);
    const float* ss = (const float*)(wsb + (mode == 1 ? WS_SS1 : WS_SS2));
    const bf16_t* OL = (const bf16_t*)(wsb + WS_OL);
    bf16_t* H = (bf16_t*)(wsb + WS_H);
    float* xc = (float*)(wsb + WS_XC);
    const float* gpost = (mode == 1 ? PIN(7) : PIN(9)) + layer * 1024;
    const int gi = mode == 1 ? 2 : 5;
    const bool donorm = !(mode == 2 && layer == NLAYER - 1);
    const int nl = mode == 2 ? layer + 1 : layer;
    const float* gpre = (mode == 1 ? PIN(8) : PIN(6)) + (donorm ? nl : 0) * 1024;
    const int shi = mode == 1 ? 3 : 0, sci = mode == 1 ? 4 : 1;
    for (int row = gw; row < R; row += NGW) {
        const int stream = row < LCTX ? 1 : 0;
        float* xp = row < LCTX ? xc + (size_t)row * 1024 : p.out + (size_t)(row - LCTX) * 1024;
        const float* src = mode == 0 ? (row < LCTX ? PIN(2) + (size_t)row * 1024 : PIN(0) + (size_t)(row - LCTX) * 1024) : xp;
        f32x4 v[4];
#pragma unroll
        for (int j = 0; j < 4; ++j) v[j] = *(const f32x4*)(src + j * 256 + lane * 4);
        if (mode != 0) {
            const float rs = rsqrtf(ss[row] * (1.0f / 1024.0f) + EPS);
            const float* mg = modv + (layer * 2 + stream) * 6144 + gi * 1024;
#pragma unroll
            for (int j = 0; j < 4; ++j) { const int col = j * 256 + lane * 4;
                const f32x4 g = *(const f32x4*)(mg + col) * *(const f32x4*)(gpost + col) * rs;
                const u32x2 o = *(const u32x2*)(OL + (size_t)row * 1024 + col);
                v[j] += g * (f32x4){bflo(o.x), bfhi(o.x), bflo(o.y), bfhi(o.y)}; }
        }
#pragma unroll
        for (int j = 0; j < 4; ++j) *(f32x4*)(xp + j * 256 + lane * 4) = v[j];
        if (donorm) {
            float s = 0.f;
#pragma unroll
            for (int j = 0; j < 4; ++j) s += (v[j][0] * v[j][0] + v[j][1] * v[j][1]) + (v[j][2] * v[j][2] + v[j][3] * v[j][3]);
            s = wave_sum(s);
            const float rstd = rsqrtf(s * (1.0f / 1024.0f) + EPS);
            const float* msh = modv + (nl * 2 + stream) * 6144 + shi * 1024; const float* msc = modv + (nl * 2 + stream) * 6144 + sci * 1024;
#pragma unroll
            for (int j = 0; j < 4; ++j) { const int col = j * 256 + lane * 4;
                const f32x4 y = v[j] * rstd * *(const f32x4*)(gpre + col) * (*(const f32x4*)(msc + col) + 1.0f) + *(const f32x4*)(msh + col);
                u32x2 w; w.x = pk2(y[0], y[1]); w.y = pk2(y[2], y[3]);
                *(u32x2*)(H + (size_t)row * 1024 + col) = w; }
        }
    }
}
__device__ __forceinline__ void transpose_item(const float* W, int K, int N, bf16_t* WT, int ldo, LAS float* scr, int item, int lane) {
    const int nblk = N / 32, kb = item / nblk, nb = item % nblk, k0 = 64 * kb, n0 = 32 * nb;
#pragma unroll 8
    for (int i = 0; i < 32; ++i) { const int kk = 2 * i + (lane >> 5); scr[kk * 33 + (lane & 31)] = W[(size_t)(k0 + kk) * N + n0 + (lane & 31)]; }
    asm volatile("s_waitcnt lgkmcnt(0)" ::: "memory");
    const int c = lane & 7;
#pragma unroll
    for (int j = 0; j < 4; ++j) { const int n = (lane >> 3) + 8 * j; const LAS float* s = scr + (8 * c) * 33 + n;
        u32x4 o; o.x = pk2(s[0 * 33], s[1 * 33]); o.y = pk2(s[2 * 33], s[3 * 33]); o.z = pk2(s[4 * 33], s[5 * 33]); o.w = pk2(s[6 * 33], s[7 * 33]);
        *(u32x4*)(WT + (size_t)(n0 + n) * ldo + k0 + 8 * c) = o; }
    asm volatile("s_waitcnt lgkmcnt(0)" ::: "memory");
}
__device__ __forceinline__ void prep_layer(const int wave_s_, const P& p, int l, LAS unsigned char* lds) { unsigned char* const wsb = lndp(p.ws); const int tidx_ = tid_of(wave_s_); const int bidx_ = lnds((int)blockIdx.x);
    const int tid = tidx_, lane = tid & 63, wave = tid >> 6;
    const int gw = bidx_ * 8 + wave, NGW = gridDim.x * 8;
    const int gt = bidx_ * 512 + tid, GT = gridDim.x * 512;
    {
        LAS float* scr = (LAS float*)(lds + wave * 16384);
        bf16_t* WIN = (bf16_t*)(wsb + WS_WIN); bf16_t* WOUT = (bf16_t*)(wsb + WS_WOUT); bf16_t* W1 = (bf16_t*)(wsb + WS_W1); bf16_t* W2 = (bf16_t*)(wsb + WS_W2);
        bf16_t* W3T = (bf16_t*)(wsb + WS_W3T); bf16_t* GLUT = (bf16_t*)(wsb + WS_GLUT);
        constexpr int I_IN = 16 * 56, I_OUT = 16 * 32, I_1 = 16 * 128, I_2 = 64 * 32, I_3 = 1 * 32, I_G = 4 * 8;
        constexpr int NIT = I_IN + I_OUT + I_1 + I_2 + I_3 + I_G;
        for (int it = gw; it < NIT; it += NGW) {
            int r = it;
            if (r < I_IN) { transpose_item(PIN(10) + (size_t)l * DM * NIN, DM, NIN, WIN, DM, scr, r, lane); continue; } r -= I_IN;
            if (r < I_OUT) { transpose_item(PIN(11) + (size_t)l * DM * DM, DM, DM, WOUT, DM, scr, r, lane); continue; } r -= I_OUT;
            if (r < I_1) { transpose_item(PIN(35) + (size_t)l * DM * FF, DM, FF, W1, DM, scr, r, lane); continue; } r -= I_1;
            if (r < I_2) { transpose_item(PIN(36) + (size_t)l * FF * DM, FF, DM, W2, FF, scr, r, lane); continue; } r -= I_2;
            if (r < I_3) { transpose_item(PIN(18) + (size_t)l * 64 * 1024, 64, 1024, W3T, 128, scr, r, lane); continue; } r -= I_3;
            transpose_item(PIN(29) + (size_t)l * 256 * 256, 256, 256, GLUT, 256, scr, r, lane);
        }
        bf16_t* H2L = (bf16_t*)(wsb + WS_H2L);
        const u32x4 z4 = {0u, 0u, 0u, 0u};
        for (int i = gt; i < 1024 * 8; i += GT) *(u32x4*)(W3T + (size_t)(i >> 3) * 128 + 64 + (i & 7) * 8) = z4;
        for (int i = gt; i < 16384 * 8; i += GT) *(u32x4*)(H2L + (size_t)(i >> 3) * 128 + 64 + (i & 7) * 8) = z4;
    }
    __syncthreads();
    {
        LAS f32x2* pw = (LAS f32x2*)lds;
        LAS f32x2* bb = pw + 17 * 64;
        LAS f32x2* cc = bb + 64 * 16;
        LAS f32x2* crci = cc + 16 * 64;
        LAS float* kt = (LAS float*)(crci + 64);
        float* lamT = (float*)(wsb + WS_LAMT);
        for (int dg = bidx_; dg < 32; dg += gridDim.x) {
            const int dir = dg >> 4, g = dg & 15; const int pb = ((l * 2 + dir) * 16 + g);
            if (tid < 64) {
                const float are = PIN(21)[pb * 64 + tid], aim = PIN(22)[pb * 64 + tid]; const float dt = expf(PIN(23)[pb]);
                const float mag = expf(are * dt), ang = aim * dt; const float lr = mag * cosf(ang), li = mag * sinf(ang);
                const float den = are * are + aim * aim, nr = lr - 1.0f, ni = li;
                crci[tid] = (f32x2){(nr * are + ni * aim) / den, (ni * are - nr * aim) / den};
                f32x2 w = {1.f, 0.f}; const f32x2 lam = {lr, li};
                for (int k = 0; k <= 16; ++k) { pw[k * 64 + tid] = w; w = cmul(w, lam); }
                const f32x2 l16 = pw[16 * 64 + tid]; lamT[dg * 128 + tid] = l16.x; lamT[dg * 128 + 64 + tid] = l16.y;
            }
            __syncthreads();
            for (int idx = tid; idx < 1024; idx += 512) {
                { const int pp = idx >> 4, h = idx & 15; const float bre = PIN(24)[(size_t)(pb * 64 + pp) * 16 + h], bim = PIN(25)[(size_t)(pb * 64 + pp) * 16 + h]; const f32x2 cr = crci[pp];
                  bb[idx] = (f32x2){cr.x * bre - cr.y * bim, cr.x * bim + cr.y * bre}; }
                { cc[idx] = (f32x2){PIN(26)[(size_t)pb * 1024 + idx], PIN(27)[(size_t)pb * 1024 + idx]}; }
            }
            __syncthreads();
            for (int idx = tid; idx < 4096; idx += 512) { const int k = idx >> 8, hp = (idx >> 4) & 15, h = idx & 15; float s = 0.f;
                for (int pp = 0; pp < 64; ++pp) { const f32x2 t = cmul(cc[hp * 64 + pp], pw[k * 64 + pp]); const f32x2 b = bb[pp * 16 + h]; s += t.x * b.x - t.y * b.y; }
                kt[idx] = s; }
            __syncthreads();
            unsigned* KI = (unsigned*)(wsb + WS_S5M + (size_t)dg * 256 * KiB); unsigned* BB = KI + 32768; unsigned* CC = BB + 16384;
            const float* dsk = PIN(28) + l * 256 + g * 16;
            for (int i2 = tid; i2 < 32768; i2 += 512) { const int n = i2 >> 7, kp = i2 & 127, kk = 2 * kp, s = kk >> 4, h = kk & 15, t = n >> 4, hp = n & 15;
                const int lag = dir == 0 ? t - s : s - t; float v0 = 0.f, v1 = 0.f;
                if (lag >= 0) { v0 = kt[(lag * 16 + hp) * 16 + h]; v1 = kt[(lag * 16 + hp) * 16 + h + 1]; }
                if (dir == 0 && lag == 0) { if (h == hp) v0 += dsk[hp]; if (h + 1 == hp) v1 += dsk[hp]; }
                KI[i2] = pk2(v0, v1); }
            for (int i2 = tid; i2 < 16384; i2 += 512) { const int col = i2 >> 7, kp = i2 & 127, kk = 2 * kp, s = kk >> 4, h = kk & 15, ri = col >> 6, pp = col & 63;
                const int e = dir == 0 ? 15 - s : s; const f32x2 w = pw[e * 64 + pp]; const f32x2 a = cmul(w, bb[pp * 16 + h]), b = cmul(w, bb[pp * 16 + h + 1]);
                BB[i2] = ri == 0 ? pk2(a.x, b.x) : pk2(a.y, b.y); }
            for (int i2 = tid; i2 < 16384; i2 += 512) { const int n = i2 >> 6, cp = i2 & 63, col = 2 * cp, ri = col >> 6, pp = col & 63, t = n >> 4, hp = n & 15;
                const int e = dir == 0 ? t + 1 : 16 - t; const f32x2 a = cmul(cc[hp * 64 + pp], pw[e * 64 + pp]), b = cmul(cc[hp * 64 + pp + 1], pw[e * 64 + pp + 1]);
                CC[i2] = ri == 0 ? pk2(a.x, b.x) : pk2(-a.y, -b.y); }
            __syncthreads();
        }
    }
    {
        LAS float* w1s = (LAS float*)lds; LAS float* b1s = w1s + 33 * 64; LAS float* w2s = b1s + 64; LAS float* b2s = w2s + 4096;
        __syncthreads();
        for (int i = tid; i < 33 * 64; i += 512) w1s[i] = PIN(14)[l * 33 * 64 + i];
        for (int i = tid; i < 4096; i += 512) w2s[i] = PIN(16)[l * 4096 + i];
        if (tid < 64) { b1s[tid] = PIN(15)[l * 64 + tid]; b2s[tid] = PIN(17)[l * 64 + tid]; }
        __syncthreads();
        bf16_t* H2L = (bf16_t*)(wsb + WS_H2L); float* H2C = (float*)(wsb + WS_H2C);
        for (int item = bidx_; item < 33; item += gridDim.x) {
            const bool isctx = item == 32; const int n = isctx ? tid : item * 512 + tid;
            if (!isctx || tid < 256) {
                const float t = (float)n / (isctx ? 256.0f : 16384.0f);
                float h1[64];
#pragma unroll
                for (int j = 0; j < 64; ++j) h1[j] = b1s[j] + t * w1s[j];
                _Pragma("nounroll") for (int f = 1; f <= 16; ++f) { float cs, sn; sincospif(2.0f * t * (float)f, &sn, &cs);
#pragma unroll
                    for (int j = 0; j < 64; ++j) h1[j] += cs * w1s[f * 64 + j] + sn * w1s[(16 + f) * 64 + j]; }
#pragma unroll
                for (int j = 0; j < 64; ++j) h1[j] = sinpif(h1[j] * 0.3183098861837907f);
                _Pragma("nounroll") for (int j = 0; j < 64; j += 2) { float a0 = b2s[j], a1 = b2s[j + 1];
#pragma unroll
                    for (int i = 0; i < 64; ++i) { a0 += h1[i] * w2s[i * 64 + j]; a1 += h1[i] * w2s[i * 64 + j + 1]; }
                    a0 = sinpif(a0 * 0.3183098861837907f); a1 = sinpif(a1 * 0.3183098861837907f);
                    if (isctx) { H2C[n * 64 + j] = a0; H2C[n * 64 + j + 1] = a1; } else *(unsigned*)(H2L + (size_t)n * 128 + j) = pk2(a0, a1); }
            }
        }
        __syncthreads();
    }
}

__device__ __forceinline__ void pb_attprep(const int wave_s_, const P& p, int l) { unsigned char* const wsb = lndp(p.ws); const int tidx_ = tid_of(wave_s_); const int bidx_ = lnds((int)blockIdx.x);
    const int gt = bidx_ * 512 + tidx_, GT = gridDim.x * 512;
    const bf16_t* U = (const bf16_t*)(wsb + WS_U); bf16_t* QN = (bf16_t*)(wsb + WS_QN); bf16_t* KN = (bf16_t*)(wsb + WS_KN);
    const f32x2* rope = (const f32x2*)(wsb + WS_ROPE);
    for (int idx = gt; idx < R * 6; idx += GT) {
        const int row = idx / 6, slot = idx - row * 6;
        const bf16_t* src = U + (size_t)row * NIN + (slot < 4 ? 1280 + slot * 64 : 1536 + (slot - 4) * 64);
        const float* gain = (slot < 4 ? PIN(33) : PIN(34)) + l * 64;
        float x[64]; float ms = 0.f;
#pragma unroll
        for (int c = 0; c < 8; ++c) { const u32x4 w = *(const u32x4*)(src + c * 8);
            x[c * 8 + 0] = bflo(w.x); x[c * 8 + 1] = bfhi(w.x); x[c * 8 + 2] = bflo(w.y); x[c * 8 + 3] = bfhi(w.y); x[c * 8 + 4] = bflo(w.z); x[c * 8 + 5] = bfhi(w.z); x[c * 8 + 6] = bflo(w.w); x[c * 8 + 7] = bfhi(w.w); }
#pragma unroll
        for (int d = 0; d < 64; ++d) ms += x[d] * x[d];
        const float rs = rsqrtf(ms * (1.0f / 64.0f) + EPS);
#pragma unroll
        for (int d = 0; d < 64; ++d) x[d] = x[d] * rs * gain[d];
        if (row >= LCTX) { const f32x2* rp = rope + (size_t)(row - LCTX) * 32;
#pragma unroll
            for (int i = 0; i < 32; ++i) { const f32x2 cs = rp[i]; const float x0 = x[2 * i], x1 = x[2 * i + 1]; x[2 * i] = x0 * cs.x - x1 * cs.y; x[2 * i + 1] = x0 * cs.y + x1 * cs.x; } }
        const float sc = slot < 4 ? QSCALE : 1.0f;
        bf16_t* dst = slot < 4 ? QN + (size_t)row * 256 + slot * 64 : KN + (size_t)row * 128 + (slot - 4) * 64;
#pragma unroll
        for (int c = 0; c < 8; ++c) { u32x4 w; w.x = pk2(x[c * 8] * sc, x[c * 8 + 1] * sc); w.y = pk2(x[c * 8 + 2] * sc, x[c * 8 + 3] * sc); w.z = pk2(x[c * 8 + 4] * sc, x[c * 8 + 5] * sc); w.w = pk2(x[c * 8 + 6] * sc, x[c * 8 + 7] * sc);
            *(u32x4*)(dst + c * 8) = w; }
    }
}
__device__ __forceinline__ void pb_s5local(const int wave_s_, const P& p) { unsigned char* const wsb = lndp(p.ws); const int tidx_ = tid_of(wave_s_); const int bidx_ = lnds((int)blockIdx.x);
    const int lane = tidx_ & 63, wave = tidx_ >> 6, gw = bidx_ * 8 + wave, NGW = gridDim.x * 8;
    const bf16_t* U = (const bf16_t*)(wsb + WS_U); float* SC = (float*)(wsb + WS_SC);
    const int m = lane & 15, kq = lane >> 4;
    for (int it = gw; it < 32 * 65; it += NGW) {
        const int dg = it / 65, ct = it - dg * 65, g = dg & 15;
        const bf16_t* BB = (const bf16_t*)(wsb + WS_S5M + (size_t)dg * 256 * KiB + 128 * KiB);
        f32x4 acc[8];
#pragma unroll
        for (int n = 0; n < 8; ++n) acc[n] = (f32x4){0.f, 0.f, 0.f, 0.f};
        const int chunk = ct * 16 + m;
        for (int ks = 0; ks < 8; ++ks) {
            const int k0 = ks * 32 + 8 * kq;
            const bf16x8 a = *(const bf16x8*)(U + (size_t)(chunk * 16 + (k0 >> 4)) * NIN + 768 + g * 16 + (k0 & 15));
#pragma unroll
            for (int n = 0; n < 8; ++n) { const bf16x8 b = *(const bf16x8*)(BB + (size_t)(n * 16 + m) * 256 + k0);
                acc[n] = __builtin_amdgcn_mfma_f32_16x16x32_bf16(a, b, acc[n], 0, 0, 0); }
        }
#pragma unroll
        for (int n = 0; n < 8; ++n)
#pragma unroll
            for (int i = 0; i < 4; ++i) SC[((size_t)dg * NCH + ct * 16 + 4 * kq + i) * 128 + n * 16 + m] = acc[n][i];
    }
}
__device__ __forceinline__ void pb_pool(const int wave_s_, const P& p, int l, LAS unsigned char* lds) { unsigned char* const wsb = lndp(p.ws); const int tidx_ = tid_of(wave_s_); const int bidx_ = lnds((int)blockIdx.x);
    const int tid = tidx_;
    const bf16_t* U = (const bf16_t*)(wsb + WS_U); bf16_t* MG = (bf16_t*)(wsb + WS_MERGED);
    LAS float* ut = (LAS float*)lds;
    LAS float* pt = ut + 80 * 64;
    LAS float* wt = pt + 64 * 65;
    for (int item = bidx_; item < 260 * 4; item += gridDim.x) {
        const int g = item & 3, r0 = (item >> 2) * 64; const int win = 2 << g, hw = win >> 1;
        const int seg0 = r0 < LCTX ? 0 : LCTX, seg1 = r0 < LCTX ? LCTX : R;
        __syncthreads();
        for (int i = tid; i < 80 * 8; i += 512) { const int rr = i >> 3, c8 = (i & 7) * 8; const int row = r0 - 8 + rr; f32x4 a = {0.f, 0.f, 0.f, 0.f}, b = a;
            if (row >= seg0 && row < seg1) { const u32x4 w = *(const u32x4*)(U + (size_t)row * NIN + 1024 + g * 64 + c8); a = (f32x4){bflo(w.x), bfhi(w.x), bflo(w.y), bfhi(w.y)}; b = (f32x4){bflo(w.z), bfhi(w.z), bflo(w.w), bfhi(w.w)}; }
            *(LAS f32x4*)(ut + rr * 64 + c8) = a; *(LAS f32x4*)(ut + rr * 64 + c8 + 4) = b; }
        for (int i = tid; i < 4096; i += 512) wt[i] = PIN(31)[(size_t)(l * 4 + g) * 4096 + i];
        __syncthreads();
        { const int t = tid >> 3, c8 = (tid & 7) * 8; const int row = r0 + t;
          int lo = row - hw; if (lo < seg0) lo = seg0; int hi = row + hw; if (hi > seg1) hi = seg1; const float inv = 1.0f / (float)(hi - lo);
#pragma unroll
          for (int c = 0; c < 8; ++c) { float s = 0.f; for (int rr = lo; rr < hi; ++rr) s += ut[(rr - r0 + 8) * 64 + c8 + c]; pt[t * 65 + c8 + c] = s * inv - ut[(t + 8) * 64 + c8 + c]; } }
        __syncthreads();
        { const int t = tid >> 3, d8 = (tid & 7) * 8; float acc[8];
#pragma unroll
          for (int d = 0; d < 8; ++d) acc[d] = 0.f;
          for (int c = 0; c < 64; ++c) { const float pv = pt[t * 65 + c]; const f32x4 w0 = *(const LAS f32x4*)(wt + c * 64 + d8), w1 = *(const LAS f32x4*)(wt + c * 64 + d8 + 4);
              acc[0] += pv * w0[0]; acc[1] += pv * w0[1]; acc[2] += pv * w0[2]; acc[3] += pv * w0[3]; acc[4] += pv * w1[0]; acc[5] += pv * w1[1]; acc[6] += pv * w1[2]; acc[7] += pv * w1[3]; }
          const float* sc = PIN(32) + l * 256 + g * 64 + d8;
          u32x4 w; w.x = pk2(acc[0] * sc[0], acc[1] * sc[1]); w.y = pk2(acc[2] * sc[2], acc[3] * sc[3]); w.z = pk2(acc[4] * sc[4], acc[5] * sc[5]); w.w = pk2(acc[6] * sc[6], acc[7] * sc[7]);
          *(u32x4*)(MG + (size_t)(r0 + t) * 1024 + 512 + g * 64 + d8) = w; }
    }
    __syncthreads();
}
__device__ __forceinline__ void pb_shortconv(const int wave_s_, const P& p, int l, LAS unsigned char* lds) { unsigned char* const wsb = lndp(p.ws); const int tidx_ = tid_of(wave_s_); const int bidx_ = lnds((int)blockIdx.x);
    const int tid = tidx_;
    const bf16_t* U = (const bf16_t*)(wsb + WS_U); bf16_t* VXT = (bf16_t*)(wsb + WS_VXT);
    LAS float* ut = (LAS float*)lds;
    const float* cw = PIN(12) + (size_t)l * 3 * 768; const float* cb = PIN(13) + l * 768;
    for (int item = bidx_; item < 256 * 12; item += gridDim.x) {
        const int cbk = item % 12, t0 = (item / 12) * 64, c0 = cbk * 64;
        __syncthreads();
        for (int i = tid; i < 66 * 8; i += 512) { const int rr = i >> 3, c8 = (i & 7) * 8; const int t = t0 - 1 + rr; f32x4 a = {0.f, 0.f, 0.f, 0.f}, b = a;
            if (t >= 0 && t < LSEQ) { const u32x4 w = *(const u32x4*)(U + (size_t)(LCTX + t) * NIN + c0 + c8); a = (f32x4){bflo(w.x), bfhi(w.x), bflo(w.y), bfhi(w.y)}; b = (f32x4){bflo(w.z), bfhi(w.z), bflo(w.w), bfhi(w.w)}; }
            LAS float* d = ut + rr * 65 + c8; d[0] = a[0]; d[1] = a[1]; d[2] = a[2]; d[3] = a[3]; d[4] = b[0]; d[5] = b[1]; d[6] = b[2]; d[7] = b[3]; }
        __syncthreads();
        { const int c = tid >> 3, t8 = (tid & 7) * 8; const int col = c0 + c; const float w0 = cw[col], w1 = cw[768 + col], w2 = cw[1536 + col], b = cb[col]; float y[8];
#pragma unroll
          for (int i = 0; i < 8; ++i) y[i] = b + w0 * ut[(t8 + i) * 65 + c] + w1 * ut[(t8 + i + 1) * 65 + c] + w2 * ut[(t8 + i + 2) * 65 + c];
          u32x4 w; w.x = pk2(y[0], y[1]); w.y = pk2(y[2], y[3]); w.z = pk2(y[4], y[5]); w.w = pk2(y[6], y[7]);
          *(u32x4*)(VXT + (size_t)col * LSEQ + t0 + t8) = w; }
    }
    __syncthreads();
}
__device__ __forceinline__ void pb_ctxhyena(const int wave_s_, const P& p, int l, LAS unsigned char* lds) { unsigned char* const wsb = lndp(p.ws); const int tidx_ = tid_of(wave_s_); const int bidx_ = lnds((int)blockIdx.x);
    const int lane = tidx_ & 63, wave = tidx_ >> 6, gw = bidx_ * 8 + wave, NGW = gridDim.x * 8;
    const bf16_t* U = (const bf16_t*)(wsb + WS_U); bf16_t* MG = (bf16_t*)(wsb + WS_MERGED); const float* H2C = (const float*)(wsb + WS_H2C);
    LAS float* base = (LAS float*)(lds + wave * 8192);
    LAS float* zc = base; LAS float* x1c = base + 256; LAS float* x2c = base + 512; LAS float* kc = base + 768; LAS float* w3c = base + 768 + 512;
    const float* cw = PIN(12) + (size_t)l * 3 * 768; const float* cb = PIN(13) + l * 768;
    for (int ch = gw; ch < 256; ch += NGW) {
#pragma unroll
        for (int s = 0; s < 3; ++s) { const int col = s * 256 + ch; const float w0 = cw[col], w1 = cw[768 + col], w2 = cw[1536 + col], b = cb[col];
            _Pragma("nounroll") for (int i = 0; i < 4; ++i) { const int t = lane + 64 * i;
                const float um = t > 0 ? bf1(U[(size_t)(t - 1) * NIN + col]) : 0.f, u0 = bf1(U[(size_t)t * NIN + col]), up = t < 255 ? bf1(U[(size_t)(t + 1) * NIN + col]) : 0.f;
                (s == 0 ? zc : s == 1 ? x1c : x2c)[t] = b + w0 * um + w1 * u0 + w2 * up; } }
        for (int o = 0; o < 2; ++o) {
            asm volatile("s_waitcnt lgkmcnt(0)" ::: "memory");
            w3c[lane] = PIN(18)[((size_t)l * 64 + lane) * 1024 + o * 512 + ch]; w3c[64 + lane] = PIN(18)[((size_t)l * 64 + lane) * 1024 + o * 512 + 256 + ch];
            asm volatile("s_waitcnt lgkmcnt(0)" ::: "memory");
            const float df = __builtin_fabsf(PIN(19)[((l * 2 + o) * 2 + 0) * 256 + ch]), db = __builtin_fabsf(PIN(19)[((l * 2 + o) * 2 + 1) * 256 + ch]);
            _Pragma("nounroll") for (int i = 0; i < 4; ++i) { const int n = lane + 64 * i; float af = 0.f, ab = 0.f;
                _Pragma("unroll 4") for (int j = 0; j < 64; ++j) { const float hv = H2C[n * 64 + j]; af += hv * w3c[j]; ab += hv * w3c[64 + j]; }
                const float t = (float)n * (1.0f / 256.0f);
                kc[255 + n] = af * expf(-t * df); if (n < 255) kc[254 - n] = ab * expf(-t * db); }
            asm volatile("s_waitcnt lgkmcnt(0)" ::: "memory");
            const float fb = PIN(20)[(l * 2 + o) * 256 + ch];
            float y[4];
#pragma unroll
            for (int i = 0; i < 4; ++i) y[i] = 0.f;
            _Pragma("unroll 4") for (int s = 0; s < 256; ++s) { const float zs = zc[s];
#pragma unroll
                for (int i = 0; i < 4; ++i) y[i] += zs * kc[255 + lane + 64 * i - s]; }
            float zn[4];
#pragma unroll
            for (int i = 0; i < 4; ++i) { const int t = lane + 64 * i; zn[i] = (o == 0 ? x1c[t] : x2c[t]) * (y[i] + fb * zc[t]); }
            asm volatile("s_waitcnt lgkmcnt(0)" ::: "memory");
#pragma unroll
            for (int i = 0; i < 4; ++i) zc[lane + 64 * i] = zn[i];
            asm volatile("s_waitcnt lgkmcnt(0)" ::: "memory");
        }
        for (int i = 0; i < 4; ++i) { const int t = lane + 64 * i; MG[(size_t)t * 1024 + ch] = (bf16_t)f2bf(zc[t]); }
        asm volatile("s_waitcnt lgkmcnt(0)" ::: "memory");
    }
}

__device__ __forceinline__ void pc_s5carry(const int wave_s_, const P& p) { unsigned char* const wsb = lndp(p.ws); const int tidx_ = tid_of(wave_s_); const int bidx_ = lnds((int)blockIdx.x);
    const float* SC = (const float*)(wsb + WS_SC); float* HIN = (float*)(wsb + WS_HIN); const float* lamT = (const float*)(wsb + WS_LAMT);
    for (int idx = bidx_ * 512 + tidx_; idx < 2048; idx += gridDim.x * 512) {
        const int dg = idx >> 6, pp = idx & 63, dir = dg >> 4;
        const float lr = lamT[dg * 128 + pp], li = lamT[dg * 128 + 64 + pp];
        float hr = 0.f, hi = 0.f;
        const float* sb = SC + (size_t)dg * NCH * 128 + pp; float* hb = HIN + (size_t)dg * NCH * 128 + pp;
        for (int b0 = 0; b0 < NCH; b0 += 16) {
            float sr[16], si[16]; int cidx[16];
#pragma unroll
            for (int j = 0; j < 16; ++j) { const int q = b0 + j;
                const int c = dir == 0 ? q : (q < 16 ? 15 - q : NCH + 15 - q);
                cidx[j] = c; sr[j] = sb[(size_t)c * 128]; si[j] = sb[(size_t)c * 128 + 64]; }
#pragma unroll
            for (int j = 0; j < 16; ++j) { hb[(size_t)cidx[j] * 128] = hr; hb[(size_t)cidx[j] * 128 + 64] = hi;
                const float nr = lr * hr - li * hi + sr[j], ni = lr * hi + li * hr + si[j]; hr = nr; hi = ni; }
        }
    }
}
__device__ __forceinline__ void pc_attention(const int wave_s_, const P& p, LAS unsigned char* lds) { unsigned char* const wsb = lndp(p.ws); const int tidx_ = tid_of(wave_s_); const int bidx_ = lnds((int)blockIdx.x);
    const int tid = tidx_, lane = tid & 63, wave = tid >> 6, r32 = lane & 31, hi = lane >> 5;
    const bf16_t* U = (const bf16_t*)(wsb + WS_U); const bf16_t* QN = (const bf16_t*)(wsb + WS_QN); const bf16_t* KN = (const bf16_t*)(wsb + WS_KN); bf16_t* MG = (bf16_t*)(wsb + WS_MERGED);
    constexpr int RS = 72;
    LAS bf16_t* Ks = (LAS bf16_t*)lds;
    LAS bf16_t* Vs = Ks + 2 * 64 * RS;
    for (int unit = bidx_; unit < 260; unit += gridDim.x) {
        int kh, qb; if (unit < 256) { kh = unit & 1; qb = 2 + (unit >> 1); } else { kh = unit & 1; qb = (unit - 256) >> 1; }
        const int nt = qb < 2 ? 4 : 260;
        const int hq = kh * 2 + (wave >> 2); const int qrow = qb * 128 + (wave & 3) * 32 + r32;
        bf16x8 qr[4];
#pragma unroll
        for (int dk = 0; dk < 4; ++dk) qr[dk] = *(const bf16x8*)(QN + (size_t)qrow * 256 + hq * 64 + dk * 16 + hi * 8);
        f32x16 o0, o1;
#pragma unroll
        for (int i = 0; i < 16; ++i) { o0[i] = 0.f; o1[i] = 0.f; }
        float mrun = -1e30f, lsum = 0.f;
        const int lr = tid >> 3, lseg = (tid & 7) * 8;
        const bf16_t* kg = KN + (size_t)lr * 128 + kh * 64 + lseg; const bf16_t* vg = U + (size_t)lr * NIN + 1664 + kh * 64 + lseg;
        u32x4 kreg = *(const u32x4*)kg, vreg = *(const u32x4*)vg;
        __syncthreads();
        for (int t = 0; t < nt; ++t) {
            const int buf = t & 1;
            LAS bf16_t* Kb = Ks + buf * 64 * RS; LAS bf16_t* Vb = Vs + buf * 64 * RS;
            *(LAS u32x4*)(Kb + lr * RS + lseg) = kreg;
            { LAS bf16_t* vd = Vb + lseg * RS + lr;
              vd[0 * RS] = (bf16_t)(vreg.x & 0xffffu); vd[1 * RS] = (bf16_t)(vreg.x >> 16); vd[2 * RS] = (bf16_t)(vreg.y & 0xffffu); vd[3 * RS] = (bf16_t)(vreg.y >> 16);
              vd[4 * RS] = (bf16_t)(vreg.z & 0xffffu); vd[5 * RS] = (bf16_t)(vreg.z >> 16); vd[6 * RS] = (bf16_t)(vreg.w & 0xffffu); vd[7 * RS] = (bf16_t)(vreg.w >> 16); }
            if (t + 1 < nt) { kreg = *(const u32x4*)(kg + (size_t)(t + 1) * 64 * 128); vreg = *(const u32x4*)(vg + (size_t)(t + 1) * 64 * NIN); }
            __syncthreads();
            f32x16 p0, p1;
#pragma unroll
            for (int i = 0; i < 16; ++i) { p0[i] = 0.f; p1[i] = 0.f; }
#pragma unroll
            for (int dk = 0; dk < 4; ++dk) {
                const bf16x8 a0 = *(const LAS bf16x8*)(Kb + r32 * RS + dk * 16 + hi * 8);
                const bf16x8 a1 = *(const LAS bf16x8*)(Kb + (32 + r32) * RS + dk * 16 + hi * 8);
                p0 = __builtin_amdgcn_mfma_f32_32x32x16_bf16(a0, qr[dk], p0, 0, 0, 0);
                p1 = __builtin_amdgcn_mfma_f32_32x32x16_bf16(a1, qr[dk], p1, 0, 0, 0);
            }
            float mx = p0[0];
#pragma unroll
            for (int i = 1; i < 16; ++i) mx = fmaxf(mx, p0[i]);
#pragma unroll
            for (int i = 0; i < 16; ++i) mx = fmaxf(mx, p1[i]);
            mx = fmaxf(mx, __shfl_xor(mx, 32));
            const float mnew = fmaxf(mrun, mx); const float alpha = __builtin_amdgcn_exp2f(mrun - mnew); mrun = mnew;
            float ps = 0.f;
#pragma unroll
            for (int i = 0; i < 16; ++i) { p0[i] = __builtin_amdgcn_exp2f(p0[i] - mnew); p1[i] = __builtin_amdgcn_exp2f(p1[i] - mnew); ps += p0[i] + p1[i]; }
            lsum = lsum * alpha + ps;
#pragma unroll
            for (int i = 0; i < 16; ++i) { o0[i] *= alpha; o1[i] *= alpha; }
#pragma unroll
            for (int j = 0; j < 4; ++j) {
                const int half = j >> 1, jj = j & 1;
                u32x4 pb;
                if (half == 0) { pb.x = pk2(p0[8 * jj + 0], p0[8 * jj + 1]); pb.y = pk2(p0[8 * jj + 2], p0[8 * jj + 3]); pb.z = pk2(p0[8 * jj + 4], p0[8 * jj + 5]); pb.w = pk2(p0[8 * jj + 6], p0[8 * jj + 7]); }
                else { pb.x = pk2(p1[8 * jj + 0], p1[8 * jj + 1]); pb.y = pk2(p1[8 * jj + 2], p1[8 * jj + 3]); pb.z = pk2(p1[8 * jj + 4], p1[8 * jj + 5]); pb.w = pk2(p1[8 * jj + 6], p1[8 * jj + 7]); }
                const bf16x8 pf = __builtin_bit_cast(bf16x8, pb);
                const int kvo = half * 32 + jj * 16 + 4 * hi;
                { const u32x2 lo = *(const LAS u32x2*)(Vb + r32 * RS + kvo), hi2 = *(const LAS u32x2*)(Vb + r32 * RS + kvo + 8);
                  const u32x4 av = {lo.x, lo.y, hi2.x, hi2.y}; o0 = __builtin_amdgcn_mfma_f32_32x32x16_bf16(__builtin_bit_cast(bf16x8, av), pf, o0, 0, 0, 0); }
                { const u32x2 lo = *(const LAS u32x2*)(Vb + (32 + r32) * RS + kvo), hi2 = *(const LAS u32x2*)(Vb + (32 + r32) * RS + kvo + 8);
                  const u32x4 av = {lo.x, lo.y, hi2.x, hi2.y}; o1 = __builtin_amdgcn_mfma_f32_32x32x16_bf16(__builtin_bit_cast(bf16x8, av), pf, o1, 0, 0, 0); }
            }
        }
        lsum += __shfl_xor(lsum, 32);
        const float il = 1.0f / lsum;
        bf16_t* op = MG + (size_t)qrow * 1024 + 768 + hq * 64;
#pragma unroll
        for (int a = 0; a < 4; ++a) {
            u32x2 w; w.x = pk2(o0[4 * a] * il, o0[4 * a + 1] * il); w.y = pk2(o0[4 * a + 2] * il, o0[4 * a + 3] * il); *(u32x2*)(op + 8 * a + 4 * hi) = w;
            u32x2 w2; w2.x = pk2(o1[4 * a] * il, o1[4 * a + 1] * il); w2.y = pk2(o1[4 * a + 2] * il, o1[4 * a + 3] * il); *(u32x2*)(op + 32 + 8 * a + 4 * hi) = w2;
        }
        __syncthreads();
    }
}
__device__ __forceinline__ void fft_fwd(LAS f32x2* buf, const f32x2* tw, int tid) {
    for (int s = 0; s < 7; ++s) {
        const int lq = 12 - 2 * s, q = 1 << lq;
        __syncthreads();
#pragma unroll 2
        for (int i = 0; i < 8; ++i) { const int id = tid + 512 * i; const int j = id & (q - 1), blk = id >> lq; const int i0 = (blk << (lq + 2)) + j;
            const f32x2 a0 = buf[i0], a1 = buf[i0 + q], a2 = buf[i0 + 2 * q], a3 = buf[i0 + 3 * q];
            const f32x2 w1 = tw[j << (2 * s)]; const f32x2 w2 = cmul(w1, w1);
            const f32x2 b0 = a0 + a2, b2 = cmul(a0 - a2, w1), b1 = a1 + a3; const f32x2 t3 = cmul(a1 - a3, w1); const f32x2 b3 = {t3.y, -t3.x};
            buf[i0] = b0 + b1; buf[i0 + q] = cmul(b0 - b1, w2); buf[i0 + 2 * q] = b2 + b3; buf[i0 + 3 * q] = cmul(b2 - b3, w2); }
    }
    __syncthreads();
}
__device__ __forceinline__ void fft_inv(LAS f32x2* buf, const f32x2* tw, int tid) {
    for (int s = 6; s >= 0; --s) {
        const int lq = 12 - 2 * s, q = 1 << lq;
        __syncthreads();
#pragma unroll 2
        for (int i = 0; i < 8; ++i) { const int id = tid + 512 * i; const int j = id & (q - 1), blk = id >> lq; const int i0 = (blk << (lq + 2)) + j;
            const f32x2 c0 = buf[i0], c1 = buf[i0 + q], c2 = buf[i0 + 2 * q], c3 = buf[i0 + 3 * q];
            const f32x2 w1 = tw[j << (2 * s)]; const f32x2 w2 = cmul(w1, w1);
            const f32x2 t1 = cmulc(c1, w2), t3 = cmulc(c3, w2);
            const f32x2 b0 = c0 + t1, b1 = c0 - t1, b2 = c2 + t3, b3 = c2 - t3;
            const f32x2 u2 = cmulc(b2, w1); const f32x2 u3c = cmulc(b3, w1); const f32x2 u3 = {-u3c.y, u3c.x};
            buf[i0] = b0 + u2; buf[i0 + 2 * q] = b0 - u2; buf[i0 + q] = b1 + u3; buf[i0 + 3 * q] = b1 - u3; }
    }
    __syncthreads();
}
__device__ __forceinline__ int brev14(int k) { return (int)(__builtin_bitreverse32((unsigned)k) >> 18); }
__device__ __forceinline__ void pc_hyena(const int wave_s_, const P& p, int l, LAS unsigned char* lds) { unsigned char* const wsb = lndp(p.ws); const int tidx_ = tid_of(wave_s_); const int bidx_ = lnds((int)blockIdx.x);
    const int tid = tidx_;
    LAS f32x2* buf = (LAS f32x2*)lds;
    const f32x2* tw = (const f32x2*)(wsb + WS_TW);
    const bf16_t* VXT = (const bf16_t*)(wsb + WS_VXT); float* Z1 = (float*)(wsb + WS_Z1); bf16_t* Z2T = (bf16_t*)(wsb + WS_Z2T);
    for (int ch = bidx_; ch < 256; ch += gridDim.x) {
        for (int o = 0; o < 2; ++o) {
            float* filt = (float*)(wsb + WS_FILT) + (size_t)(ch * 2 + o) * 2 * LSEQ;
            const float* hf = filt; const float* hb = filt + LSEQ;
            __syncthreads();
            for (int m = tid; m < NFFT; m += 512) { f32x2 v;
                if (m < NFFT / 2) v = *(const f32x2*)(hf + 2 * m);
                else { const int r = 2 * LSEQ - 2 * m - 2; const f32x2 t = *(const f32x2*)(hb + r); v = (f32x2){m == NFFT / 2 ? 0.f : t.y, t.x}; }
                buf[m] = v; }
            fft_fwd(buf, tw, tid);
            f32x4* ksp = (f32x4*)filt;
            const float sc = 1.0f / (float)NFFT;
            for (int k = tid; k < NFFT / 2; k += 512) {
                if (k == 0) { const f32x2 a = buf[0], b = buf[1]; ksp[0] = (f32x4){a.x * sc, a.y * sc, b.x * sc, b.y * sc}; }
                else { const f32x2 A = buf[brev14(k)], B = cconj(buf[brev14(NFFT - k)]);
                    const f32x2 E = (A + B) * (0.5f * sc), D = (A - B) * (0.5f * sc); ksp[k] = (f32x4){E.x, E.y, D.y, -D.x}; }
            }
            __syncthreads();
            const bf16_t* zb = VXT + (size_t)ch * LSEQ; const float* z1 = Z1 + (size_t)ch * LSEQ;
            for (int m = tid; m < NFFT; m += 512) { f32x2 v = {0.f, 0.f};
                if (m < NFFT / 2) { if (o == 0) { const unsigned w = *(const unsigned*)(zb + 2 * m); v = (f32x2){bflo(w), bfhi(w)}; } else v = *(const f32x2*)(z1 + 2 * m); }
                buf[m] = v; }
            fft_fwd(buf, tw, tid);
            for (int k = tid; k < NFFT / 2; k += 512) {
                const f32x4 ks = ksp[k];
                if (k == 0) { const f32x2 a = buf[0], b = buf[1];
                    buf[0] = (f32x2){a.x * ks[0] + a.y * ks[1], a.x * ks[1] + a.y * ks[0]};
                    buf[1] = (f32x2){b.x * ks[2] - b.y * ks[3], b.x * ks[3] + b.y * ks[2]}; }
                else { const int p1 = brev14(k), p2 = brev14(NFFT - k); const f32x2 A = buf[p1], B = cconj(buf[p2]);
                    const f32x2 Ez = (A + B) * 0.5f, Dz = (A - B) * 0.5f; const f32x2 Oz = {Dz.y, -Dz.x};
                    const f32x2 Ek = {ks[0], ks[1]}, Ok = {ks[2], ks[3]};
                    const f32x2 Ey = cmul(Ez, Ek) + cmul(tw[k], cmul(Oz, Ok)); const f32x2 Oy = cmul(Ez, Ok) + cmul(Oz, Ek);
                    buf[p1] = (f32x2){Ey.x - Oy.y, Ey.y + Oy.x};
                    buf[p2] = (f32x2){Ey.x + Oy.y, Oy.x - Ey.y}; }
            }
            fft_inv(buf, tw, tid);
            const float fb = PIN(20)[(l * 2 + o) * 256 + ch];
            const bf16_t* gt = VXT + (size_t)((o + 1) * 256 + ch) * LSEQ;
            for (int m = tid; m < NFFT / 2; m += 512) { const f32x2 y = buf[m]; f32x2 zp;
                if (o == 0) { const unsigned w = *(const unsigned*)(zb + 2 * m); zp = (f32x2){bflo(w), bfhi(w)}; } else zp = *(const f32x2*)(z1 + 2 * m);
                const unsigned gw = *(const unsigned*)(gt + 2 * m);
                const f32x2 zn = {bflo(gw) * (y.x + fb * zp.x), bfhi(gw) * (y.y + fb * zp.y)};
                if (o == 0) *(f32x2*)(Z1 + (size_t)ch * LSEQ + 2 * m) = zn; else *(unsigned*)(Z2T + (size_t)ch * LSEQ + 2 * m) = pk2(zn.x, zn.y); }
            __syncthreads();
        }
    }
}

__device__ __forceinline__ float gelu_tanh(float x) { const float u = 0.7978845608028654f * (x + 0.044715f * x * x * x); return 0.5f * x * (1.0f + tanhf(u)); }
__device__ __forceinline__ void pd_s5out(const int wave_s_, const P& p) { unsigned char* const wsb = lndp(p.ws); const int tidx_ = tid_of(wave_s_); const int bidx_ = lnds((int)blockIdx.x);
    const int lane = tidx_ & 63, wave = tidx_ >> 6, gw = bidx_ * 8 + wave, NGW = gridDim.x * 8;
    const bf16_t* U = (const bf16_t*)(wsb + WS_U); const float* HIN = (const float*)(wsb + WS_HIN); bf16_t* GB = (bf16_t*)(wsb + WS_GBUF);
    const int m = lane & 15, kq = lane >> 4;
    for (int it = gw; it < 16 * 65; it += NGW) {
        const int g = it / 65, ct = it - g * 65;
        f32x4 acc[16];
#pragma unroll
        for (int n = 0; n < 16; ++n) acc[n] = (f32x4){0.f, 0.f, 0.f, 0.f};
        const int chunk = ct * 16 + m;
        for (int dir = 0; dir < 2; ++dir) {
            const int dg = dir * 16 + g;
            const bf16_t* KI = (const bf16_t*)(wsb + WS_S5M + (size_t)dg * 256 * KiB); const bf16_t* CC = KI + 65536 + 32768;
            for (int ks = 0; ks < 8; ++ks) { const int k0 = ks * 32 + 8 * kq;
                const bf16x8 a = *(const bf16x8*)(U + (size_t)(chunk * 16 + (k0 >> 4)) * NIN + 768 + g * 16 + (k0 & 15));
#pragma unroll
                for (int n = 0; n < 16; ++n) { const bf16x8 b = *(const bf16x8*)(KI + (size_t)(n * 16 + m) * 256 + k0); acc[n] = __builtin_amdgcn_mfma_f32_16x16x32_bf16(a, b, acc[n], 0, 0, 0); } }
            for (int ks = 0; ks < 4; ++ks) { const int k0 = ks * 32 + 8 * kq;
                const float* hp = HIN + ((size_t)dg * NCH + chunk) * 128 + k0; const f32x4 h0 = *(const f32x4*)hp, h1 = *(const f32x4*)(hp + 4);
                u32x4 aw; aw.x = pk2(h0[0], h0[1]); aw.y = pk2(h0[2], h0[3]); aw.z = pk2(h1[0], h1[1]); aw.w = pk2(h1[2], h1[3]);
                const bf16x8 a = __builtin_bit_cast(bf16x8, aw);
#pragma unroll
                for (int n = 0; n < 16; ++n) { const bf16x8 b = *(const bf16x8*)(CC + (size_t)(n * 16 + m) * 128 + k0); acc[n] = __builtin_amdgcn_mfma_f32_16x16x32_bf16(a, b, acc[n], 0, 0, 0); } }
        }
#pragma unroll
        for (int n = 0; n < 16; ++n)
#pragma unroll
            for (int i = 0; i < 4; ++i) { const int row = (ct * 16 + 4 * kq + i) * 16 + n; GB[(size_t)row * 256 + g * 16 + m] = (bf16_t)f2bf(gelu_tanh(acc[n][i])); }
    }
}
__device__ __forceinline__ void pd_hytrans(const int wave_s_, const P& p, LAS unsigned char* lds) { unsigned char* const wsb = lndp(p.ws); const int tidx_ = tid_of(wave_s_); const int bidx_ = lnds((int)blockIdx.x);
    const int tid = tidx_;
    const bf16_t* Z2T = (const bf16_t*)(wsb + WS_Z2T); bf16_t* MG = (bf16_t*)(wsb + WS_MERGED);
    LAS bf16_t* tile = (LAS bf16_t*)lds;
    for (int item = bidx_; item < 256 * 4; item += gridDim.x) {
        const int c0 = (item & 3) * 64, t0 = (item >> 2) * 64;
        __syncthreads();
        { const int c = tid >> 3, t8 = (tid & 7) * 8; const u32x4 w = *(const u32x4*)(Z2T + (size_t)(c0 + c) * LSEQ + t0 + t8);
          LAS unsigned* d = (LAS unsigned*)(tile + c * 66 + t8); d[0] = w.x; d[1] = w.y; d[2] = w.z; d[3] = w.w; }
        __syncthreads();
        { const int t = tid >> 3, c8 = (tid & 7) * 8; unsigned short e[8];
#pragma unroll
          for (int i = 0; i < 8; ++i) e[i] = tile[(c8 + i) * 66 + t];
          u32x4 w; w.x = e[0] | ((unsigned)e[1] << 16); w.y = e[2] | ((unsigned)e[3] << 16); w.z = e[4] | ((unsigned)e[5] << 16); w.w = e[6] | ((unsigned)e[7] << 16);
          *(u32x4*)(MG + (size_t)(LCTX + t0 + t) * 1024 + c0 + c8) = w; }
    }
    __syncthreads();
}
__device__ __forceinline__ void pd2_glu(const int wave_s_, const P& p, int l) { unsigned char* const wsb = lndp(p.ws); const int tidx_ = tid_of(wave_s_); const int bidx_ = lnds((int)blockIdx.x);
    const int lane = tidx_ & 63, wave = tidx_ >> 6, gw = bidx_ * 8 + wave, NGW = gridDim.x * 8, r32 = lane & 31, hi = lane >> 5;
    const bf16_t* GB = (const bf16_t*)(wsb + WS_GBUF); const bf16_t* GLUT = (const bf16_t*)(wsb + WS_GLUT); bf16_t* MG = (bf16_t*)(wsb + WS_MERGED);
    const float* gb = PIN(30) + l * 256;
    for (int it = gw; it < 520 * 8; it += NGW) {
        const int rt = it >> 3, ct = it & 7;
        f32x16 acc;
#pragma unroll
        for (int i = 0; i < 16; ++i) acc[i] = 0.f;
        for (int ks = 0; ks < 16; ++ks) { const int k0 = ks * 16 + 8 * hi;
            const bf16x8 a = *(const bf16x8*)(GB + (size_t)(rt * 32 + r32) * 256 + k0); const bf16x8 b = *(const bf16x8*)(GLUT + (size_t)(ct * 32 + r32) * 256 + k0);
            acc = __builtin_amdgcn_mfma_f32_32x32x16_bf16(a, b, acc, 0, 0, 0); }
        const int col = ct * 32 + r32; const float bias = gb[col];
#pragma unroll
        for (int i = 0; i < 16; ++i) { const int row = rt * 32 + (i & 3) + 8 * (i >> 2) + 4 * hi; const float gv = bf1(GB[(size_t)row * 256 + col]);
            const float sg = 1.0f / (1.0f + expf(-(acc[i] + bias))); MG[(size_t)row * 1024 + 256 + col] = (bf16_t)f2bf(gv * sg); }
    }
}

__device__ __forceinline__ void grid_bar(unsigned* ctr, unsigned target, int tid) {
    asm volatile("s_waitcnt vmcnt(0) lgkmcnt(0)" ::: "memory");
    __syncthreads();
    if (tid == 0) {
        __builtin_amdgcn_fence(__ATOMIC_RELEASE, "agent");
        asm volatile("s_waitcnt vmcnt(0)" ::: "memory");
        __hip_atomic_fetch_add(ctr, 1u, __ATOMIC_RELAXED, __HIP_MEMORY_SCOPE_AGENT);
        while (__hip_atomic_load(ctr, __ATOMIC_RELAXED, __HIP_MEMORY_SCOPE_AGENT) < target) __builtin_amdgcn_s_sleep(2);
        __builtin_amdgcn_fence(__ATOMIC_ACQUIRE, "agent");
        asm volatile("s_waitcnt vmcnt(0)" ::: "memory");
    }
    __syncthreads();
}
#define PH_BEGIN if (ph >= lo && ph < hi) { unsigned char* const wsb = lndp(p.ws); const int tidx_ = tid_of(wave_s_); const int bidx_ = lnds((int)blockIdx.x); (void)tidx_; (void)bidx_;
#define PH_END   if (ph + 1 < hi) { ++nbar; grid_bar((unsigned*)(lndp(p.ws) + WS_BAR), (unsigned)nbar * gridDim.x, tid_of(wave_s_)); } } ++ph;
#define PH_END0  if (ph + 1 < hi) grid.sync(); } ++ph;
template <int l> __device__ __forceinline__ void layer_phases(const int wave_s_, const P& p, LAS unsigned char* lds, const int lo, const int hi, int& ph, int& nbar) {

        PH_BEGIN
            { float* ss1 = (float*)(wsb + WS_SS1); float* ss2 = (float*)(wsb + WS_SS2); const int t0_ = tid_of(wave_s_);
              for (int i = bidx_ * 512 + t0_; i < R; i += gridDim.x * 512) { ss1[i] = 0.f; ss2[i] = 0.f; } }
            { pg8::Gemm g{(const pg8::bf16_t*)(wsb + WS_H), (const pg8::bf16_t*)(wsb + WS_WIN), R, NIN, DM, tidx_}; pg8::StaticOrder S; S.init(R, NIN, gridDim.x, bidx_);
              pg8::EpiBf16<0> E{(pg8::bf16_t*)(wsb + WS_U), NIN};
              pg8::gemm_phase<pg8::EpiBf16<0>, pg8::StaticOrder, true, true>(lds, g, S, E); }
            __syncthreads();
            { pg8::Gemm g{(const pg8::bf16_t*)(wsb + WS_H2L), (const pg8::bf16_t*)(wsb + WS_W3T), LSEQ, 1024, 128, tid_of(wave_s_)}; pg8::StaticOrder S; S.init(LSEQ, 1024, gridDim.x, bidx_);
              pg8::EpiFilt E{(float*)(wsb + WS_FILT), PIN(19) + l * 1024};
              pg8::gemm_phase<pg8::EpiFilt, pg8::StaticOrder, false, false>(lds, g, S, E); }
            __syncthreads();
        PH_END
        PH_BEGIN
            pb_attprep(wave_s_, p, l); pb_s5local(wave_s_, p); pb_pool(wave_s_, p, l, lds); pb_shortconv(wave_s_, p, l, lds); pb_ctxhyena(wave_s_, p, l, lds);
        PH_END
        PH_BEGIN
            pc_s5carry(wave_s_, p); pc_attention(wave_s_, p, lds); pc_hyena(wave_s_, p, l, lds);
        PH_END
        PH_BEGIN
            pd_s5out(wave_s_, p); pd_hytrans(wave_s_, p, lds);
        PH_END
        PH_BEGIN
            pd2_glu(wave_s_, p, l);
        PH_END
        PH_BEGIN
            { pg8::Gemm g{(const pg8::bf16_t*)(wsb + WS_MERGED), (const pg8::bf16_t*)(wsb + WS_WOUT), R, DM, DM, tidx_}; pg8::StaticOrder S; S.init(R, DM, gridDim.x, bidx_);
              pg8::EpiSumsq E{(pg8::bf16_t*)(wsb + WS_OL), DM, (float*)(wsb + WS_SS1)};
              pg8::gemm_phase<pg8::EpiSumsq, pg8::StaticOrder, true, true>(lds, g, S, E); }
            __syncthreads();
        PH_END
        PH_BEGIN
            ew_phase(wave_s_, p, 1, l);
        PH_END
        PH_BEGIN
            { pg8::Gemm g{(const pg8::bf16_t*)(wsb + WS_H), (const pg8::bf16_t*)(wsb + WS_W1), R, FF, DM, tidx_}; pg8::StaticOrder S; S.init(R, FF, gridDim.x, bidx_);
              pg8::EpiBf16<1> E{(pg8::bf16_t*)(wsb + WS_HID), FF};
              pg8::gemm_phase<pg8::EpiBf16<1>, pg8::StaticOrder, true, true>(lds, g, S, E); }
            __syncthreads();
        PH_END
        PH_BEGIN
            { pg8::Gemm g{(const pg8::bf16_t*)(wsb + WS_HID), (const pg8::bf16_t*)(wsb + WS_W2), R, DM, FF, tidx_}; pg8::StaticOrder S; S.init(R, DM, gridDim.x, bidx_);
              pg8::EpiSumsq E{(pg8::bf16_t*)(wsb + WS_OL), DM, (float*)(wsb + WS_SS2)};
              pg8::gemm_phase<pg8::EpiSumsq, pg8::StaticOrder, true, true>(lds, g, S, E); }
            __syncthreads();
        PH_END
        PH_BEGIN
            ew_phase(wave_s_, p, 2, l);
            if (l + 1 < NLAYER) prep_layer(wave_s_, p, l + 1, lds);
        PH_END
    }
__global__ void __launch_bounds__(512) mega_fwd(P p) {
    extern __shared__ __attribute__((aligned(16))) unsigned char lds_raw[];
    LAS unsigned char* lds = (LAS unsigned char*)lds_raw;
    cg::grid_group grid = cg::this_grid();
    const int wave_s_ = __builtin_amdgcn_readfirstlane((int)threadIdx.x >> 6);
    const int lo = p.lo, hi = p.hi;
    int ph = 0, nbar = 0;
    PH_BEGIN
        pro_mod(wave_s_, p, lds); pro_tables(wave_s_, p); prep_layer(wave_s_, p, 0, lds);
    PH_END0
    PH_BEGIN
        ew_phase(wave_s_, p, 0, 0);
    PH_END
    layer_phases<0>(wave_s_, p, lds, lo, hi, ph, nbar);
    layer_phases<1>(wave_s_, p, lds, lo, hi, ph, nbar);
    layer_phases<2>(wave_s_, p, lds, lo, hi, ph, nbar);
    layer_phases<3>(wave_s_, p, lds, lo, hi, ph, nbar);
#undef PH_BEGIN
#undef PH_END
#undef PH_END0
}
constexpr int N_PHASES = 2 + NLAYER * 10;

#ifndef MK_MULTI
#define MK_MULTI 0
#endif
extern "C" void kernel_launch(void* const* d_in, const int* in_sizes, int n_in, void* d_out, int out_size, void* d_ws, size_t ws_size, hipStream_t stream) {
    static int grid = 0;
    if (grid == 0) {
        if (n_in != 37 || out_size != LSEQ * DM || ws_size < WS_END) { fprintf(stderr, "kernel_launch: unexpected shapes (n_in %d out %d ws %zu)\n", n_in, out_size, ws_size); grid = -1; return; }
        int dev = 0, cus = 0, per_cu = 0;
        (void)hipGetDevice(&dev); (void)hipDeviceGetAttribute(&cus, hipDeviceAttributeMultiprocessorCount, dev);
        if (hipFuncSetAttribute((const void*)mega_fwd, hipFuncAttributeMaxDynamicSharedMemorySize, LDS_BYTES) != hipSuccess) { fprintf(stderr, "kernel_launch: hipFuncSetAttribute failed\n"); grid = -1; return; }
        if (hipOccupancyMaxActiveBlocksPerMultiprocessor(&per_cu, (const void*)mega_fwd, 512, LDS_BYTES) != hipSuccess || per_cu < 1) { fprintf(stderr, "kernel_launch: occupancy query gave %d\n", per_cu); per_cu = 1; }
        (void)hipGetLastError();
        grid = cus * 1;
        if (grid <= 0) grid = 256;
    }
    if (grid < 0) return;
    (void)hipMemsetAsync((unsigned char*)d_ws + WS_BAR, 0, 256, stream);
    P a{};
    for (int i = 0; i < 37; ++i) a.in[i] = (const float*)d_in[i];
    a.out = (float*)d_out; a.ws = (unsigned char*)d_ws;
#if MK_MULTI
    for (int ph = 0; ph < N_PHASES; ++ph) { a.lo = ph; a.hi = ph + 1; hipLaunchKernelGGL(mega_fwd, dim3(grid), dim3(512), LDS_BYTES, stream, a); }
#else
    a.lo = 0; a.hi = N_PHASES;
    void* args[] = {&a};
    hipError_t e = hipLaunchCooperativeKernel((const void*)mega_fwd, dim3(grid), dim3(512), args, LDS_BYTES, stream);
    if (e != hipSuccess) fprintf(stderr, "cooperative launch failed: %s (grid %d)\n", hipGetErrorString(e), grid);
#endif
}
```

```cpp
#include <hip/hip_runtime.h>
#include <hip/hip_cooperative_groups.h>
#include <cstdio>
#include <cstdint>
namespace cg = cooperative_groups;

__device__ __forceinline__ int lndv(int i) { asm volatile("" : "+v"(i)); return i; }
__device__ __forceinline__ int lnds(int i) { asm volatile("" : "+v"(i)); return __builtin_amdgcn_readfirstlane(i); }
__device__ __forceinline__ int tid_of(int wave_s) { int z = 0; asm volatile("" : "+v"(z)); return (wave_s << 6) + (int)__builtin_amdgcn_mbcnt_hi(~0u, __builtin_amdgcn_mbcnt_lo(~0u, (unsigned)z)); }
namespace pg8 {
#define PG8_LAS __attribute__((address_space(3)))
typedef unsigned short bf16_t;
typedef short bf16x8 __attribute__((ext_vector_type(8)));
typedef float f32x4 __attribute__((ext_vector_type(4)));
typedef unsigned u32x4 __attribute__((ext_vector_type(4)));
constexpr int BM = 256, BK = 64, HALF = 128, HTB = HALF * BK * 2  , STAGE_BYTES = 8 * HTB, NXCD = 8, WGM = 8;

__host__ __device__ __forceinline__ int lds_byte(int r, int c) { const int st = (r >> 4) * 2 + (c >> 5), rr = r & 15, cc = c & 31, ob = rr * 64 + cc * 2; return st * 1024 + (ob ^ (((ob >> 9) & 1) << 5)); }
__host__ __device__ __forceinline__ void stage_rc(int b, int& R, int& C) { const int st = b / 1024, sb = b % 1024, swz = sb ^ (((sb >> 9) & 1) << 5); R = (st >> 1) * 16 + swz / 64; C = (st & 1) * 32 + (swz % 64) / 2; }
__host__ __device__ __forceinline__ int perm32(int rho) { const int n = rho >> 4, i = rho & 15; return 8 * (i >> 2) + 4 * n + (i & 3); }

struct Unit { int pm, pn; };
struct Gemm { const bf16_t* A; const bf16_t* Bt; int M, N, K, tid; };

struct StaticOrder {
    int nM, nN, nwg, G, c;
    __host__ __device__ void init(int M, int N, int G_, int c_) { nM = M / BM; nN = N / BM; nwg = nM * nN; G = G_; c = c_; }
    __host__ __device__ bool next(int i, Unit& u) const {
        const long L = (long)i * G + c; if (L >= nwg) return false;
        int wgid = (int)L; { const int q = nwg / NXCD, r = nwg % NXCD, xcd = wgid % NXCD, off = wgid / NXCD; wgid = (xcd < r ? xcd * (q + 1) : r * (q + 1) + (xcd - r) * q) + off; }
        const int nig = WGM * nN, gid = wgid / nig, fm = gid * WGM, gsz = (nM - fm) < WGM ? (nM - fm) : WGM;
        u.pm = fm + ((wgid % nig) % gsz); u.pn = (wgid % nig) / gsz; return true;
    }
    __device__ __forceinline__ void a_ready(const Unit&) const {}
    __device__ __forceinline__ void done(const Unit&) const {}
};

__device__ __forceinline__ unsigned cvt_pk_bf16(float lo, float hi) { unsigned r; asm volatile("v_cvt_pk_bf16_f32 %0, %1, %2" : "=v"(r) : "v"(lo), "v"(hi)); return r; }

template <int ACT> struct EpiBf16 {
    static constexpr bool PERM = true, AFTER_DRAIN = false;
    bf16_t* O; int ldc;
    __device__ __forceinline__ void operator()(const f32x4 (&acc)[2][2][4][2], const Unit& u, int wr, int wc, int fr, int fq) const {
        const int row0 = u.pm * BM + wr * 64 + fr, col0 = u.pn * BM + wc * 32 + 8 * fq;
#pragma unroll
        for (int ai = 0; ai < 2; ++ai)
#pragma unroll
            for (int m = 0; m < 4; ++m) { bf16_t* rowp = O + (size_t)(row0 + ai * HALF + m * 16) * ldc + col0;
#pragma unroll
                for (int bj = 0; bj < 2; ++bj) { f32x4 v0 = acc[ai][bj][m][0], v1 = acc[ai][bj][m][1];
                    if (ACT == 1) {
#pragma unroll
                        for (int e = 0; e < 4; ++e) { float a = v0[e] > 0.f ? v0[e] : 0.f; v0[e] = a * a; float b = v1[e] > 0.f ? v1[e] : 0.f; v1[e] = b * b; } }
                    u32x4 w; w.x = cvt_pk_bf16(v0[0], v0[1]); w.y = cvt_pk_bf16(v0[2], v0[3]); w.z = cvt_pk_bf16(v1[0], v1[1]); w.w = cvt_pk_bf16(v1[2], v1[3]);
                    *(u32x4*)(rowp + bj * HALF) = w; } }
    }
};
struct EpiSumsq {
    static constexpr bool PERM = true, AFTER_DRAIN = false;
    bf16_t* O; int ldc; float* ss;
    __device__ __forceinline__ void operator()(const f32x4 (&acc)[2][2][4][2], const Unit& u, int wr, int wc, int fr, int fq) const {
        const int row0 = u.pm * BM + wr * 64 + fr, col0 = u.pn * BM + wc * 32 + 8 * fq;
#pragma unroll
        for (int ai = 0; ai < 2; ++ai)
#pragma unroll
            for (int m = 0; m < 4; ++m) { const int row = row0 + ai * HALF + m * 16; bf16_t* rowp = O + (size_t)row * ldc + col0; float s = 0.f;
#pragma unroll
                for (int bj = 0; bj < 2; ++bj) { const f32x4 v0 = acc[ai][bj][m][0], v1 = acc[ai][bj][m][1];
                    s += (v0[0] * v0[0] + v0[1] * v0[1]) + (v0[2] * v0[2] + v0[3] * v0[3]) + (v1[0] * v1[0] + v1[1] * v1[1]) + (v1[2] * v1[2] + v1[3] * v1[3]);
                    u32x4 w; w.x = cvt_pk_bf16(v0[0], v0[1]); w.y = cvt_pk_bf16(v0[2], v0[3]); w.z = cvt_pk_bf16(v1[0], v1[1]); w.w = cvt_pk_bf16(v1[2], v1[3]);
                    *(u32x4*)(rowp + bj * HALF) = w; }
                s += __shfl_xor(s, 16); s += __shfl_xor(s, 32);
                if (fq == 0) atomicAdd(ss + row, s); }
    }
};
struct EpiFilt {
    static constexpr bool PERM = false, AFTER_DRAIN = false;
    float* F; const float* decay;
    __device__ __forceinline__ void operator()(const f32x4 (&acc)[2][2][4][2], const Unit& u, int wr, int wc, int fr, int fq) const {
        const int row0 = u.pm * BM + wr * 64 + fr, col0 = u.pn * BM + wc * 32 + 4 * fq;
#pragma unroll
        for (int bj = 0; bj < 2; ++bj)
#pragma unroll
            for (int n = 0; n < 2; ++n) {
                const int cb = col0 + bj * HALF + n * 16;
                const f32x4 dc = *(const f32x4*)(decay + cb);
#pragma unroll
                for (int e = 0; e < 4; ++e) { const int col = cb + e; const float ad = __builtin_fabsf(dc[e]);
                    float* fp = F + (size_t)((((col & 255) * 2 + (col >> 9)) * 2) + ((col >> 8) & 1)) * 16384;
#pragma unroll
                    for (int ai = 0; ai < 2; ++ai)
#pragma unroll
                        for (int m = 0; m < 4; ++m) { const int r = row0 + ai * HALF + m * 16; const float t = (float)r * (1.0f / 16384.0f);
                            fp[r] = acc[ai][bj][m][n][e] * expf(-t * ad); } } }
    }
};

template <class Epi, class Sched, bool ALIGN_EPI = false, bool SP2 = false>
__device__ __forceinline__ void gemm_phase(PG8_LAS unsigned char* lds, const Gemm g, const Sched& S, const Epi& E) {
    const int tid = g.tid, wid = __builtin_amdgcn_readfirstlane(tid >> 6), lane = tid & 63, wr = wid >> 2, wc = wid & 3, fr = lane & 15, fq = lane >> 4;
    const int K = g.K, nt = K / BK;
    unsigned voffA[2], voffB[2];
#pragma unroll
    for (int i = 0; i < 2; ++i) { int R, C; stage_rc(tid * 16 + i * 8192, R, C); const int Rb = Epi::PERM ? ((R & ~31) + perm32(R & 31)) : R;
        voffA[i] = (unsigned)(R * K + C) * 2u; voffB[i] = (unsigned)(Rb * K + C) * 2u; }
    const size_t kstep = (size_t)(BK * 2);
    const size_t hstep = (size_t)HALF * K * 2;
    const size_t tstep = 2 * hstep;
    const unsigned ldsw = (unsigned)wid * 1024u;
    const int aoff = lds_byte(wr * 64 + fr, fq * 8), boff = lds_byte(wc * 32 + fr, fq * 8);
#define PG8_SA(b, h) (((b) * 2 + (h)) * HTB)
#define PG8_SB(b, h) ((4 + (b) * 2 + (h)) * HTB)
#define PG8_STAGE(bufoff, gbase, voff) do { _Pragma("unroll") for (int _i = 0; _i < 2; ++_i) \
        __builtin_amdgcn_global_load_lds((const unsigned*)((const char*)(gbase) + (voff)[_i]), (PG8_LAS unsigned*)(lds + (bufoff) + ldsw + _i * 8192), 16, 0, 0); } while (0)
#define PG8_LDA(dst, b, h) do { _Pragma("unroll") for (int m = 0; m < 4; ++m) _Pragma("unroll") for (int k = 0; k < 2; ++k) dst[m][k] = *(const PG8_LAS bf16x8*)(lds + PG8_SA(b, h) + aoff + m * 2048 + k * 1024); } while (0)
#define PG8_LDB(dst, b, h) do { _Pragma("unroll") for (int n = 0; n < 2; ++n) _Pragma("unroll") for (int k = 0; k < 2; ++k) dst[n][k] = *(const PG8_LAS bf16x8*)(lds + PG8_SB(b, h) + boff + n * 2048 + k * 1024); } while (0)
#define PG8_MMA(ai, bj, At, Bt) do { __builtin_amdgcn_s_setprio(1); _Pragma("unroll") for (int m = 0; m < 4; ++m) _Pragma("unroll") for (int n = 0; n < 2; ++n) _Pragma("unroll") for (int k = 0; k < 2; ++k) \
        acc[ai][bj][m][n] = __builtin_amdgcn_mfma_f32_16x16x32_bf16(Bt[n][k], At[m][k], acc[ai][bj][m][n], 0, 0, 0); __builtin_amdgcn_s_setprio(0); } while (0)
#define PG8_WAIT_V(n) asm volatile("s_waitcnt vmcnt(" #n ")" ::: "memory")
#define PG8_WAIT_L(n) asm volatile("s_waitcnt lgkmcnt(" #n ")" ::: "memory")
#define PG8_BAR __builtin_amdgcn_s_barrier()
#define PG8_SCHED __builtin_amdgcn_sched_barrier(0)
    Unit cur, nxt; int ui = 0;
    if (!S.next(0, cur)) return;
    f32x4 acc[2][2][4][2];
#pragma unroll
    for (int a = 0; a < 2; ++a)
#pragma unroll
        for (int b = 0; b < 2; ++b)
#pragma unroll
            for (int m = 0; m < 4; ++m)
#pragma unroll
                for (int n = 0; n < 2; ++n) acc[a][b][m][n] = (f32x4){0.f, 0.f, 0.f, 0.f};
    bf16x8 At[4][2], B0[2][2], B1[2][2];
    const char* cA = (const char*)g.A + (size_t)cur.pm * tstep; const char* cB = (const char*)g.Bt + (size_t)cur.pn * tstep;
    S.a_ready(cur);
    if constexpr (SP2) {
        PG8_STAGE(PG8_SB(0, 0), cB, voffB); PG8_STAGE(PG8_SB(0, 1), cB + hstep, voffB); PG8_STAGE(PG8_SA(0, 0), cA, voffA); PG8_STAGE(PG8_SA(0, 1), cA + hstep, voffA);
        if (wr == 1) PG8_BAR;
        PG8_WAIT_V(2); PG8_BAR;
        PG8_STAGE(PG8_SB(1, 0), cB + kstep, voffB); PG8_STAGE(PG8_SA(1, 0), cA + kstep, voffA); PG8_STAGE(PG8_SB(1, 1), cB + hstep + kstep, voffB);
        PG8_WAIT_V(6); PG8_BAR;
    } else {
        PG8_STAGE(PG8_SB(0, 0), cB, voffB); PG8_STAGE(PG8_SA(0, 0), cA, voffA); PG8_STAGE(PG8_SB(0, 1), cB + hstep, voffB); PG8_STAGE(PG8_SA(0, 1), cA + hstep, voffA);
        if (wr == 1) PG8_BAR;
        PG8_WAIT_V(4); PG8_BAR;
        PG8_STAGE(PG8_SB(1, 0), cB + kstep, voffB); PG8_STAGE(PG8_SA(1, 0), cA + kstep, voffA); PG8_STAGE(PG8_SB(1, 1), cB + hstep + kstep, voffB);
        PG8_WAIT_V(6); PG8_BAR;
    }
    for (;;) {
        const bool has_next = S.next(ui + 1, nxt);
        const char* nA = has_next ? (const char*)g.A + (size_t)nxt.pm * tstep : cA; const char* nB = has_next ? (const char*)g.Bt + (size_t)nxt.pn * tstep : cB;
        for (int t = 0; t < nt; t += 2) {
            const bool last = (t == nt - 2);
            const char* a1 = cA + (size_t)(t + 1) * kstep;
            const char* a2 = last ? nA : cA + (size_t)(t + 2) * kstep; const char* b2 = last ? nB : cB + (size_t)(t + 2) * kstep;
            const char* a3 = a2 + kstep; const char* b3 = b2 + kstep;
            if (last && has_next) S.a_ready(nxt);
            if constexpr (SP2) {
            PG8_LDB(B0, 0, 0); PG8_LDB(B1, 0, 1); PG8_SCHED; PG8_LDA(At, 0, 0); PG8_STAGE(PG8_SA(1, 1), a1 + hstep, voffA);
            PG8_WAIT_V(8); PG8_WAIT_L(0); PG8_BAR; PG8_MMA(0, 0, At, B0); PG8_MMA(0, 1, At, B1); PG8_BAR; PG8_SCHED;
            PG8_LDA(At, 0, 1); PG8_STAGE(PG8_SB(0, 0), b2, voffB); PG8_STAGE(PG8_SB(0, 1), b2 + hstep, voffB); PG8_STAGE(PG8_SA(0, 0), a2, voffA);
            PG8_WAIT_V(8); PG8_WAIT_L(0); PG8_BAR; PG8_MMA(1, 0, At, B0); PG8_MMA(1, 1, At, B1); PG8_BAR; PG8_SCHED;
            PG8_LDB(B0, 1, 0); PG8_LDB(B1, 1, 1); PG8_SCHED; PG8_LDA(At, 1, 0); PG8_STAGE(PG8_SA(0, 1), a2 + hstep, voffA);
            PG8_WAIT_V(8); PG8_WAIT_L(0); PG8_BAR; PG8_MMA(0, 0, At, B0); PG8_MMA(0, 1, At, B1); PG8_BAR; PG8_SCHED;
            PG8_LDA(At, 1, 1); PG8_STAGE(PG8_SB(1, 0), b3, voffB); PG8_STAGE(PG8_SB(1, 1), b3 + hstep, voffB); PG8_STAGE(PG8_SA(1, 0), a3, voffA);
            PG8_WAIT_V(8); PG8_WAIT_L(0); PG8_BAR; PG8_MMA(1, 0, At, B0); PG8_MMA(1, 1, At, B1); PG8_BAR; PG8_SCHED;
            } else {
            PG8_LDB(B0, 0, 0); PG8_SCHED; PG8_LDA(At, 0, 0); PG8_STAGE(PG8_SA(1, 1), a1 + hstep, voffA);
            PG8_WAIT_L(8); PG8_BAR; PG8_WAIT_L(0); PG8_MMA(0, 0, At, B0); PG8_BAR; PG8_SCHED;
            PG8_LDB(B1, 0, 1); PG8_STAGE(PG8_SB(0, 0), b2, voffB);
            PG8_BAR; PG8_WAIT_L(0); PG8_MMA(0, 1, At, B1); PG8_BAR;
            PG8_LDA(At, 0, 1); PG8_STAGE(PG8_SA(0, 0), a2, voffA);
            PG8_BAR; PG8_WAIT_L(0); PG8_MMA(1, 0, At, B0); PG8_BAR; PG8_SCHED;
            PG8_STAGE(PG8_SB(0, 1), b2 + hstep, voffB);
            PG8_WAIT_V(6); PG8_BAR; PG8_MMA(1, 1, At, B1); PG8_BAR;
            PG8_LDB(B0, 1, 0); PG8_SCHED; PG8_LDA(At, 1, 0); PG8_STAGE(PG8_SA(0, 1), a2 + hstep, voffA);
            PG8_WAIT_L(8); PG8_BAR; PG8_WAIT_L(0); PG8_MMA(0, 0, At, B0); PG8_BAR; PG8_SCHED;
            PG8_LDB(B1, 1, 1); PG8_STAGE(PG8_SB(1, 0), b3, voffB);
            PG8_BAR; PG8_WAIT_L(0); PG8_MMA(0, 1, At, B1); PG8_BAR;
            PG8_LDA(At, 1, 1); PG8_STAGE(PG8_SA(1, 0), a3, voffA);
            PG8_BAR; PG8_WAIT_L(0); PG8_MMA(1, 0, At, B0); PG8_BAR; PG8_SCHED;
            PG8_STAGE(PG8_SB(1, 1), b3 + hstep, voffB);
            PG8_WAIT_V(6); PG8_BAR; PG8_MMA(1, 1, At, B1); PG8_BAR;
            }
        }
        if constexpr (ALIGN_EPI) { if (wr == 0) PG8_BAR; }
        if constexpr (!Epi::AFTER_DRAIN) { E(acc, cur, wr, wc, fr, fq); S.done(cur); }
        if (!has_next) break;
#pragma unroll
        for (int a = 0; a < 2; ++a)
#pragma unroll
            for (int b = 0; b < 2; ++b)
#pragma unroll
                for (int m = 0; m < 4; ++m)
#pragma unroll
                    for (int n = 0; n < 2; ++n) acc[a][b][m][n] = (f32x4){0.f, 0.f, 0.f, 0.f};
        cur = nxt; cA = nA; cB = nB; ++ui;
        if constexpr (ALIGN_EPI) { if (wr == 1) PG8_BAR; }
    }
    PG8_WAIT_V(0);
    if constexpr (!ALIGN_EPI) { if (wr == 0) PG8_BAR; }
    PG8_BAR;
    if constexpr (Epi::AFTER_DRAIN) { E.fused(acc, cur, wr, wc, fr, fq, lds, wid, lane); S.done(cur); }
#undef PG8_SA
#undef PG8_SB
#undef PG8_STAGE
#undef PG8_LDA
#undef PG8_LDB
#undef PG8_MMA
#undef PG8_WAIT_V
#undef PG8_WAIT_L
#undef PG8_BAR
#undef PG8_SCHED
}
}
#define LAS __attribute__((address_space(3)))
typedef unsigned short bf16_t;
typedef short bf16x8 __attribute__((ext_vector_type(8)));
typedef float f32x4 __attribute__((ext_vector_type(4)));
typedef float f32x2 __attribute__((ext_vector_type(2)));
typedef float f32x16 __attribute__((ext_vector_type(16)));
typedef unsigned u32x4 __attribute__((ext_vector_type(4)));
typedef unsigned u32x2 __attribute__((ext_vector_type(2)));

constexpr int LCTX = 256, LSEQ = 16384, R = LCTX + LSEQ;
constexpr int DM = 1024, NIN = 1792, FF = 4096, NLAYER = 4;
constexpr int NFFT = 16384;
constexpr int NCH = R / 16;
constexpr float EPS = 1e-6f;
constexpr float QSCALE = 0.125f * 1.4426950408889634f;
constexpr size_t KiB = 1024, MiB = 1024 * 1024;
constexpr size_t WS_SS1 = 0, WS_SS2 = 128 * KiB, WS_MODV = 256 * KiB, WS_TW = 512 * KiB, WS_LAMT = 640 * KiB, WS_H2C = 704 * KiB;
constexpr size_t WS_BAR = 768 * KiB;
constexpr size_t WS_XC = 1 * MiB;
constexpr size_t WS_WIN = 2 * MiB, WS_WOUT = 6 * MiB, WS_W1 = 8 * MiB, WS_W2 = 16 * MiB, WS_W3T = 24 * MiB, WS_GLUT = 24 * MiB + 512 * KiB;
constexpr size_t WS_S5M = 25 * MiB;
constexpr size_t WS_H2L = 34 * MiB;
constexpr size_t WS_H = 38 * MiB;
constexpr size_t WS_VXT = 38 * MiB, WS_Z2T = 62 * MiB;
constexpr size_t WS_OL = 71 * MiB;
constexpr size_t WS_SC = 71 * MiB, WS_HIN = WS_SC + (size_t)32 * NCH * 128 * 4;
constexpr size_t WS_U = 104 * MiB, WS_MERGED = 161 * MiB, WS_QN = 194 * MiB, WS_GBUF = WS_QN, WS_KN = 203 * MiB, WS_FILT = 208 * MiB, WS_Z1 = 272 * MiB;
constexpr size_t WS_HID = 104 * MiB;
constexpr size_t WS_ROPE = 288 * MiB;
constexpr size_t WS_END = 292 * MiB;
constexpr int LDS_BYTES = 132 * 1024;

struct P { const float* in[37]; float* out; unsigned char* ws; int lo, hi; };
__device__ __forceinline__ int lnd(int i) { asm volatile("" : "+v"(i)); return __builtin_amdgcn_readfirstlane(i); }
#define PIN(i) (p.in[lnd(i)])
__device__ __forceinline__ unsigned char* lndp(unsigned char* q) { unsigned lo = (unsigned)(uintptr_t)q, hi = (unsigned)((uintptr_t)q >> 32); asm volatile("" : "+v"(lo), "+v"(hi)); lo = __builtin_amdgcn_readfirstlane(lo); hi = __builtin_amdgcn_readfirstlane(hi); return (unsigned char*)(((uintptr_t)hi << 32) | (uintptr_t)lo); }


__device__ __forceinline__ unsigned f2bf(float f) { unsigned u = __builtin_bit_cast(unsigned, f); return (u + 0x7fffu + ((u >> 16) & 1u)) >> 16; }
__device__ __forceinline__ unsigned pk2(float lo, float hi) { return f2bf(lo) | (f2bf(hi) << 16); }
__device__ __forceinline__ float bflo(unsigned w) { return __builtin_bit_cast(float, w << 16); }
__device__ __forceinline__ float bfhi(unsigned w) { return __builtin_bit_cast(float, w & 0xffff0000u); }
__device__ __forceinline__ float bf1(bf16_t b) { return __builtin_bit_cast(float, (unsigned)b << 16); }
__device__ __forceinline__ float wave_sum(float v) {
#pragma unroll
    for (int o = 1; o < 64; o <<= 1) v += __shfl_xor(v, o);
    return v;
}
__device__ __forceinline__ f32x2 cmul(f32x2 a, f32x2 b) { return (f32x2){a.x * b.x - a.y * b.y, a.x * b.y + a.y * b.x}; }
__device__ __forceinline__ f32x2 cmulc(f32x2 a, f32x2 b) { return (f32x2){a.x * b.x + a.y * b.y, a.y * b.x - a.x * b.y}; }
__device__ __forceinline__ f32x2 cconj(f32x2 a) { return (f32x2){a.x, -a.y}; }

__device__ __forceinline__ void pro_mod(const int wave_s_, const P& p, LAS unsigned char* lds) { unsigned char* const wsb = lndp(p.ws); const int tidx_ = tid_of(wave_s_); const int bidx_ = lnds((int)blockIdx.x);
    const float* c = PIN(1); const float* cc = PIN(3); const float* mw = PIN(4); const float* mb = PIN(5);
    float* modv = (float*)(wsb + WS_MODV);
    LAS float* red = (LAS float*)lds;
    const int tid = tidx_, cq = tid & 15, ks = tid >> 4;
    for (int item = bidx_; item < 4 * 96; item += gridDim.x) {
        const int layer = item / 96, n0 = (item % 96) * 64;
        f32x4 aL = {0.f, 0.f, 0.f, 0.f}, aC = {0.f, 0.f, 0.f, 0.f};
        const float* wp = mw + ((size_t)layer * 1024 + ks * 32) * 6144 + n0 + 4 * cq;
        for (int k = 0; k < 32; ++k) {
            const float cv = c[ks * 32 + k], xv = cc[ks * 32 + k];
            const float sl = cv / (1.f + expf(-cv)), sc = xv / (1.f + expf(-xv));
            const f32x4 w = *(const f32x4*)(wp + (size_t)k * 6144);
            aL += w * sl; aC += w * sc;
        }
        LAS float* r = red + (ks * 16 + cq) * 8;
        r[0] = aL[0]; r[1] = aL[1]; r[2] = aL[2]; r[3] = aL[3]; r[4] = aC[0]; r[5] = aC[1]; r[6] = aC[2]; r[7] = aC[3];
        __syncthreads();
        if (tid < 128) { const int cq2 = tid & 15, j = tid >> 4; float s = 0.f;
            for (int k2 = 0; k2 < 32; ++k2) s += red[(k2 * 16 + cq2) * 8 + j];
            const int n = n0 + 4 * cq2 + (j & 3), stream = j >> 2;
            modv[(layer * 2 + stream) * 6144 + n] = s + mb[layer * 6144 + n]; }
        __syncthreads();
    }
}
__device__ __forceinline__ void pro_tables(const int wave_s_, const P& p) { unsigned char* const wsb = lndp(p.ws); const int tidx_ = tid_of(wave_s_); const int bidx_ = lnds((int)blockIdx.x);
    const int gt = bidx_ * 512 + tidx_, GT = gridDim.x * 512;
    f32x2* tw = (f32x2*)(wsb + WS_TW);
    for (int t = gt; t <= 8192; t += GT) { float s, c; sincospif((float)t * (1.0f / 8192.0f), &s, &c); tw[t] = (f32x2){c, -s}; }
    f32x2* rope = (f32x2*)(wsb + WS_ROPE);
    for (int i = gt; i < LSEQ * 32; i += GT) { const int t = i >> 5, j = i & 31; const int pos = j < 16 ? (t >> 6) : (t & 63);
        const float inv = powf(10000.0f, -(float)(2 * (j & 15)) / 32.0f); const float ang = (float)pos * inv; float s, c; sincosf(ang, &s, &c); rope[i] = (f32x2){c, s}; }
}
__device__ __forceinline__ void ew_phase(const int wave_s_, const P& p, int mode, int layer) { unsigned char* const wsb = lndp(p.ws); const int tidx_ = tid_of(wave_s_); const int bidx_ = lnds((int)blockIdx.x);
    const int lane = tidx_ & 63, wave = tidx_ >> 6;
    const int gw = bidx_ * 8 + wave, NGW = gridDim.x * 8;
    const float* modv = (const float*)(wsb + WS_MODV);
    const float* ss = (const float*)(wsb + (mode == 1 ? WS_SS1 : WS_SS2));
    const bf16_t* OL = (const bf16_t*)(wsb + WS_OL);
    bf16_t* H = (bf16_t*)(wsb + WS_H);
    float* xc = (float*)(wsb + WS_XC);
    const float* gpost = (mode == 1 ? PIN(7) : PIN(9)) + layer * 1024;
    const int gi = mode == 1 ? 2 : 5;
    const bool donorm = !(mode == 2 && layer == NLAYER - 1);
    const int nl = mode == 2 ? layer + 1 : layer;
    const float* gpre = (mode == 1 ? PIN(8) : PIN(6)) + (donorm ? nl : 0) * 1024;
    const int shi = mode == 1 ? 3 : 0, sci = mode == 1 ? 4 : 1;
    for (int row = gw; row < R; row += NGW) {
        const int stream = row < LCTX ? 1 : 0;
        float* xp = row < LCTX ? xc + (size_t)row * 1024 : p.out + (size_t)(row - LCTX) * 1024;
        const float* src = mode == 0 ? (row < LCTX ? PIN(2) + (size_t)row * 1024 : PIN(0) + (size_t)(row - LCTX) * 1024) : xp;
        f32x4 v[4];
#pragma unroll
        for (int j = 0; j < 4; ++j) v[j] = *(const f32x4*)(src + j * 256 + lane * 4);
        if (mode != 0) {
            const float rs = rsqrtf(ss[row] * (1.0f / 1024.0f) + EPS);
            const float* mg = modv + (layer * 2 + stream) * 6144 + gi * 1024;
#pragma unroll
            for (int j = 0; j < 4; ++j) { const int col = j * 256 + lane * 4;
                const f32x4 g = *(const f32x4*)(mg + col) * *(const f32x4*)(gpost + col) * rs;
                const u32x2 o = *(const u32x2*)(OL + (size_t)row * 1024 + col);
                v[j] += g * (f32x4){bflo(o.x), bfhi(o.x), bflo(o.y), bfhi(o.y)}; }
        }
#pragma unroll
        for (int j = 0; j < 4; ++j) *(f32x4*)(xp + j * 256 + lane * 4) = v[j];
        if (donorm) {
            float s = 0.f;
#pragma unroll
            for (int j = 0; j < 4; ++j) s += (v[j][0] * v[j][0] + v[j][1] * v[j][1]) + (v[j][2] * v[j][2] + v[j][3] * v[j][3]);
            s = wave_sum(s);
            const float rstd = rsqrtf(s * (1.0f / 1024.0f) + EPS);
            const float* msh = modv + (nl * 2 + stream) * 6144 + shi * 1024; const float* msc = modv + (nl * 2 + stream) * 6144 + sci * 1024;
#pragma unroll
            for (int j = 0; j < 4; ++j) { const int col = j * 256 + lane * 4;
                const f32x4 y = v[j] * rstd * *(const f32x4*)(gpre + col) * (*(const f32x4*)(msc + col) + 1.0f) + *(const f32x4*)(msh + col);
                u32x2 w; w.x = pk2(y[0], y[1]); w.y = pk2(y[2], y[3]);
                *(u32x2*)(H + (size_t)row * 1024 + col) = w; }
        }
    }
}
__device__ __forceinline__ void transpose_item(const float* W, int K, int N, bf16_t* WT, int ldo, LAS float* scr, int item, int lane) {
    const int nblk = N / 32, kb = item / nblk, nb = item % nblk, k0 = 64 * kb, n0 = 32 * nb;
#pragma unroll 8
    for (int i = 0; i < 32; ++i) { const int kk = 2 * i + (lane >> 5); scr[kk * 33 + (lane & 31)] = W[(size_t)(k0 + kk) * N + n0 + (lane & 31)]; }
    asm volatile("s_waitcnt lgkmcnt(0)" ::: "memory");
    const int c = lane & 7;
#pragma unroll
    for (int j = 0; j < 4; ++j) { const int n = (lane >> 3) + 8 * j; const LAS float* s = scr + (8 * c) * 33 + n;
        u32x4 o; o.x = pk2(s[0 * 33], s[1 * 33]); o.y = pk2(s[2 * 33], s[3 * 33]); o.z = pk2(s[4 * 33], s[5 * 33]); o.w = pk2(s[6 * 33], s[7 * 33]);
        *(u32x4*)(WT + (size_t)(n0 + n) * ldo + k0 + 8 * c) = o; }
    asm volatile("s_waitcnt lgkmcnt(0)" ::: "memory");
}
__device__ __forceinline__ void prep_layer(const int wave_s_, const P& p, int l, LAS unsigned char* lds) { unsigned char* const wsb = lndp(p.ws); const int tidx_ = tid_of(wave_s_); const int bidx_ = lnds((int)blockIdx.x);
    const int tid = tidx_, lane = tid & 63, wave = tid >> 6;
    const int gw = bidx_ * 8 + wave, NGW = gridDim.x * 8;
    const int gt = bidx_ * 512 + tid, GT = gridDim.x * 512;
    {
        LAS float* scr = (LAS float*)(lds + wave * 16384);
        bf16_t* WIN = (bf16_t*)(wsb + WS_WIN); bf16_t* WOUT = (bf16_t*)(wsb + WS_WOUT); bf16_t* W1 = (bf16_t*)(wsb + WS_W1); bf16_t* W2 = (bf16_t*)(wsb + WS_W2);
        bf16_t* W3T = (bf16_t*)(wsb + WS_W3T); bf16_t* GLUT = (bf16_t*)(wsb + WS_GLUT);
        constexpr int I_IN = 16 * 56, I_OUT = 16 * 32, I_1 = 16 * 128, I_2 = 64 * 32, I_3 = 1 * 32, I_G = 4 * 8;
        constexpr int NIT = I_IN + I_OUT + I_1 + I_2 + I_3 + I_G;
        for (int it = gw; it < NIT; it += NGW) {
            int r = it;
            if (r < I_IN) { transpose_item(PIN(10) + (size_t)l * DM * NIN, DM, NIN, WIN, DM, scr, r, lane); continue; } r -= I_IN;
            if (r < I_OUT) { transpose_item(PIN(11) + (size_t)l * DM * DM, DM, DM, WOUT, DM, scr, r, lane); continue; } r -= I_OUT;
            if (r < I_1) { transpose_item(PIN(35) + (size_t)l * DM * FF, DM, FF, W1, DM, scr, r, lane); continue; } r -= I_1;
            if (r < I_2) { transpose_item(PIN(36) + (size_t)l * FF * DM, FF, DM, W2, FF, scr, r, lane); continue; } r -= I_2;
            if (r < I_3) { transpose_item(PIN(18) + (size_t)l * 64 * 1024, 64, 1024, W3T, 128, scr, r, lane); continue; } r -= I_3;
            transpose_item(PIN(29) + (size_t)l * 256 * 256, 256, 256, GLUT, 256, scr, r, lane);
        }
        bf16_t* H2L = (bf16_t*)(wsb + WS_H2L);
        const u32x4 z4 = {0u, 0u, 0u, 0u};
        for (int i = gt; i < 1024 * 8; i += GT) *(u32x4*)(W3T + (size_t)(i >> 3) * 128 + 64 + (i & 7) * 8) = z4;
        for (int i = gt; i < 16384 * 8; i += GT) *(u32x4*)(H2L + (size_t)(i >> 3) * 128 + 64 + (i & 7) * 8) = z4;
    }
    __syncthreads();
    {
        LAS f32x2* pw = (LAS f32x2*)lds;
        LAS f32x2* bb = pw + 17 * 64;
        LAS f32x2* cc = bb + 64 * 16;
        LAS f32x2* crci = cc + 16 * 64;
        LAS float* kt = (LAS float*)(crci + 64);
        float* lamT = (float*)(wsb + WS_LAMT);
        for (int dg = bidx_; dg < 32; dg += gridDim.x) {
            const int dir = dg >> 4, g = dg & 15; const int pb = ((l * 2 + dir) * 16 + g);
            if (tid < 64) {
                const float are = PIN(21)[pb * 64 + tid], aim = PIN(22)[pb * 64 + tid]; const float dt = expf(PIN(23)[pb]);
                const float mag = expf(are * dt), ang = aim * dt; const float lr = mag * cosf(ang), li = mag * sinf(ang);
                const float den = are * are + aim * aim, nr = lr - 1.0f, ni = li;
                crci[tid] = (f32x2){(nr * are + ni * aim) / den, (ni * are - nr * aim) / den};
                f32x2 w = {1.f, 0.f}; const f32x2 lam = {lr, li};
                for (int k = 0; k <= 16; ++k) { pw[k * 64 + tid] = w; w = cmul(w, lam); }
                const f32x2 l16 = pw[16 * 64 + tid]; lamT[dg * 128 + tid] = l16.x; lamT[dg * 128 + 64 + tid] = l16.y;
            }
            __syncthreads();
            for (int idx = tid; idx < 1024; idx += 512) {
                { const int pp = idx >> 4, h = idx & 15; const float bre = PIN(24)[(size_t)(pb * 64 + pp) * 16 + h], bim = PIN(25)[(size_t)(pb * 64 + pp) * 16 + h]; const f32x2 cr = crci[pp];
                  bb[idx] = (f32x2){cr.x * bre - cr.y * bim, cr.x * bim + cr.y * bre}; }
                { cc[idx] = (f32x2){PIN(26)[(size_t)pb * 1024 + idx], PIN(27)[(size_t)pb * 1024 + idx]}; }
            }
            __syncthreads();
            for (int idx = tid; idx < 4096; idx += 512) { const int k = idx >> 8, hp = (idx >> 4) & 15, h = idx & 15; float s = 0.f;
                for (int pp = 0; pp < 64; ++pp) { const f32x2 t = cmul(cc[hp * 64 + pp], pw[k * 64 + pp]); const f32x2 b = bb[pp * 16 + h]; s += t.x * b.x - t.y * b.y; }
                kt[idx] = s; }
            __syncthreads();
            unsigned* KI = (unsigned*)(wsb + WS_S5M + (size_t)dg * 256 * KiB); unsigned* BB = KI + 32768; unsigned* CC = BB + 16384;
            const float* dsk = PIN(28) + l * 256 + g * 16;
            for (int i2 = tid; i2 < 32768; i2 += 512) { const int n = i2 >> 7, kp = i2 & 127, kk = 2 * kp, s = kk >> 4, h = kk & 15, t = n >> 4, hp = n & 15;
                const int lag = dir == 0 ? t - s : s - t; float v0 = 0.f, v1 = 0.f;
                if (lag >= 0) { v0 = kt[(lag * 16 + hp) * 16 + h]; v1 = kt[(lag * 16 + hp) * 16 + h + 1]; }
                if (dir == 0 && lag == 0) { if (h == hp) v0 += dsk[hp]; if (h + 1 == hp) v1 += dsk[hp]; }
                KI[i2] = pk2(v0, v1); }
            for (int i2 = tid; i2 < 16384; i2 += 512) { const int col = i2 >> 7, kp = i2 & 127, kk = 2 * kp, s = kk >> 4, h = kk & 15, ri = col >> 6, pp = col & 63;
                const int e = dir == 0 ? 15 - s : s; const f32x2 w = pw[e * 64 + pp]; const f32x2 a = cmul(w, bb[pp * 16 + h]), b = cmul(w, bb[pp * 16 + h + 1]);
                BB[i2] = ri == 0 ? pk2(a.x, b.x) : pk2(a.y, b.y); }
            for (int i2 = tid; i2 < 16384; i2 += 512) { const int n = i2 >> 6, cp = i2 & 63, col = 2 * cp, ri = col >> 6, pp = col & 63, t = n >> 4, hp = n & 15;
                const int e = dir == 0 ? t + 1 : 16 - t; const f32x2 a = cmul(cc[hp * 64 + pp], pw[e * 64 + pp]), b = cmul(cc[hp * 64 + pp + 1], pw[e * 64 + pp + 1]);
                CC[i2] = ri == 0 ? pk2(a.x, b.x) : pk2(-a.y, -b.y); }
            __syncthreads();
        }
    }
    {
        LAS float* w1s = (LAS float*)lds; LAS float* b1s = w1s + 33 * 64; LAS float* w2s = b1s + 64; LAS float* b2s = w2s + 4096;
        __syncthreads();
        for (int i = tid; i < 33 * 64; i += 512) w1s[i] = PIN(14)[l * 33 * 64 + i];
        for (int i = tid; i < 4096; i += 512) w2s[i] = PIN(16)[l * 4096 + i];
        if (tid < 64) { b1s[tid] = PIN(15)[l * 64 + tid]; b2s[tid] = PIN(17)[l * 64 + tid]; }
        __syncthreads();
        bf16_t* H2L = (bf16_t*)(wsb + WS_H2L); float* H2C = (float*)(wsb + WS_H2C);
        for (int item = bidx_; item < 33; item += gridDim.x) {
            const bool isctx = item == 32; const int n = isctx ? tid : item * 512 + tid;
            if (!isctx || tid < 256) {
                const float t = (float)n / (isctx ? 256.0f : 16384.0f);
                float h1[64];
#pragma unroll
                for (int j = 0; j < 64; ++j) h1[j] = b1s[j] + t * w1s[j];
                _Pragma("nounroll") for (int f = 1; f <= 16; ++f) { float cs, sn; sincospif(2.0f * t * (float)f, &sn, &cs);
#pragma unroll
                    for (int j = 0; j < 64; ++j) h1[j] += cs * w1s[f * 64 + j] + sn * w1s[(16 + f) * 64 + j]; }
#pragma unroll
                for (int j = 0; j < 64; ++j) h1[j] = sinpif(h1[j] * 0.3183098861837907f);
                _Pragma("nounroll") for (int j = 0; j < 64; j += 2) { float a0 = b2s[j], a1 = b2s[j + 1];
#pragma unroll
                    for (int i = 0; i < 64; ++i) { a0 += h1[i] * w2s[i * 64 + j]; a1 += h1[i] * w2s[i * 64 + j + 1]; }
                    a0 = sinpif(a0 * 0.3183098861837907f); a1 = sinpif(a1 * 0.3183098861837907f);
                    if (isctx) { H2C[n * 64 + j] = a0; H2C[n * 64 + j + 1] = a1; } else *(unsigned*)(H2L + (size_t)n * 128 + j) = pk2(a0, a1); }
            }
        }
        __syncthreads();
    }
}

__device__ __forceinline__ void pb_attprep(const int wave_s_, const P& p, int l) { unsigned char* const wsb = lndp(p.ws); const int tidx_ = tid_of(wave_s_); const int bidx_ = lnds((int)blockIdx.x);
    const int gt = bidx_ * 512 + tidx_, GT = gridDim.x * 512;
    const bf16_t* U = (const bf16_t*)(wsb + WS_U); bf16_t* QN = (bf16_t*)(wsb + WS_QN); bf16_t* KN = (bf16_t*)(wsb + WS_KN);
    const f32x2* rope = (const f32x2*)(wsb + WS_ROPE);
    for (int idx = gt; idx < R * 6; idx += GT) {
        const int row = idx / 6, slot = idx - row * 6;
        const bf16_t* src = U + (size_t)row * NIN + (slot < 4 ? 1280 + slot * 64 : 1536 + (slot - 4) * 64);
        const float* gain = (slot < 4 ? PIN(33) : PIN(34)) + l * 64;
        float x[64]; float ms = 0.f;
#pragma unroll
        for (int c = 0; c < 8; ++c) { const u32x4 w = *(const u32x4*)(src + c * 8);
            x[c * 8 + 0] = bflo(w.x); x[c * 8 + 1] = bfhi(w.x); x[c * 8 + 2] = bflo(w.y); x[c * 8 + 3] = bfhi(w.y); x[c * 8 + 4] = bflo(w.z); x[c * 8 + 5] = bfhi(w.z); x[c * 8 + 6] = bflo(w.w); x[c * 8 + 7] = bfhi(w.w); }
#pragma unroll
        for (int d = 0; d < 64; ++d) ms += x[d] * x[d];
        const float rs = rsqrtf(ms * (1.0f / 64.0f) + EPS);
#pragma unroll
        for (int d = 0; d < 64; ++d) x[d] = x[d] * rs * gain[d];
        if (row >= LCTX) { const f32x2* rp = rope + (size_t)(row - LCTX) * 32;
#pragma unroll
            for (int i = 0; i < 32; ++i) { const f32x2 cs = rp[i]; const float x0 = x[2 * i], x1 = x[2 * i + 1]; x[2 * i] = x0 * cs.x - x1 * cs.y; x[2 * i + 1] = x0 * cs.y + x1 * cs.x; } }
        const float sc = slot < 4 ? QSCALE : 1.0f;
        bf16_t* dst = slot < 4 ? QN + (size_t)row * 256 + slot * 64 : KN + (size_t)row * 128 + (slot - 4) * 64;
#pragma unroll
        for (int c = 0; c < 8; ++c) { u32x4 w; w.x = pk2(x[c * 8] * sc, x[c * 8 + 1] * sc); w.y = pk2(x[c * 8 + 2] * sc, x[c * 8 + 3] * sc); w.z = pk2(x[c * 8 + 4] * sc, x[c * 8 + 5] * sc); w.w = pk2(x[c * 8 + 6] * sc, x[c * 8 + 7] * sc);
            *(u32x4*)(dst + c * 8) = w; }
    }
}
__device__ __forceinline__ void pb_s5local(const int wave_s_, const P& p) { unsigned char* const wsb = lndp(p.ws); const int tidx_ = tid_of(wave_s_); const int bidx_ = lnds((int)blockIdx.x);
    const int lane = tidx_ & 63, wave = tidx_ >> 6, gw = bidx_ * 8 + wave, NGW = gridDim.x * 8;
    const bf16_t* U = (const bf16_t*)(wsb + WS_U); float* SC = (float*)(wsb + WS_SC);
    const int m = lane & 15, kq = lane >> 4;
    for (int it = gw; it < 32 * 65; it += NGW) {
        const int dg = it / 65, ct = it - dg * 65, g = dg & 15;
        const bf16_t* BB = (const bf16_t*)(wsb + WS_S5M + (size_t)dg * 256 * KiB + 128 * KiB);
        f32x4 acc[8];
#pragma unroll
        for (int n = 0; n < 8; ++n) acc[n] = (f32x4){0.f, 0.f, 0.f, 0.f};
        const int chunk = ct * 16 + m;
        for (int ks = 0; ks < 8; ++ks) {
            const int k0 = ks * 32 + 8 * kq;
            const bf16x8 a = *(const bf16x8*)(U + (size_t)(chunk * 16 + (k0 >> 4)) * NIN + 768 + g * 16 + (k0 & 15));
#pragma unroll
            for (int n = 0; n < 8; ++n) { const bf16x8 b = *(const bf16x8*)(BB + (size_t)(n * 16 + m) * 256 + k0);
                acc[n] = __builtin_amdgcn_mfma_f32_16x16x32_bf16(a, b, acc[n], 0, 0, 0); }
        }
#pragma unroll
        for (int n = 0; n < 8; ++n)
#pragma unroll
            for (int i = 0; i < 4; ++i) SC[((size_t)dg * NCH + ct * 16 + 4 * kq + i) * 128 + n * 16 + m] = acc[n][i];
    }
}
__device__ __forceinline__ void pb_pool(const int wave_s_, const P& p, int l, LAS unsigned char* lds) { unsigned char* const wsb = lndp(p.ws); const int tidx_ = tid_of(wave_s_); const int bidx_ = lnds((int)blockIdx.x);
    const int tid = tidx_;
    const bf16_t* U = (const bf16_t*)(wsb + WS_U); bf16_t* MG = (bf16_t*)(wsb + WS_MERGED);
    LAS float* ut = (LAS float*)lds;
    LAS float* pt = ut + 80 * 64;
    LAS float* wt = pt + 64 * 65;
    for (int item = bidx_; item < 260 * 4; item += gridDim.x) {
        const int g = item & 3, r0 = (item >> 2) * 64; const int win = 2 << g, hw = win >> 1;
        const int seg0 = r0 < LCTX ? 0 : LCTX, seg1 = r0 < LCTX ? LCTX : R;
        __syncthreads();
        for (int i = tid; i < 80 * 8; i += 512) { const int rr = i >> 3, c8 = (i & 7) * 8; const int row = r0 - 8 + rr; f32x4 a = {0.f, 0.f, 0.f, 0.f}, b = a;
            if (row >= seg0 && row < seg1) { const u32x4 w = *(const u32x4*)(U + (size_t)row * NIN + 1024 + g * 64 + c8); a = (f32x4){bflo(w.x), bfhi(w.x), bflo(w.y), bfhi(w.y)}; b = (f32x4){bflo(w.z), bfhi(w.z), bflo(w.w), bfhi(w.w)}; }
            *(LAS f32x4*)(ut + rr * 64 + c8) = a; *(LAS f32x4*)(ut + rr * 64 + c8 + 4) = b; }
        for (int i = tid; i < 4096; i += 512) wt[i] = PIN(31)[(size_t)(l * 4 + g) * 4096 + i];
        __syncthreads();
        { const int t = tid >> 3, c8 = (tid & 7) * 8; const int row = r0 + t;
          int lo = row - hw; if (lo < seg0) lo = seg0; int hi = row + hw; if (hi > seg1) hi = seg1; const float inv = 1.0f / (float)(hi - lo);
#pragma unroll
          for (int c = 0; c < 8; ++c) { float s = 0.f; for (int rr = lo; rr < hi; ++rr) s += ut[(rr - r0 + 8) * 64 + c8 + c]; pt[t * 65 + c8 + c] = s * inv - ut[(t + 8) * 64 + c8 + c]; } }
        __syncthreads();
        { const int t = tid >> 3, d8 = (tid & 7) * 8; float acc[8];
#pragma unroll
          for (int d = 0; d < 8; ++d) acc[d] = 0.f;
          for (int c = 0; c < 64; ++c) { const float pv = pt[t * 65 + c]; const f32x4 w0 = *(const LAS f32x4*)(wt + c * 64 + d8), w1 = *(const LAS f32x4*)(wt + c * 64 + d8 + 4);
              acc[0] += pv * w0[0]; acc[1] += pv * w0[1]; acc[2] += pv * w0[2]; acc[3] += pv * w0[3]; acc[4] += pv * w1[0]; acc[5] += pv * w1[1]; acc[6] += pv * w1[2]; acc[7] += pv * w1[3]; }
          const float* sc = PIN(32) + l * 256 + g * 64 + d8;
          u32x4 w; w.x = pk2(acc[0] * sc[0], acc[1] * sc[1]); w.y = pk2(acc[2] * sc[2], acc[3] * sc[3]); w.z = pk2(acc[4] * sc[4], acc[5] * sc[5]); w.w = pk2(acc[6] * sc[6], acc[7] * sc[7]);
          *(u32x4*)(MG + (size_t)(r0 + t) * 1024 + 512 + g * 64 + d8) = w; }
    }
    __syncthreads();
}
__device__ __forceinline__ void pb_shortconv(const int wave_s_, const P& p, int l, LAS unsigned char* lds) { unsigned char* const wsb = lndp(p.ws); const int tidx_ = tid_of(wave_s_); const int bidx_ = lnds((int)blockIdx.x);
    const int tid = tidx_;
    const bf16_t* U = (const bf16_t*)(wsb + WS_U); bf16_t* VXT = (bf16_t*)(wsb + WS_VXT);
    LAS float* ut = (LAS float*)lds;
    const float* cw = PIN(12) + (size_t)l * 3 * 768; const float* cb = PIN(13) + l * 768;
    for (int item = bidx_; item < 256 * 12; item += gridDim.x) {
        const int cbk = item % 12, t0 = (item / 12) * 64, c0 = cbk * 64;
        __syncthreads();
        for (int i = tid; i < 66 * 8; i += 512) { const int rr = i >> 3, c8 = (i & 7) * 8; const int t = t0 - 1 + rr; f32x4 a = {0.f, 0.f, 0.f, 0.f}, b = a;
            if (t >= 0 && t < LSEQ) { const u32x4 w = *(const u32x4*)(U + (size_t)(LCTX + t) * NIN + c0 + c8); a = (f32x4){bflo(w.x), bfhi(w.x), bflo(w.y), bfhi(w.y)}; b = (f32x4){bflo(w.z), bfhi(w.z), bflo(w.w), bfhi(w.w)}; }
            LAS float* d = ut + rr * 65 + c8; d[0] = a[0]; d[1] = a[1]; d[2] = a[2]; d[3] = a[3]; d[4] = b[0]; d[5] = b[1]; d[6] = b[2]; d[7] = b[3]; }
        __syncthreads();
        { const int c = tid >> 3, t8 = (tid & 7) * 8; const int col = c0 + c; const float w0 = cw[col], w1 = cw[768 + col], w2 = cw[1536 + col], b = cb[col]; float y[8];
#pragma unroll
          for (int i = 0; i < 8; ++i) y[i] = b + w0 * ut[(t8 + i) * 65 + c] + w1 * ut[(t8 + i + 1) * 65 + c] + w2 * ut[(t8 + i + 2) * 65 + c];
          u32x4 w; w.x = pk2(y[0], y[1]); w.y = pk2(y[2], y[3]); w.z = pk2(y[4], y[5]); w.w = pk2(y[6], y[7]);
          *(u32x4*)(VXT + (size_t)col * LSEQ + t0 + t8) = w; }
    }
    __syncthreads();
}
__device__ __forceinline__ void pb_ctxhyena(const int wave_s_, const P& p, int l, LAS unsigned char* lds) { unsigned char* const wsb = lndp(p.ws); const int tidx_ = tid_of(wave_s_); const int bidx_ = lnds((int)blockIdx.x);
    const int lane = tidx_ & 63, wave = tidx_ >> 6, gw = bidx_ * 8 + wave, NGW = gridDim.x * 8;
    const bf16_t* U = (const bf16_t*)(wsb + WS_U); bf16_t* MG = (bf16_t*)(wsb + WS_MERGED); const float* H2C = (const float*)(wsb + WS_H2C);
    LAS float* base = (LAS float*)(lds + wave * 8192);
    LAS float* zc = base; LAS float* x1c = base + 256; LAS float* x2c = base + 512; LAS float* kc = base + 768; LAS float* w3c = base + 768 + 512;
    const float* cw = PIN(12) + (size_t)l * 3 * 768; const float* cb = PIN(13) + l * 768;
    for (int ch = gw; ch < 256; ch += NGW) {
#pragma unroll
        for (int s = 0; s < 3; ++s) { const int col = s * 256 + ch; const float w0 = cw[col], w1 = cw[768 + col], w2 = cw[1536 + col], b = cb[col];
            _Pragma("nounroll") for (int i = 0; i < 4; ++i) { const int t = lane + 64 * i;
                const float um = t > 0 ? bf1(U[(size_t)(t - 1) * NIN + col]) : 0.f, u0 = bf1(U[(size_t)t * NIN + col]), up = t < 255 ? bf1(U[(size_t)(t + 1) * NIN + col]) : 0.f;
                (s == 0 ? zc : s == 1 ? x1c : x2c)[t] = b + w0 * um + w1 * u0 + w2 * up; } }
        for (int o = 0; o < 2; ++o) {
            asm volatile("s_waitcnt lgkmcnt(0)" ::: "memory");
            w3c[lane] = PIN(18)[((size_t)l * 64 + lane) * 1024 + o * 512 + ch]; w3c[64 + lane] = PIN(18)[((size_t)l * 64 + lane) * 1024 + o * 512 + 256 + ch];
            asm volatile("s_waitcnt lgkmcnt(0)" ::: "memory");
            const float df = __builtin_fabsf(PIN(19)[((l * 2 + o) * 2 + 0) * 256 + ch]), db = __builtin_fabsf(PIN(19)[((l * 2 + o) * 2 + 1) * 256 + ch]);
            _Pragma("nounroll") for (int i = 0; i < 4; ++i) { const int n = lane + 64 * i; float af = 0.f, ab = 0.f;
                _Pragma("unroll 4") for (int j = 0; j < 64; ++j) { const float hv = H2C[n * 64 + j]; af += hv * w3c[j]; ab += hv * w3c[64 + j]; }
                const float t = (float)n * (1.0f / 256.0f);
                kc[255 + n] = af * expf(-t * df); if (n < 255) kc[254 - n] = ab * expf(-t * db); }
            asm volatile("s_waitcnt lgkmcnt(0)" ::: "memory");
            const float fb = PIN(20)[(l * 2 + o) * 256 + ch];
            float y[4];
#pragma unroll
            for (int i = 0; i < 4; ++i) y[i] = 0.f;
            _Pragma("unroll 4") for (int s = 0; s < 256; ++s) { const float zs = zc[s];
#pragma unroll
                for (int i = 0; i < 4; ++i) y[i] += zs * kc[255 + lane + 64 * i - s]; }
            float zn[4];
#pragma unroll
            for (int i = 0; i < 4; ++i) { const int t = lane + 64 * i; zn[i] = (o == 0 ? x1c[t] : x2c[t]) * (y[i] + fb * zc[t]); }
            asm volatile("s_waitcnt lgkmcnt(0)" ::: "memory");
#pragma unroll
            for (int i = 0; i < 4; ++i) zc[lane + 64 * i] = zn[i];
            asm volatile("s_waitcnt lgkmcnt(0)" ::: "memory");
        }
        for (int i = 0; i < 4; ++i) { const int t = lane + 64 * i; MG[(size_t)t * 1024 + ch] = (bf16_t)f2bf(zc[t]); }
        asm volatile("s_waitcnt lgkmcnt(0)" ::: "memory");
    }
}

__device__ __forceinline__ void pc_s5carry(const int wave_s_, const P& p) { unsigned char* const wsb = lndp(p.ws); const int tidx_ = tid_of(wave_s_); const int bidx_ = lnds((int)blockIdx.x);
    const float* SC = (const float*)(wsb + WS_SC); float* HIN = (float*)(wsb + WS_HIN); const float* lamT = (const float*)(wsb + WS_LAMT);
    for (int idx = bidx_ * 512 + tidx_; idx < 2048; idx += gridDim.x * 512) {
        const int dg = idx >> 6, pp = idx & 63, dir = dg >> 4;
        const float lr = lamT[dg * 128 + pp], li = lamT[dg * 128 + 64 + pp];
        float hr = 0.f, hi = 0.f;
        const float* sb = SC + (size_t)dg * NCH * 128 + pp; float* hb = HIN + (size_t)dg * NCH * 128 + pp;
        for (int b0 = 0; b0 < NCH; b0 += 16) {
            float sr[16], si[16]; int cidx[16];
#pragma unroll
            for (int j = 0; j < 16; ++j) { const int q = b0 + j;
                const int c = dir == 0 ? q : (q < 16 ? 15 - q : NCH + 15 - q);
                cidx[j] = c; sr[j] = sb[(size_t)c * 128]; si[j] = sb[(size_t)c * 128 + 64]; }
#pragma unroll
            for (int j = 0; j < 16; ++j) { hb[(size_t)cidx[j] * 128] = hr; hb[(size_t)cidx[j] * 128 + 64] = hi;
                const float nr = lr * hr - li * hi + sr[j], ni = lr * hi + li * hr + si[j]; hr = nr; hi = ni; }
        }
    }
}
typedef __bf16 bf16x2_t __attribute__((ext_vector_type(2)));
__device__ __forceinline__ unsigned cvtpk(float lo, float hi) { f32x2 v = {lo, hi}; bf16x2_t b = __builtin_convertvector(v, bf16x2_t); return __builtin_bit_cast(unsigned, b); }
constexpr float ATT_THR = 10.0f;
__device__ __forceinline__ void pc_attention(const int wave_s_, const P& p, LAS unsigned char* lds) { unsigned char* const wsb = lndp(p.ws); const int tidx_ = tid_of(wave_s_); const int bidx_ = lnds((int)blockIdx.x);
    const int tid = tidx_, lane = tid & 63, wave = tid >> 6, r32 = lane & 31, hi = lane >> 5;
    const bf16_t* U = (const bf16_t*)(wsb + WS_U); const bf16_t* QN = (const bf16_t*)(wsb + WS_QN); const bf16_t* KN = (const bf16_t*)(wsb + WS_KN); bf16_t* MG = (bf16_t*)(wsb + WS_MERGED);
    constexpr int RS = 72;
    LAS bf16_t* Ks = (LAS bf16_t*)lds;
    LAS bf16_t* Vs = Ks + 2 * 64 * RS;
    for (int unit = bidx_; unit < 260; unit += gridDim.x) {
        int kh, qb; if (unit < 256) { kh = unit & 1; qb = 2 + (unit >> 1); } else { kh = unit & 1; qb = (unit - 256) >> 1; }
        const int nt = qb < 2 ? 4 : 260;
        const int hq = kh * 2 + (wave >> 2); const int qrow = qb * 128 + (wave & 3) * 32 + r32;
        bf16x8 qr[4];
#pragma unroll
        for (int dk = 0; dk < 4; ++dk) qr[dk] = *(const bf16x8*)(QN + (size_t)qrow * 256 + hq * 64 + dk * 16 + hi * 8);
        f32x16 o0, o1, negm;
#pragma unroll
        for (int i = 0; i < 16; ++i) { o0[i] = 0.f; o1[i] = 0.f; negm[i] = 0.f; }
        float mref = 0.f, lsum = 0.f;
        const int klr = tid >> 3, kseg = (tid & 7) * 8;
        const int vlr = lane, vseg = wave * 8;
        const bf16_t* kg = KN + (size_t)klr * 128 + kh * 64 + kseg; const bf16_t* vg = U + (size_t)vlr * NIN + 1664 + kh * 64 + vseg;
        u32x4 kreg = *(const u32x4*)kg, vreg = *(const u32x4*)vg;
        __syncthreads();
        for (int t = 0; t < nt; ++t) {
            const int buf = t & 1;
            LAS bf16_t* Kb = Ks + buf * 64 * RS; LAS bf16_t* Vb = Vs + buf * 64 * RS;
            *(LAS u32x4*)(Kb + klr * RS + kseg) = kreg;
            { LAS bf16_t* vd = Vb + vseg * RS + vlr;
              vd[0 * RS] = (bf16_t)(vreg.x & 0xffffu); vd[1 * RS] = (bf16_t)(vreg.x >> 16); vd[2 * RS] = (bf16_t)(vreg.y & 0xffffu); vd[3 * RS] = (bf16_t)(vreg.y >> 16);
              vd[4 * RS] = (bf16_t)(vreg.z & 0xffffu); vd[5 * RS] = (bf16_t)(vreg.z >> 16); vd[6 * RS] = (bf16_t)(vreg.w & 0xffffu); vd[7 * RS] = (bf16_t)(vreg.w >> 16); }
            if (t + 1 < nt) { kreg = *(const u32x4*)(kg + (size_t)(t + 1) * 64 * 128); vreg = *(const u32x4*)(vg + (size_t)(t + 1) * 64 * NIN); }
            __syncthreads();
            f32x16 p0, p1;
            __builtin_amdgcn_s_setprio(1);
#pragma unroll
            for (int dk = 0; dk < 4; ++dk) {
                const bf16x8 a0 = *(const LAS bf16x8*)(Kb + r32 * RS + dk * 16 + hi * 8);
                const bf16x8 a1 = *(const LAS bf16x8*)(Kb + (32 + r32) * RS + dk * 16 + hi * 8);
                if (dk == 0) { p0 = __builtin_amdgcn_mfma_f32_32x32x16_bf16(a0, qr[0], negm, 0, 0, 0); p1 = __builtin_amdgcn_mfma_f32_32x32x16_bf16(a1, qr[0], negm, 0, 0, 0); }
                else { p0 = __builtin_amdgcn_mfma_f32_32x32x16_bf16(a0, qr[dk], p0, 0, 0, 0); p1 = __builtin_amdgcn_mfma_f32_32x32x16_bf16(a1, qr[dk], p1, 0, 0, 0); }
            }
            __builtin_amdgcn_s_setprio(0);
            float mx = fmaxf(fmaxf(p0[0], p0[1]), p1[0]);
#pragma unroll
            for (int i = 2; i < 16; i += 2) mx = fmaxf(fmaxf(mx, p0[i]), p0[i + 1]);
#pragma unroll
            for (int i = 1; i < 15; i += 2) mx = fmaxf(fmaxf(mx, p1[i]), p1[i + 1]);
            mx = fmaxf(mx, p1[15]);
            mx = fmaxf(mx, __shfl_xor(mx, 32));
            const bool first = (t == 0);
            if (first || __any(mx > ATT_THR)) {
                const float d = first ? mx : fmaxf(mx, 0.f);
                mref += d;
#pragma unroll
                for (int i = 0; i < 16; ++i) { p0[i] -= d; p1[i] -= d; negm[i] = -mref; }
                if (!first) { const float al = __builtin_amdgcn_exp2f(-d); lsum *= al;
#pragma unroll
                    for (int i = 0; i < 16; ++i) { o0[i] *= al; o1[i] *= al; } }
            }
            float ps = 0.f;
#pragma unroll
            for (int i = 0; i < 16; ++i) { p0[i] = __builtin_amdgcn_exp2f(p0[i]); p1[i] = __builtin_amdgcn_exp2f(p1[i]); ps += p0[i] + p1[i]; }
            lsum += ps;
            __builtin_amdgcn_s_setprio(1);
#pragma unroll
            for (int j = 0; j < 4; ++j) {
                const int half = j >> 1, jj = j & 1;
                u32x4 pb;
                if (half == 0) { pb.x = cvtpk(p0[8 * jj + 0], p0[8 * jj + 1]); pb.y = cvtpk(p0[8 * jj + 2], p0[8 * jj + 3]); pb.z = cvtpk(p0[8 * jj + 4], p0[8 * jj + 5]); pb.w = cvtpk(p0[8 * jj + 6], p0[8 * jj + 7]); }
                else { pb.x = cvtpk(p1[8 * jj + 0], p1[8 * jj + 1]); pb.y = cvtpk(p1[8 * jj + 2], p1[8 * jj + 3]); pb.z = cvtpk(p1[8 * jj + 4], p1[8 * jj + 5]); pb.w = cvtpk(p1[8 * jj + 6], p1[8 * jj + 7]); }
                const bf16x8 pf = __builtin_bit_cast(bf16x8, pb);
                const int kvo = half * 32 + jj * 16 + 4 * hi;
                { const u32x2 lo = *(const LAS u32x2*)(Vb + r32 * RS + kvo), hi2 = *(const LAS u32x2*)(Vb + r32 * RS + kvo + 8);
                  const u32x4 av = {lo.x, lo.y, hi2.x, hi2.y}; o0 = __builtin_amdgcn_mfma_f32_32x32x16_bf16(__builtin_bit_cast(bf16x8, av), pf, o0, 0, 0, 0); }
                { const u32x2 lo = *(const LAS u32x2*)(Vb + (32 + r32) * RS + kvo), hi2 = *(const LAS u32x2*)(Vb + (32 + r32) * RS + kvo + 8);
                  const u32x4 av = {lo.x, lo.y, hi2.x, hi2.y}; o1 = __builtin_amdgcn_mfma_f32_32x32x16_bf16(__builtin_bit_cast(bf16x8, av), pf, o1, 0, 0, 0); }
            }
            __builtin_amdgcn_s_setprio(0);
        }
        lsum += __shfl_xor(lsum, 32);
        const float il = 1.0f / lsum;
        bf16_t* op = MG + (size_t)qrow * 1024 + 768 + hq * 64;
#pragma unroll
        for (int a = 0; a < 4; ++a) {
            u32x2 w; w.x = cvtpk(o0[4 * a] * il, o0[4 * a + 1] * il); w.y = cvtpk(o0[4 * a + 2] * il, o0[4 * a + 3] * il); *(u32x2*)(op + 8 * a + 4 * hi) = w;
            u32x2 w2; w2.x = cvtpk(o1[4 * a] * il, o1[4 * a + 1] * il); w2.y = cvtpk(o1[4 * a + 2] * il, o1[4 * a + 3] * il); *(u32x2*)(op + 32 + 8 * a + 4 * hi) = w2;
        }
        __syncthreads();
    }
}
__device__ __forceinline__ void fft_fwd(LAS f32x2* buf, const f32x2* tw, int tid) {
    for (int s = 0; s < 7; ++s) {
        const int lq = 12 - 2 * s, q = 1 << lq;
        __syncthreads();
#pragma unroll 2
        for (int i = 0; i < 8; ++i) { const int id = tid + 512 * i; const int j = id & (q - 1), blk = id >> lq; const int i0 = (blk << (lq + 2)) + j;
            const f32x2 a0 = buf[i0], a1 = buf[i0 + q], a2 = buf[i0 + 2 * q], a3 = buf[i0 + 3 * q];
            const f32x2 w1 = tw[j << (2 * s)]; const f32x2 w2 = cmul(w1, w1);
            const f32x2 b0 = a0 + a2, b2 = cmul(a0 - a2, w1), b1 = a1 + a3; const f32x2 t3 = cmul(a1 - a3, w1); const f32x2 b3 = {t3.y, -t3.x};
            buf[i0] = b0 + b1; buf[i0 + q] = cmul(b0 - b1, w2); buf[i0 + 2 * q] = b2 + b3; buf[i0 + 3 * q] = cmul(b2 - b3, w2); }
    }
    __syncthreads();
}
__device__ __forceinline__ void fft_inv(LAS f32x2* buf, const f32x2* tw, int tid) {
    for (int s = 6; s >= 0; --s) {
        const int lq = 12 - 2 * s, q = 1 << lq;
        __syncthreads();
#pragma unroll 2
        for (int i = 0; i < 8; ++i) { const int id = tid + 512 * i; const int j = id & (q - 1), blk = id >> lq; const int i0 = (blk << (lq + 2)) + j;
            const f32x2 c0 = buf[i0], c1 = buf[i0 + q], c2 = buf[i0 + 2 * q], c3 = buf[i0 + 3 * q];
            const f32x2 w1 = tw[j << (2 * s)]; const f32x2 w2 = cmul(w1, w1);
            const f32x2 t1 = cmulc(c1, w2), t3 = cmulc(c3, w2);
            const f32x2 b0 = c0 + t1, b1 = c0 - t1, b2 = c2 + t3, b3 = c2 - t3;
            const f32x2 u2 = cmulc(b2, w1); const f32x2 u3c = cmulc(b3, w1); const f32x2 u3 = {-u3c.y, u3c.x};
            buf[i0] = b0 + u2; buf[i0 + 2 * q] = b0 - u2; buf[i0 + q] = b1 + u3; buf[i0 + 3 * q] = b1 - u3; }
    }
    __syncthreads();
}
__device__ __forceinline__ int brev14(int k) { return (int)(__builtin_bitreverse32((unsigned)k) >> 18); }
__device__ __forceinline__ void pc_hyena(const int wave_s_, const P& p, int l, LAS unsigned char* lds) { unsigned char* const wsb = lndp(p.ws); const int tidx_ = tid_of(wave_s_); const int bidx_ = lnds((int)blockIdx.x);
    const int tid = tidx_;
    LAS f32x2* buf = (LAS f32x2*)lds;
    const f32x2* tw = (const f32x2*)(wsb + WS_TW);
    const bf16_t* VXT = (const bf16_t*)(wsb + WS_VXT); float* Z1 = (float*)(wsb + WS_Z1); bf16_t* Z2T = (bf16_t*)(wsb + WS_Z2T);
    for (int ch = bidx_; ch < 256; ch += gridDim.x) {
        for (int o = 0; o < 2; ++o) {
            float* filt = (float*)(wsb + WS_FILT) + (size_t)(ch * 2 + o) * 2 * LSEQ;
            const float* hf = filt; const float* hb = filt + LSEQ;
            __syncthreads();
            for (int m = tid; m < NFFT; m += 512) { f32x2 v;
                if (m < NFFT / 2) v = *(const f32x2*)(hf + 2 * m);
                else { const int r = 2 * LSEQ - 2 * m - 2; const f32x2 t = *(const f32x2*)(hb + r); v = (f32x2){m == NFFT / 2 ? 0.f : t.y, t.x}; }
                buf[m] = v; }
            fft_fwd(buf, tw, tid);
            f32x4* ksp = (f32x4*)filt;
            const float sc = 1.0f / (float)NFFT;
            for (int k = tid; k < NFFT / 2; k += 512) {
                if (k == 0) { const f32x2 a = buf[0], b = buf[1]; ksp[0] = (f32x4){a.x * sc, a.y * sc, b.x * sc, b.y * sc}; }
                else { const f32x2 A = buf[brev14(k)], B = cconj(buf[brev14(NFFT - k)]);
                    const f32x2 E = (A + B) * (0.5f * sc), D = (A - B) * (0.5f * sc); ksp[k] = (f32x4){E.x, E.y, D.y, -D.x}; }
            }
            __syncthreads();
            const bf16_t* zb = VXT + (size_t)ch * LSEQ; const float* z1 = Z1 + (size_t)ch * LSEQ;
            for (int m = tid; m < NFFT; m += 512) { f32x2 v = {0.f, 0.f};
                if (m < NFFT / 2) { if (o == 0) { const unsigned w = *(const unsigned*)(zb + 2 * m); v = (f32x2){bflo(w), bfhi(w)}; } else v = *(const f32x2*)(z1 + 2 * m); }
                buf[m] = v; }
            fft_fwd(buf, tw, tid);
            for (int k = tid; k < NFFT / 2; k += 512) {
                const f32x4 ks = ksp[k];
                if (k == 0) { const f32x2 a = buf[0], b = buf[1];
                    buf[0] = (f32x2){a.x * ks[0] + a.y * ks[1], a.x * ks[1] + a.y * ks[0]};
                    buf[1] = (f32x2){b.x * ks[2] - b.y * ks[3], b.x * ks[3] + b.y * ks[2]}; }
                else { const int p1 = brev14(k), p2 = brev14(NFFT - k); const f32x2 A = buf[p1], B = cconj(buf[p2]);
                    const f32x2 Ez = (A + B) * 0.5f, Dz = (A - B) * 0.5f; const f32x2 Oz = {Dz.y, -Dz.x};
                    const f32x2 Ek = {ks[0], ks[1]}, Ok = {ks[2], ks[3]};
                    const f32x2 Ey = cmul(Ez, Ek) + cmul(tw[k], cmul(Oz, Ok)); const f32x2 Oy = cmul(Ez, Ok) + cmul(Oz, Ek);
                    buf[p1] = (f32x2){Ey.x - Oy.y, Ey.y + Oy.x};
                    buf[p2] = (f32x2){Ey.x + Oy.y, Oy.x - Ey.y}; }
            }
            fft_inv(buf, tw, tid);
            const float fb = PIN(20)[(l * 2 + o) * 256 + ch];
            const bf16_t* gt = VXT + (size_t)((o + 1) * 256 + ch) * LSEQ;
            for (int m = tid; m < NFFT / 2; m += 512) { const f32x2 y = buf[m]; f32x2 zp;
                if (o == 0) { const unsigned w = *(const unsigned*)(zb + 2 * m); zp = (f32x2){bflo(w), bfhi(w)}; } else zp = *(const f32x2*)(z1 + 2 * m);
                const unsigned gw = *(const unsigned*)(gt + 2 * m);
                const f32x2 zn = {bflo(gw) * (y.x + fb * zp.x), bfhi(gw) * (y.y + fb * zp.y)};
                if (o == 0) *(f32x2*)(Z1 + (size_t)ch * LSEQ + 2 * m) = zn; else *(unsigned*)(Z2T + (size_t)ch * LSEQ + 2 * m) = pk2(zn.x, zn.y); }
            __syncthreads();
        }
    }
}

__device__ __forceinline__ float gelu_tanh(float x) { const float u = 0.7978845608028654f * (x + 0.044715f * x * x * x); return 0.5f * x * (1.0f + tanhf(u)); }
__device__ __forceinline__ void pd_s5out(const int wave_s_, const P& p) { unsigned char* const wsb = lndp(p.ws); const int tidx_ = tid_of(wave_s_); const int bidx_ = lnds((int)blockIdx.x);
    const int lane = tidx_ & 63, wave = tidx_ >> 6, gw = bidx_ * 8 + wave, NGW = gridDim.x * 8;
    const bf16_t* U = (const bf16_t*)(wsb + WS_U); const float* HIN = (const float*)(wsb + WS_HIN); bf16_t* GB = (bf16_t*)(wsb + WS_GBUF);
    const int m = lane & 15, kq = lane >> 4;
    for (int it = gw; it < 16 * 65; it += NGW) {
        const int g = it / 65, ct = it - g * 65;
        f32x4 acc[16];
#pragma unroll
        for (int n = 0; n < 16; ++n) acc[n] = (f32x4){0.f, 0.f, 0.f, 0.f};
        const int chunk = ct * 16 + m;
        for (int dir = 0; dir < 2; ++dir) {
            const int dg = dir * 16 + g;
            const bf16_t* KI = (const bf16_t*)(wsb + WS_S5M + (size_t)dg * 256 * KiB); const bf16_t* CC = KI + 65536 + 32768;
            for (int ks = 0; ks < 8; ++ks) { const int k0 = ks * 32 + 8 * kq;
                const bf16x8 a = *(const bf16x8*)(U + (size_t)(chunk * 16 + (k0 >> 4)) * NIN + 768 + g * 16 + (k0 & 15));
#pragma unroll
                for (int n = 0; n < 16; ++n) { const bf16x8 b = *(const bf16x8*)(KI + (size_t)(n * 16 + m) * 256 + k0); acc[n] = __builtin_amdgcn_mfma_f32_16x16x32_bf16(a, b, acc[n], 0, 0, 0); } }
            for (int ks = 0; ks < 4; ++ks) { const int k0 = ks * 32 + 8 * kq;
                const float* hp = HIN + ((size_t)dg * NCH + chunk) * 128 + k0; const f32x4 h0 = *(const f32x4*)hp, h1 = *(const f32x4*)(hp + 4);
                u32x4 aw; aw.x = pk2(h0[0], h0[1]); aw.y = pk2(h0[2], h0[3]); aw.z = pk2(h1[0], h1[1]); aw.w = pk2(h1[2], h1[3]);
                const bf16x8 a = __builtin_bit_cast(bf16x8, aw);
#pragma unroll
                for (int n = 0; n < 16; ++n) { const bf16x8 b = *(const bf16x8*)(CC + (size_t)(n * 16 + m) * 128 + k0); acc[n] = __builtin_amdgcn_mfma_f32_16x16x32_bf16(a, b, acc[n], 0, 0, 0); } }
        }
#pragma unroll
        for (int n = 0; n < 16; ++n)
#pragma unroll
            for (int i = 0; i < 4; ++i) { const int row = (ct * 16 + 4 * kq + i) * 16 + n; GB[(size_t)row * 256 + g * 16 + m] = (bf16_t)f2bf(gelu_tanh(acc[n][i])); }
    }
}
__device__ __forceinline__ void pd_hytrans(const int wave_s_, const P& p, LAS unsigned char* lds) { unsigned char* const wsb = lndp(p.ws); const int tidx_ = tid_of(wave_s_); const int bidx_ = lnds((int)blockIdx.x);
    const int tid = tidx_;
    const bf16_t* Z2T = (const bf16_t*)(wsb + WS_Z2T); bf16_t* MG = (bf16_t*)(wsb + WS_MERGED);
    LAS bf16_t* tile = (LAS bf16_t*)lds;
    for (int item = bidx_; item < 256 * 4; item += gridDim.x) {
        const int c0 = (item & 3) * 64, t0 = (item >> 2) * 64;
        __syncthreads();
        { const int c = tid >> 3, t8 = (tid & 7) * 8; const u32x4 w = *(const u32x4*)(Z2T + (size_t)(c0 + c) * LSEQ + t0 + t8);
          LAS unsigned* d = (LAS unsigned*)(tile + c * 66 + t8); d[0] = w.x; d[1] = w.y; d[2] = w.z; d[3] = w.w; }
        __syncthreads();
        { const int t = tid >> 3, c8 = (tid & 7) * 8; unsigned short e[8];
#pragma unroll
          for (int i = 0; i < 8; ++i) e[i] = tile[(c8 + i) * 66 + t];
          u32x4 w; w.x = e[0] | ((unsigned)e[1] << 16); w.y = e[2] | ((unsigned)e[3] << 16); w.z = e[4] | ((unsigned)e[5] << 16); w.w = e[6] | ((unsigned)e[7] << 16);
          *(u32x4*)(MG + (size_t)(LCTX + t0 + t) * 1024 + c0 + c8) = w; }
    }
    __syncthreads();
}
__device__ __forceinline__ void pd2_glu(const int wave_s_, const P& p, int l) { unsigned char* const wsb = lndp(p.ws); const int tidx_ = tid_of(wave_s_); const int bidx_ = lnds((int)blockIdx.x);
    const int lane = tidx_ & 63, wave = tidx_ >> 6, gw = bidx_ * 8 + wave, NGW = gridDim.x * 8, r32 = lane & 31, hi = lane >> 5;
    const bf16_t* GB = (const bf16_t*)(wsb + WS_GBUF); const bf16_t* GLUT = (const bf16_t*)(wsb + WS_GLUT); bf16_t* MG = (bf16_t*)(wsb + WS_MERGED);
    const float* gb = PIN(30) + l * 256;
    for (int it = gw; it < 520 * 8; it += NGW) {
        const int rt = it >> 3, ct = it & 7;
        f32x16 acc;
#pragma unroll
        for (int i = 0; i < 16; ++i) acc[i] = 0.f;
        for (int ks = 0; ks < 16; ++ks) { const int k0 = ks * 16 + 8 * hi;
            const bf16x8 a = *(const bf16x8*)(GB + (size_t)(rt * 32 + r32) * 256 + k0); const bf16x8 b = *(const bf16x8*)(GLUT + (size_t)(ct * 32 + r32) * 256 + k0);
            acc = __builtin_amdgcn_mfma_f32_32x32x16_bf16(a, b, acc, 0, 0, 0); }
        const int col = ct * 32 + r32; const float bias = gb[col];
#pragma unroll
        for (int i = 0; i < 16; ++i) { const int row = rt * 32 + (i & 3) + 8 * (i >> 2) + 4 * hi; const float gv = bf1(GB[(size_t)row * 256 + col]);
            const float sg = 1.0f / (1.0f + expf(-(acc[i] + bias))); MG[(size_t)row * 1024 + 256 + col] = (bf16_t)f2bf(gv * sg); }
    }
}

__device__ __forceinline__ void grid_bar(unsigned* ctr, unsigned target, int tid) {
    asm volatile("s_waitcnt vmcnt(0) lgkmcnt(0)" ::: "memory");
    __syncthreads();
    if (tid == 0) {
        __builtin_amdgcn_fence(__ATOMIC_RELEASE, "agent");
        asm volatile("s_waitcnt vmcnt(0)" ::: "memory");
        __hip_atomic_fetch_add(ctr, 1u, __ATOMIC_RELAXED, __HIP_MEMORY_SCOPE_AGENT);
        while (__hip_atomic_load(ctr, __ATOMIC_RELAXED, __HIP_MEMORY_SCOPE_AGENT) < target) __builtin_amdgcn_s_sleep(2);
        __builtin_amdgcn_fence(__ATOMIC_ACQUIRE, "agent");
        asm volatile("s_waitcnt vmcnt(0)" ::: "memory");
    }
    __syncthreads();
}
#define PH_BEGIN if (ph >= lo && ph < hi) { unsigned char* const wsb = lndp(p.ws); const int tidx_ = tid_of(wave_s_); const int bidx_ = lnds((int)blockIdx.x); (void)tidx_; (void)bidx_;
#define PH_END   if (ph + 1 < hi) { ++nbar; grid_bar((unsigned*)(lndp(p.ws) + WS_BAR), (unsigned)nbar * gridDim.x, tid_of(wave_s_)); } } ++ph;
#define PH_END0  if (ph + 1 < hi) grid.sync(); } ++ph;
template <int l> __device__ __forceinline__ void layer_phases(const int wave_s_, const P& p, LAS unsigned char* lds, const int lo, const int hi, int& ph, int& nbar) {

        PH_BEGIN
            { float* ss1 = (float*)(wsb + WS_SS1); float* ss2 = (float*)(wsb + WS_SS2); const int t0_ = tid_of(wave_s_);
              for (int i = bidx_ * 512 + t0_; i < R; i += gridDim.x * 512) { ss1[i] = 0.f; ss2[i] = 0.f; } }
            { pg8::Gemm g{(const pg8::bf16_t*)(wsb + WS_H), (const pg8::bf16_t*)(wsb + WS_WIN), R, NIN, DM, tidx_}; pg8::StaticOrder S; S.init(R, NIN, gridDim.x, bidx_);
              pg8::EpiBf16<0> E{(pg8::bf16_t*)(wsb + WS_U), NIN};
              pg8::gemm_phase<pg8::EpiBf16<0>, pg8::StaticOrder, true, true>(lds, g, S, E); }
            __syncthreads();
            { pg8::Gemm g{(const pg8::bf16_t*)(wsb + WS_H2L), (const pg8::bf16_t*)(wsb + WS_W3T), LSEQ, 1024, 128, tid_of(wave_s_)}; pg8::StaticOrder S; S.init(LSEQ, 1024, gridDim.x, bidx_);
              pg8::EpiFilt E{(float*)(wsb + WS_FILT), PIN(19) + l * 1024};
              pg8::gemm_phase<pg8::EpiFilt, pg8::StaticOrder, false, false>(lds, g, S, E); }
            __syncthreads();
        PH_END
        PH_BEGIN
            pb_attprep(wave_s_, p, l); pb_s5local(wave_s_, p); pb_pool(wave_s_, p, l, lds); pb_shortconv(wave_s_, p, l, lds); pb_ctxhyena(wave_s_, p, l, lds);
        PH_END
        PH_BEGIN
            pc_s5carry(wave_s_, p); pc_attention(wave_s_, p, lds); pc_hyena(wave_s_, p, l, lds);
        PH_END
        PH_BEGIN
            pd_s5out(wave_s_, p); pd_hytrans(wave_s_, p, lds);
        PH_END
        PH_BEGIN
            pd2_glu(wave_s_, p, l);
        PH_END
        PH_BEGIN
            { pg8::Gemm g{(const pg8::bf16_t*)(wsb + WS_MERGED), (const pg8::bf16_t*)(wsb + WS_WOUT), R, DM, DM, tidx_}; pg8::StaticOrder S; S.init(R, DM, gridDim.x, bidx_);
              pg8::EpiSumsq E{(pg8::bf16_t*)(wsb + WS_OL), DM, (float*)(wsb + WS_SS1)};
              pg8::gemm_phase<pg8::EpiSumsq, pg8::StaticOrder, true, true>(lds, g, S, E); }
            __syncthreads();
        PH_END
        PH_BEGIN
            ew_phase(wave_s_, p, 1, l);
        PH_END
        PH_BEGIN
            { pg8::Gemm g{(const pg8::bf16_t*)(wsb + WS_H), (const pg8::bf16_t*)(wsb + WS_W1), R, FF, DM, tidx_}; pg8::StaticOrder S; S.init(R, FF, gridDim.x, bidx_);
              pg8::EpiBf16<1> E{(pg8::bf16_t*)(wsb + WS_HID), FF};
              pg8::gemm_phase<pg8::EpiBf16<1>, pg8::StaticOrder, true, true>(lds, g, S, E); }
            __syncthreads();
        PH_END
        PH_BEGIN
            { pg8::Gemm g{(const pg8::bf16_t*)(wsb + WS_HID), (const pg8::bf16_t*)(wsb + WS_W2), R, DM, FF, tidx_}; pg8::StaticOrder S; S.init(R, DM, gridDim.x, bidx_);
              pg8::EpiSumsq E{(pg8::bf16_t*)(wsb + WS_OL), DM, (float*)(wsb + WS_SS2)};
              pg8::gemm_phase<pg8::EpiSumsq, pg8::StaticOrder, true, true>(lds, g, S, E); }
            __syncthreads();
        PH_END
        PH_BEGIN
            ew_phase(wave_s_, p, 2, l);
            if (l + 1 < NLAYER) prep_layer(wave_s_, p, l + 1, lds);
        PH_END
    }
__global__ void __launch_bounds__(512) mega_fwd(P p) {
    extern __shared__ __attribute__((aligned(16))) unsigned char lds_raw[];
    LAS unsigned char* lds = (LAS unsigned char*)lds_raw;
    cg::grid_group grid = cg::this_grid();
    const int wave_s_ = __builtin_amdgcn_readfirstlane((int)threadIdx.x >> 6);
    const int lo = p.lo, hi = p.hi;
    int ph = 0, nbar = 0;
    PH_BEGIN
        pro_mod(wave_s_, p, lds); pro_tables(wave_s_, p); prep_layer(wave_s_, p, 0, lds);
    PH_END0
    PH_BEGIN
        ew_phase(wave_s_, p, 0, 0);
    PH_END
    layer_phases<0>(wave_s_, p, lds, lo, hi, ph, nbar);
    layer_phases<1>(wave_s_, p, lds, lo, hi, ph, nbar);
    layer_phases<2>(wave_s_, p, lds, lo, hi, ph, nbar);
    layer_phases<3>(wave_s_, p, lds, lo, hi, ph, nbar);
#undef PH_BEGIN
#undef PH_END
#undef PH_END0
}
constexpr int N_PHASES = 2 + NLAYER * 10;

#ifndef MK_MULTI
#define MK_MULTI 0
#endif
extern "C" void kernel_launch(void* const* d_in, const int* in_sizes, int n_in, void* d_out, int out_size, void* d_ws, size_t ws_size, hipStream_t stream) {
    static int grid = 0;
    if (grid == 0) {
        if (n_in != 37 || out_size != LSEQ * DM || ws_size < WS_END) { fprintf(stderr, "kernel_launch: unexpected shapes (n_in %d out %d ws %zu)\n", n_in, out_size, ws_size); grid = -1; return; }
        int dev = 0, cus = 0, per_cu = 0;
        (void)hipGetDevice(&dev); (void)hipDeviceGetAttribute(&cus, hipDeviceAttributeMultiprocessorCount, dev);
        if (hipFuncSetAttribute((const void*)mega_fwd, hipFuncAttributeMaxDynamicSharedMemorySize, LDS_BYTES) != hipSuccess) { fprintf(stderr, "kernel_launch: hipFuncSetAttribute failed\n"); grid = -1; return; }
        if (hipOccupancyMaxActiveBlocksPerMultiprocessor(&per_cu, (const void*)mega_fwd, 512, LDS_BYTES) != hipSuccess || per_cu < 1) { fprintf(stderr, "kernel_launch: occupancy query gave %d\n", per_cu); per_cu = 1; }
        (void)hipGetLastError();
        grid = cus * 1;
        if (grid <= 0) grid = 256;
    }
    if (grid < 0) return;
    (void)hipMemsetAsync((unsigned char*)d_ws + WS_BAR, 0, 256, stream);
    P a{};
    for (int i = 0; i < 37; ++i) a.in[i] = (const float*)d_in[i];
    a.out = (float*)d_out; a.ws = (unsigned char*)d_ws;
#if MK_MULTI
    for (int ph = 0; ph < N_PHASES; ++ph) { a.lo = ph; a.hi = ph + 1; hipLaunchKernelGGL(mega_fwd, dim3(grid), dim3(512), LDS_BYTES, stream, a); }
#else
    a.lo = 0; a.hi = N_PHASES;
    void* args[] = {&a};
    hipError_t e = hipLaunchCooperativeKernel((const void*)mega_fwd, dim3(grid), dim3(512), args, LDS_BYTES, stream);
    if (e != hipSuccess) fprintf(stderr, "cooperative launch failed: %s (grid %d)\n", hipGetErrorString(e), grid);
#endif
}
```

```cpp
#include <hip/hip_runtime.h>
#include <hip/hip_cooperative_groups.h>
#include <cstdio>
#include <cstdint>
namespace cg = cooperative_groups;

__device__ __forceinline__ int lndv(int i) { asm volatile("" : "+v"(i)); return i; }
__device__ __forceinline__ int lnds(int i) { asm volatile("" : "+v"(i)); return __builtin_amdgcn_readfirstlane(i); }
__device__ __forceinline__ int tid_of(int wave_s) { int z = 0; asm volatile("" : "+v"(z)); return (wave_s << 6) + (int)__builtin_amdgcn_mbcnt_hi(~0u, __builtin_amdgcn_mbcnt_lo(~0u, (unsigned)z)); }
namespace pg8 {
#define PG8_LAS __attribute__((address_space(3)))
typedef unsigned short bf16_t;
typedef short bf16x8 __attribute__((ext_vector_type(8)));
typedef float f32x4 __attribute__((ext_vector_type(4)));
typedef unsigned u32x4 __attribute__((ext_vector_type(4)));
constexpr int BM = 256, BK = 64, HALF = 128, HTB = HALF * BK * 2  , STAGE_BYTES = 8 * HTB, NXCD = 8, WGM = 8;

__host__ __device__ __forceinline__ int lds_byte(int r, int c) { const int st = (r >> 4) * 2 + (c >> 5), rr = r & 15, cc = c & 31, ob = rr * 64 + cc * 2; return st * 1024 + (ob ^ (((ob >> 9) & 1) << 5)); }
__host__ __device__ __forceinline__ void stage_rc(int b, int& R, int& C) { const int st = b / 1024, sb = b % 1024, swz = sb ^ (((sb >> 9) & 1) << 5); R = (st >> 1) * 16 + swz / 64; C = (st & 1) * 32 + (swz % 64) / 2; }
__host__ __device__ __forceinline__ int perm32(int rho) { const int n = rho >> 4, i = rho & 15; return 8 * (i >> 2) + 4 * n + (i & 3); }

struct Unit { int pm, pn; };
struct Gemm { const bf16_t* A; const bf16_t* Bt; int M, N, K, tid; };

struct StaticOrder {
    int nM, nN, nwg, G, c;
    __host__ __device__ void init(int M, int N, int G_, int c_) { nM = M / BM; nN = N / BM; nwg = nM * nN; G = G_; c = c_; }
    __host__ __device__ bool next(int i, Unit& u) const {
        const long L = (long)i * G + c; if (L >= nwg) return false;
        int wgid = (int)L; { const int q = nwg / NXCD, r = nwg % NXCD, xcd = wgid % NXCD, off = wgid / NXCD; wgid = (xcd < r ? xcd * (q + 1) : r * (q + 1) + (xcd - r) * q) + off; }
        const int nig = WGM * nN, gid = wgid / nig, fm = gid * WGM, gsz = (nM - fm) < WGM ? (nM - fm) : WGM;
        u.pm = fm + ((wgid % nig) % gsz); u.pn = (wgid % nig) / gsz; return true;
    }
    __device__ __forceinline__ void a_ready(const Unit&) const {}
    __device__ __forceinline__ void done(const Unit&) const {}
};

__device__ __forceinline__ unsigned cvt_pk_bf16(float lo, float hi) { unsigned r; asm volatile("v_cvt_pk_bf16_f32 %0, %1, %2" : "=v"(r) : "v"(lo), "v"(hi)); return r; }

template <int ACT> struct EpiBf16 {
    static constexpr bool PERM = true, AFTER_DRAIN = false;
    bf16_t* O; int ldc;
    __device__ __forceinline__ void operator()(const f32x4 (&acc)[2][2][4][2], const Unit& u, int wr, int wc, int fr, int fq) const {
        const int row0 = u.pm * BM + wr * 64 + fr, col0 = u.pn * BM + wc * 32 + 8 * fq;
#pragma unroll
        for (int ai = 0; ai < 2; ++ai)
#pragma unroll
            for (int m = 0; m < 4; ++m) { bf16_t* rowp = O + (size_t)(row0 + ai * HALF + m * 16) * ldc + col0;
#pragma unroll
                for (int bj = 0; bj < 2; ++bj) { f32x4 v0 = acc[ai][bj][m][0], v1 = acc[ai][bj][m][1];
                    if (ACT == 1) {
#pragma unroll
                        for (int e = 0; e < 4; ++e) { float a = v0[e] > 0.f ? v0[e] : 0.f; v0[e] = a * a; float b = v1[e] > 0.f ? v1[e] : 0.f; v1[e] = b * b; } }
                    u32x4 w; w.x = cvt_pk_bf16(v0[0], v0[1]); w.y = cvt_pk_bf16(v0[2], v0[3]); w.z = cvt_pk_bf16(v1[0], v1[1]); w.w = cvt_pk_bf16(v1[2], v1[3]);
                    *(u32x4*)(rowp + bj * HALF) = w; } }
    }
};
struct EpiSumsq {
    static constexpr bool PERM = true, AFTER_DRAIN = false;
    bf16_t* O; int ldc; float* ss;
    __device__ __forceinline__ void operator()(const f32x4 (&acc)[2][2][4][2], const Unit& u, int wr, int wc, int fr, int fq) const {
        const int row0 = u.pm * BM + wr * 64 + fr, col0 = u.pn * BM + wc * 32 + 8 * fq;
#pragma unroll
        for (int ai = 0; ai < 2; ++ai)
#pragma unroll
            for (int m = 0; m < 4; ++m) { const int row = row0 + ai * HALF + m * 16; bf16_t* rowp = O + (size_t)row * ldc + col0; float s = 0.f;
#pragma unroll
                for (int bj = 0; bj < 2; ++bj) { const f32x4 v0 = acc[ai][bj][m][0], v1 = acc[ai][bj][m][1];
                    s += (v0[0] * v0[0] + v0[1] * v0[1]) + (v0[2] * v0[2] + v0[3] * v0[3]) + (v1[0] * v1[0] + v1[1] * v1[1]) + (v1[2] * v1[2] + v1[3] * v1[3]);
                    u32x4 w; w.x = cvt_pk_bf16(v0[0], v0[1]); w.y = cvt_pk_bf16(v0[2], v0[3]); w.z = cvt_pk_bf16(v1[0], v1[1]); w.w = cvt_pk_bf16(v1[2], v1[3]);
                    *(u32x4*)(rowp + bj * HALF) = w; }
                s += __shfl_xor(s, 16); s += __shfl_xor(s, 32);
                if (fq == 0) atomicAdd(ss + row, s); }
    }
};
struct EpiFilt {
    static constexpr bool PERM = false, AFTER_DRAIN = false;
    float* F; const float* decay;
    __device__ __forceinline__ void operator()(const f32x4 (&acc)[2][2][4][2], const Unit& u, int wr, int wc, int fr, int fq) const {
        const int row0 = u.pm * BM + wr * 64 + fr, col0 = u.pn * BM + wc * 32 + 4 * fq;
#pragma unroll
        for (int bj = 0; bj < 2; ++bj)
#pragma unroll
            for (int n = 0; n < 2; ++n) {
                const int cb = col0 + bj * HALF + n * 16;
                const f32x4 dc = *(const f32x4*)(decay + cb);
#pragma unroll
                for (int e = 0; e < 4; ++e) { const int col = cb + e; const float ad = __builtin_fabsf(dc[e]);
                    float* fp = F + (size_t)((((col & 255) * 2 + (col >> 9)) * 2) + ((col >> 8) & 1)) * 16384;
#pragma unroll
                    for (int ai = 0; ai < 2; ++ai)
#pragma unroll
                        for (int m = 0; m < 4; ++m) { const int r = row0 + ai * HALF + m * 16; const float t = (float)r * (1.0f / 16384.0f);
                            fp[r] = acc[ai][bj][m][n][e] * expf(-t * ad); } } }
    }
};

template <class Epi, class Sched, bool ALIGN_EPI = false, bool SP2 = false>
__device__ __forceinline__ void gemm_phase(PG8_LAS unsigned char* lds, const Gemm g, const Sched& S, const Epi& E) {
    const int tid = g.tid, wid = __builtin_amdgcn_readfirstlane(tid >> 6), lane = tid & 63, wr = wid >> 2, wc = wid & 3, fr = lane & 15, fq = lane >> 4;
    const int K = g.K, nt = K / BK;
    unsigned voffA[2], voffB[2];
#pragma unroll
    for (int i = 0; i < 2; ++i) { int R, C; stage_rc(tid * 16 + i * 8192, R, C); const int Rb = Epi::PERM ? ((R & ~31) + perm32(R & 31)) : R;
        voffA[i] = (unsigned)(R * K + C) * 2u; voffB[i] = (unsigned)(Rb * K + C) * 2u; }
    const size_t kstep = (size_t)(BK * 2);
    const size_t hstep = (size_t)HALF * K * 2;
    const size_t tstep = 2 * hstep;
    const unsigned ldsw = (unsigned)wid * 1024u;
    const int aoff = lds_byte(wr * 64 + fr, fq * 8), boff = lds_byte(wc * 32 + fr, fq * 8);
#define PG8_SA(b, h) (((b) * 2 + (h)) * HTB)
#define PG8_SB(b, h) ((4 + (b) * 2 + (h)) * HTB)
#define PG8_STAGE(bufoff, gbase, voff) do { _Pragma("unroll") for (int _i = 0; _i < 2; ++_i) \
        __builtin_amdgcn_global_load_lds((const unsigned*)((const char*)(gbase) + (voff)[_i]), (PG8_LAS unsigned*)(lds + (bufoff) + ldsw + _i * 8192), 16, 0, 0); } while (0)
#define PG8_LDA(dst, b, h) do { _Pragma("unroll") for (int m = 0; m < 4; ++m) _Pragma("unroll") for (int k = 0; k < 2; ++k) dst[m][k] = *(const PG8_LAS bf16x8*)(lds + PG8_SA(b, h) + aoff + m * 2048 + k * 1024); } while (0)
#define PG8_LDB(dst, b, h) do { _Pragma("unroll") for (int n = 0; n < 2; ++n) _Pragma("unroll") for (int k = 0; k < 2; ++k) dst[n][k] = *(const PG8_LAS bf16x8*)(lds + PG8_SB(b, h) + boff + n * 2048 + k * 1024); } while (0)
#define PG8_MMA(ai, bj, At, Bt) do { __builtin_amdgcn_s_setprio(1); _Pragma("unroll") for (int m = 0; m < 4; ++m) _Pragma("unroll") for (int n = 0; n < 2; ++n) _Pragma("unroll") for (int k = 0; k < 2; ++k) \
        acc[ai][bj][m][n] = __builtin_amdgcn_mfma_f32_16x16x32_bf16(Bt[n][k], At[m][k], acc[ai][bj][m][n], 0, 0, 0); __builtin_amdgcn_s_setprio(0); } while (0)
#define PG8_WAIT_V(n) asm volatile("s_waitcnt vmcnt(" #n ")" ::: "memory")
#define PG8_WAIT_L(n) asm volatile("s_waitcnt lgkmcnt(" #n ")" ::: "memory")
#define PG8_BAR __builtin_amdgcn_s_barrier()
#define PG8_SCHED __builtin_amdgcn_sched_barrier(0)
    Unit cur, nxt; int ui = 0;
    if (!S.next(0, cur)) return;
    f32x4 acc[2][2][4][2];
#pragma unroll
    for (int a = 0; a < 2; ++a)
#pragma unroll
        for (int b = 0; b < 2; ++b)
#pragma unroll
            for (int m = 0; m < 4; ++m)
#pragma unroll
                for (int n = 0; n < 2; ++n) acc[a][b][m][n] = (f32x4){0.f, 0.f, 0.f, 0.f};
    bf16x8 At[4][2], B0[2][2], B1[2][2];
    const char* cA = (const char*)g.A + (size_t)cur.pm * tstep; const char* cB = (const char*)g.Bt + (size_t)cur.pn * tstep;
    S.a_ready(cur);
    if constexpr (SP2) {
        PG8_STAGE(PG8_SB(0, 0), cB, voffB); PG8_STAGE(PG8_SB(0, 1), cB + hstep, voffB); PG8_STAGE(PG8_SA(0, 0), cA, voffA); PG8_STAGE(PG8_SA(0, 1), cA + hstep, voffA);
        if (wr == 1) PG8_BAR;
        PG8_WAIT_V(2); PG8_BAR;
        PG8_STAGE(PG8_SB(1, 0), cB + kstep, voffB); PG8_STAGE(PG8_SA(1, 0), cA + kstep, voffA); PG8_STAGE(PG8_SB(1, 1), cB + hstep + kstep, voffB);
        PG8_WAIT_V(6); PG8_BAR;
    } else {
        PG8_STAGE(PG8_SB(0, 0), cB, voffB); PG8_STAGE(PG8_SA(0, 0), cA, voffA); PG8_STAGE(PG8_SB(0, 1), cB + hstep, voffB); PG8_STAGE(PG8_SA(0, 1), cA + hstep, voffA);
        if (wr == 1) PG8_BAR;
        PG8_WAIT_V(4); PG8_BAR;
        PG8_STAGE(PG8_SB(1, 0), cB + kstep, voffB); PG8_STAGE(PG8_SA(1, 0), cA + kstep, voffA); PG8_STAGE(PG8_SB(1, 1), cB + hstep + kstep, voffB);
        PG8_WAIT_V(6); PG8_BAR;
    }
    for (;;) {
        const bool has_next = S.next(ui + 1, nxt);
        const char* nA = has_next ? (const char*)g.A + (size_t)nxt.pm * tstep : cA; const char* nB = has_next ? (const char*)g.Bt + (size_t)nxt.pn * tstep : cB;
        for (int t = 0; t < nt; t += 2) {
            const bool last = (t == nt - 2);
            const char* a1 = cA + (size_t)(t + 1) * kstep;
            const char* a2 = last ? nA : cA + (size_t)(t + 2) * kstep; const char* b2 = last ? nB : cB + (size_t)(t + 2) * kstep;
            const char* a3 = a2 + kstep; const char* b3 = b2 + kstep;
            if (last && has_next) S.a_ready(nxt);
            if constexpr (SP2) {
            PG8_LDB(B0, 0, 0); PG8_LDB(B1, 0, 1); PG8_SCHED; PG8_LDA(At, 0, 0); PG8_STAGE(PG8_SA(1, 1), a1 + hstep, voffA);
            PG8_WAIT_V(8); PG8_WAIT_L(0); PG8_BAR; PG8_MMA(0, 0, At, B0); PG8_MMA(0, 1, At, B1); PG8_BAR; PG8_SCHED;
            PG8_LDA(At, 0, 1); PG8_STAGE(PG8_SB(0, 0), b2, voffB); PG8_STAGE(PG8_SB(0, 1), b2 + hstep, voffB); PG8_STAGE(PG8_SA(0, 0), a2, voffA);
            PG8_WAIT_V(8); PG8_WAIT_L(0); PG8_BAR; PG8_MMA(1, 0, At, B0); PG8_MMA(1, 1, At, B1); PG8_BAR; PG8_SCHED;
            PG8_LDB(B0, 1, 0); PG8_LDB(B1, 1, 1); PG8_SCHED; PG8_LDA(At, 1, 0); PG8_STAGE(PG8_SA(0, 1), a2 + hstep, voffA);
            PG8_WAIT_V(8); PG8_WAIT_L(0); PG8_BAR; PG8_MMA(0, 0, At, B0); PG8_MMA(0, 1, At, B1); PG8_BAR; PG8_SCHED;
            PG8_LDA(At, 1, 1); PG8_STAGE(PG8_SB(1, 0), b3, voffB); PG8_STAGE(PG8_SB(1, 1), b3 + hstep, voffB); PG8_STAGE(PG8_SA(1, 0), a3, voffA);
            PG8_WAIT_V(8); PG8_WAIT_L(0); PG8_BAR; PG8_MMA(1, 0, At, B0); PG8_MMA(1, 1, At, B1); PG8_BAR; PG8_SCHED;
            } else {
            PG8_LDB(B0, 0, 0); PG8_SCHED; PG8_LDA(At, 0, 0); PG8_STAGE(PG8_SA(1, 1), a1 + hstep, voffA);
            PG8_WAIT_L(8); PG8_BAR; PG8_WAIT_L(0); PG8_MMA(0, 0, At, B0); PG8_BAR; PG8_SCHED;
            PG8_LDB(B1, 0, 1); PG8_STAGE(PG8_SB(0, 0), b2, voffB);
            PG8_BAR; PG8_WAIT_L(0); PG8_MMA(0, 1, At, B1); PG8_BAR;
            PG8_LDA(At, 0, 1); PG8_STAGE(PG8_SA(0, 0), a2, voffA);
            PG8_BAR; PG8_WAIT_L(0); PG8_MMA(1, 0, At, B0); PG8_BAR; PG8_SCHED;
            PG8_STAGE(PG8_SB(0, 1), b2 + hstep, voffB);
            PG8_WAIT_V(6); PG8_BAR; PG8_MMA(1, 1, At, B1); PG8_BAR;
            PG8_LDB(B0, 1, 0); PG8_SCHED; PG8_LDA(At, 1, 0); PG8_STAGE(PG8_SA(0, 1), a2 + hstep, voffA);
            PG8_WAIT_L(8); PG8_BAR; PG8_WAIT_L(0); PG8_MMA(0, 0, At, B0); PG8_BAR; PG8_SCHED;
            PG8_LDB(B1, 1, 1); PG8_STAGE(PG8_SB(1, 0), b3, voffB);
            PG8_BAR; PG8_WAIT_L(0); PG8_MMA(0, 1, At, B1); PG8_BAR;
            PG8_LDA(At, 1, 1); PG8_STAGE(PG8_SA(1, 0), a3, voffA);
            PG8_BAR; PG8_WAIT_L(0); PG8_MMA(1, 0, At, B0); PG8_BAR; PG8_SCHED;
            PG8_STAGE(PG8_SB(1, 1), b3 + hstep, voffB);
            PG8_WAIT_V(6); PG8_BAR; PG8_MMA(1, 1, At, B1); PG8_BAR;
            }
        }
        if constexpr (ALIGN_EPI) { if (wr == 0) PG8_BAR; }
        if constexpr (!Epi::AFTER_DRAIN) { E(acc, cur, wr, wc, fr, fq); S.done(cur); }
        if (!has_next) break;
#pragma unroll
        for (int a = 0; a < 2; ++a)
#pragma unroll
            for (int b = 0; b < 2; ++b)
#pragma unroll
                for (int m = 0; m < 4; ++m)
#pragma unroll
                    for (int n = 0; n < 2; ++n) acc[a][b][m][n] = (f32x4){0.f, 0.f, 0.f, 0.f};
        cur = nxt; cA = nA; cB = nB; ++ui;
        if constexpr (ALIGN_EPI) { if (wr == 1) PG8_BAR; }
    }
    PG8_WAIT_V(0);
    if constexpr (!ALIGN_EPI) { if (wr == 0) PG8_BAR; }
    PG8_BAR;
    if constexpr (Epi::AFTER_DRAIN) { E.fused(acc, cur, wr, wc, fr, fq, lds, wid, lane); S.done(cur); }
#undef PG8_SA
#undef PG8_SB
#undef PG8_STAGE
#undef PG8_LDA
#undef PG8_LDB
#undef PG8_MMA
#undef PG8_WAIT_V
#undef PG8_WAIT_L
#undef PG8_BAR
#undef PG8_SCHED
}
}
#define LAS __attribute__((address_space(3)))
typedef unsigned short bf16_t;
typedef short bf16x8 __attribute__((ext_vector_type(8)));
typedef float f32x4 __attribute__((ext_vector_type(4)));
typedef float f32x2 __attribute__((ext_vector_type(2)));
typedef float f32x16 __attribute__((ext_vector_type(16)));
typedef unsigned u32x4 __attribute__((ext_vector_type(4)));
typedef unsigned u32x2 __attribute__((ext_vector_type(2)));

constexpr int LCTX = 256, LSEQ = 16384, R = LCTX + LSEQ;
constexpr int DM = 1024, NIN = 1792, FF = 4096, NLAYER = 4;
constexpr int NFFT = 16384;
constexpr int NCH = R / 16;
constexpr float EPS = 1e-6f;
constexpr float QSCALE = 0.125f * 1.4426950408889634f;
constexpr size_t KiB = 1024, MiB = 1024 * 1024;
constexpr size_t WS_SS1 = 0, WS_SS2 = 128 * KiB, WS_MODV = 256 * KiB, WS_TW = 512 * KiB, WS_LAMT = 640 * KiB, WS_H2C = 704 * KiB;
constexpr size_t WS_BAR = 768 * KiB;
constexpr size_t WS_XC = 1 * MiB;
constexpr size_t WS_WIN = 2 * MiB, WS_WOUT = 6 * MiB, WS_W1 = 8 * MiB, WS_W2 = 16 * MiB, WS_W3T = 24 * MiB, WS_GLUT = 24 * MiB + 512 * KiB;
constexpr size_t WS_S5M = 25 * MiB;
constexpr size_t WS_KCT = 33 * MiB;
constexpr size_t WS_H2L = 34 * MiB;
constexpr size_t WS_H = 38 * MiB;
constexpr size_t WS_VXT = 38 * MiB, WS_Z2T = 62 * MiB;
constexpr size_t WS_OL = 71 * MiB;
constexpr size_t WS_SC = 71 * MiB, WS_HIN = WS_SC + (size_t)32 * NCH * 128 * 4;
constexpr size_t WS_U = 104 * MiB, WS_MERGED = 161 * MiB, WS_QN = 194 * MiB, WS_GBUF = WS_QN, WS_KN = 203 * MiB, WS_FILT = 208 * MiB, WS_Z1 = 272 * MiB;
constexpr size_t WS_HID = 104 * MiB;
constexpr size_t WS_ROPE = 288 * MiB;
constexpr size_t WS_END = 292 * MiB;
constexpr int LDS_BYTES = 138 * 1024;

struct P { const float* in[37]; float* out; unsigned char* ws; int lo, hi; };
__device__ __forceinline__ int lnd(int i) { asm volatile("" : "+v"(i)); return __builtin_amdgcn_readfirstlane(i); }
#define PIN(i) (p.in[lnd(i)])
__device__ __forceinline__ unsigned char* lndp(unsigned char* q) { unsigned lo = (unsigned)(uintptr_t)q, hi = (unsigned)((uintptr_t)q >> 32); asm volatile("" : "+v"(lo), "+v"(hi)); lo = __builtin_amdgcn_readfirstlane(lo); hi = __builtin_amdgcn_readfirstlane(hi); return (unsigned char*)(((uintptr_t)hi << 32) | (uintptr_t)lo); }


__device__ __forceinline__ unsigned f2bf(float f) { unsigned u = __builtin_bit_cast(unsigned, f); return (u + 0x7fffu + ((u >> 16) & 1u)) >> 16; }
__device__ __forceinline__ unsigned pk2(float lo, float hi) { return f2bf(lo) | (f2bf(hi) << 16); }
__device__ __forceinline__ float bflo(unsigned w) { return __builtin_bit_cast(float, w << 16); }
__device__ __forceinline__ float bfhi(unsigned w) { return __builtin_bit_cast(float, w & 0xffff0000u); }
__device__ __forceinline__ float bf1(bf16_t b) { return __builtin_bit_cast(float, (unsigned)b << 16); }
__device__ __forceinline__ float wave_sum(float v) {
#pragma unroll
    for (int o = 1; o < 64; o <<= 1) v += __shfl_xor(v, o);
    return v;
}
__device__ __forceinline__ f32x2 cmul(f32x2 a, f32x2 b) { return (f32x2){a.x * b.x - a.y * b.y, a.x * b.y + a.y * b.x}; }
__device__ __forceinline__ f32x2 cmulc(f32x2 a, f32x2 b) { return (f32x2){a.x * b.x + a.y * b.y, a.y * b.x - a.x * b.y}; }
__device__ __forceinline__ f32x2 cconj(f32x2 a) { return (f32x2){a.x, -a.y}; }

__device__ __forceinline__ void pro_mod(const int wave_s_, const P& p, LAS unsigned char* lds) { unsigned char* const wsb = lndp(p.ws); const int tidx_ = tid_of(wave_s_); const int bidx_ = lnds((int)blockIdx.x);
    const float* c = PIN(1); const float* cc = PIN(3); const float* mw = PIN(4); const float* mb = PIN(5);
    float* modv = (float*)(wsb + WS_MODV);
    LAS float* red = (LAS float*)lds;
    const int tid = tidx_, cq = tid & 15, ks = tid >> 4;
    for (int item = bidx_; item < 4 * 96; item += gridDim.x) {
        const int layer = item / 96, n0 = (item % 96) * 64;
        f32x4 aL = {0.f, 0.f, 0.f, 0.f}, aC = {0.f, 0.f, 0.f, 0.f};
        const float* wp = mw + ((size_t)layer * 1024 + ks * 32) * 6144 + n0 + 4 * cq;
        for (int k = 0; k < 32; ++k) {
            const float cv = c[ks * 32 + k], xv = cc[ks * 32 + k];
            const float sl = cv / (1.f + expf(-cv)), sc = xv / (1.f + expf(-xv));
            const f32x4 w = *(const f32x4*)(wp + (size_t)k * 6144);
            aL += w * sl; aC += w * sc;
        }
        LAS float* r = red + (ks * 16 + cq) * 8;
        r[0] = aL[0]; r[1] = aL[1]; r[2] = aL[2]; r[3] = aL[3]; r[4] = aC[0]; r[5] = aC[1]; r[6] = aC[2]; r[7] = aC[3];
        __syncthreads();
        if (tid < 128) { const int cq2 = tid & 15, j = tid >> 4; float s = 0.f;
            for (int k2 = 0; k2 < 32; ++k2) s += red[(k2 * 16 + cq2) * 8 + j];
            const int n = n0 + 4 * cq2 + (j & 3), stream = j >> 2;
            modv[(layer * 2 + stream) * 6144 + n] = s + mb[layer * 6144 + n]; }
        __syncthreads();
    }
}
__device__ __forceinline__ void pro_tables(const int wave_s_, const P& p) { unsigned char* const wsb = lndp(p.ws); const int tidx_ = tid_of(wave_s_); const int bidx_ = lnds((int)blockIdx.x);
    const int gt = bidx_ * 512 + tidx_, GT = gridDim.x * 512;
    f32x2* tw = (f32x2*)(wsb + WS_TW);
    for (int t = gt; t <= 8192; t += GT) { float s, c; sincospif((float)t * (1.0f / 8192.0f), &s, &c); tw[t] = (f32x2){c, -s}; }
    f32x2* rope = (f32x2*)(wsb + WS_ROPE);
    for (int i = gt; i < LSEQ * 32; i += GT) { const int t = i >> 5, j = i & 31; const int pos = j < 16 ? (t >> 6) : (t & 63);
        const float inv = powf(10000.0f, -(float)(2 * (j & 15)) / 32.0f); const float ang = (float)pos * inv; float s, c; sincosf(ang, &s, &c); rope[i] = (f32x2){c, s}; }
}
__device__ __forceinline__ void ew_phase(const int wave_s_, const P& p, int mode, int layer) { unsigned char* const wsb = lndp(p.ws); const int tidx_ = tid_of(wave_s_); const int bidx_ = lnds((int)blockIdx.x);
    const int lane = tidx_ & 63, wave = tidx_ >> 6;
    const int gw = bidx_ * 8 + wave, NGW = gridDim.x * 8;
    const float* modv = (const float*)(wsb + WS_MODV);
    const float* ss = (const float*)(wsb + (mode == 1 ? WS_SS1 : WS_SS2));
    const bf16_t* OL = (const bf16_t*)(wsb + WS_OL);
    bf16_t* H = (bf16_t*)(wsb + WS_H);
    float* xc = (float*)(wsb + WS_XC);
    const float* gpost = (mode == 1 ? PIN(7) : PIN(9)) + layer * 1024;
    const int gi = mode == 1 ? 2 : 5;
    const bool donorm = !(mode == 2 && layer == NLAYER - 1);
    const int nl = mode == 2 ? layer + 1 : layer;
    const float* gpre = (mode == 1 ? PIN(8) : PIN(6)) + (donorm ? nl : 0) * 1024;
    const int shi = mode == 1 ? 3 : 0, sci = mode == 1 ? 4 : 1;
    for (int row = gw; row < R; row += NGW) {
        const int stream = row < LCTX ? 1 : 0;
        float* xp = row < LCTX ? xc + (size_t)row * 1024 : p.out + (size_t)(row - LCTX) * 1024;
        const float* src = mode == 0 ? (row < LCTX ? PIN(2) + (size_t)row * 1024 : PIN(0) + (size_t)(row - LCTX) * 1024) : xp;
        f32x4 v[4];
#pragma unroll
        for (int j = 0; j < 4; ++j) v[j] = *(const f32x4*)(src + j * 256 + lane * 4);
        if (mode != 0) {
            const float rs = rsqrtf(ss[row] * (1.0f / 1024.0f) + EPS);
            const float* mg = modv + (layer * 2 + stream) * 6144 + gi * 1024;
#pragma unroll
            for (int j = 0; j < 4; ++j) { const int col = j * 256 + lane * 4;
                const f32x4 g = *(const f32x4*)(mg + col) * *(const f32x4*)(gpost + col) * rs;
                const u32x2 o = *(const u32x2*)(OL + (size_t)row * 1024 + col);
                v[j] += g * (f32x4){bflo(o.x), bfhi(o.x), bflo(o.y), bfhi(o.y)}; }
        }
#pragma unroll
        for (int j = 0; j < 4; ++j) *(f32x4*)(xp + j * 256 + lane * 4) = v[j];
        if (donorm) {
            float s = 0.f;
#pragma unroll
            for (int j = 0; j < 4; ++j) s += (v[j][0] * v[j][0] + v[j][1] * v[j][1]) + (v[j][2] * v[j][2] + v[j][3] * v[j][3]);
            s = wave_sum(s);
            const float rstd = rsqrtf(s * (1.0f / 1024.0f) + EPS);
            const float* msh = modv + (nl * 2 + stream) * 6144 + shi * 1024; const float* msc = modv + (nl * 2 + stream) * 6144 + sci * 1024;
#pragma unroll
            for (int j = 0; j < 4; ++j) { const int col = j * 256 + lane * 4;
                const f32x4 y = v[j] * rstd * *(const f32x4*)(gpre + col) * (*(const f32x4*)(msc + col) + 1.0f) + *(const f32x4*)(msh + col);
                u32x2 w; w.x = pk2(y[0], y[1]); w.y = pk2(y[2], y[3]);
                *(u32x2*)(H + (size_t)row * 1024 + col) = w; }
        }
    }
}
__device__ __forceinline__ void transpose_item(const float* W, int K, int N, bf16_t* WT, int ldo, LAS float* scr, int item, int lane) {
    const int nblk = N / 32, kb = item / nblk, nb = item % nblk, k0 = 64 * kb, n0 = 32 * nb;
#pragma unroll 8
    for (int i = 0; i < 32; ++i) { const int kk = 2 * i + (lane >> 5); scr[kk * 33 + (lane & 31)] = W[(size_t)(k0 + kk) * N + n0 + (lane & 31)]; }
    asm volatile("s_waitcnt lgkmcnt(0)" ::: "memory");
    const int c = lane & 7;
#pragma unroll
    for (int j = 0; j < 4; ++j) { const int n = (lane >> 3) + 8 * j; const LAS float* s = scr + (8 * c) * 33 + n;
        u32x4 o; o.x = pk2(s[0 * 33], s[1 * 33]); o.y = pk2(s[2 * 33], s[3 * 33]); o.z = pk2(s[4 * 33], s[5 * 33]); o.w = pk2(s[6 * 33], s[7 * 33]);
        *(u32x4*)(WT + (size_t)(n0 + n) * ldo + k0 + 8 * c) = o; }
    asm volatile("s_waitcnt lgkmcnt(0)" ::: "memory");
}
__device__ __forceinline__ void prep_layer(const int wave_s_, const P& p, int l, LAS unsigned char* lds) { unsigned char* const wsb = lndp(p.ws); const int tidx_ = tid_of(wave_s_); const int bidx_ = lnds((int)blockIdx.x);
    const int tid = tidx_, lane = tid & 63, wave = tid >> 6;
    const int gw = bidx_ * 8 + wave, NGW = gridDim.x * 8;
    const int gt = bidx_ * 512 + tid, GT = gridDim.x * 512;
    {
        LAS float* scr = (LAS float*)(lds + wave * 16384);
        bf16_t* WIN = (bf16_t*)(wsb + WS_WIN); bf16_t* WOUT = (bf16_t*)(wsb + WS_WOUT); bf16_t* W1 = (bf16_t*)(wsb + WS_W1); bf16_t* W2 = (bf16_t*)(wsb + WS_W2);
        bf16_t* W3T = (bf16_t*)(wsb + WS_W3T); bf16_t* GLUT = (bf16_t*)(wsb + WS_GLUT);
        constexpr int I_IN = 16 * 56, I_OUT = 16 * 32, I_1 = 16 * 128, I_2 = 64 * 32, I_3 = 1 * 32, I_G = 4 * 8;
        constexpr int NIT = I_IN + I_OUT + I_1 + I_2 + I_3 + I_G;
        for (int it = gw; it < NIT; it += NGW) {
            int r = it;
            if (r < I_IN) { transpose_item(PIN(10) + (size_t)l * DM * NIN, DM, NIN, WIN, DM, scr, r, lane); continue; } r -= I_IN;
            if (r < I_OUT) { transpose_item(PIN(11) + (size_t)l * DM * DM, DM, DM, WOUT, DM, scr, r, lane); continue; } r -= I_OUT;
            if (r < I_1) { transpose_item(PIN(35) + (size_t)l * DM * FF, DM, FF, W1, DM, scr, r, lane); continue; } r -= I_1;
            if (r < I_2) { transpose_item(PIN(36) + (size_t)l * FF * DM, FF, DM, W2, FF, scr, r, lane); continue; } r -= I_2;
            if (r < I_3) { transpose_item(PIN(18) + (size_t)l * 64 * 1024, 64, 1024, W3T, 128, scr, r, lane); continue; } r -= I_3;
            transpose_item(PIN(29) + (size_t)l * 256 * 256, 256, 256, GLUT, 256, scr, r, lane);
        }
        bf16_t* H2L = (bf16_t*)(wsb + WS_H2L);
        const u32x4 z4 = {0u, 0u, 0u, 0u};
        for (int i = gt; i < 1024 * 8; i += GT) *(u32x4*)(W3T + (size_t)(i >> 3) * 128 + 64 + (i & 7) * 8) = z4;
        for (int i = gt; i < 16384 * 8; i += GT) *(u32x4*)(H2L + (size_t)(i >> 3) * 128 + 64 + (i & 7) * 8) = z4;
    }
    __syncthreads();
    {
        LAS f32x2* pw = (LAS f32x2*)lds;
        LAS f32x2* bb = pw + 17 * 64;
        LAS f32x2* cc = bb + 64 * 16;
        LAS f32x2* crci = cc + 16 * 64;
        LAS float* kt = (LAS float*)(crci + 64);
        float* lamT = (float*)(wsb + WS_LAMT);
        for (int dg = bidx_; dg < 32; dg += gridDim.x) {
            const int dir = dg >> 4, g = dg & 15; const int pb = ((l * 2 + dir) * 16 + g);
            if (tid < 64) {
                const float are = PIN(21)[pb * 64 + tid], aim = PIN(22)[pb * 64 + tid]; const float dt = expf(PIN(23)[pb]);
                const float mag = expf(are * dt), ang = aim * dt; const float lr = mag * cosf(ang), li = mag * sinf(ang);
                const float den = are * are + aim * aim, nr = lr - 1.0f, ni = li;
                crci[tid] = (f32x2){(nr * are + ni * aim) / den, (ni * are - nr * aim) / den};
                f32x2 w = {1.f, 0.f}; const f32x2 lam = {lr, li};
                for (int k = 0; k <= 16; ++k) { pw[k * 64 + tid] = w; w = cmul(w, lam); }
                const f32x2 l16 = pw[16 * 64 + tid]; lamT[dg * 128 + tid] = l16.x; lamT[dg * 128 + 64 + tid] = l16.y;
            }
            __syncthreads();
            for (int idx = tid; idx < 1024; idx += 512) {
                { const int pp = idx >> 4, h = idx & 15; const float bre = PIN(24)[(size_t)(pb * 64 + pp) * 16 + h], bim = PIN(25)[(size_t)(pb * 64 + pp) * 16 + h]; const f32x2 cr = crci[pp];
                  bb[idx] = (f32x2){cr.x * bre - cr.y * bim, cr.x * bim + cr.y * bre}; }
                { cc[idx] = (f32x2){PIN(26)[(size_t)pb * 1024 + idx], PIN(27)[(size_t)pb * 1024 + idx]}; }
            }
            __syncthreads();
            for (int idx = tid; idx < 4096; idx += 512) { const int k = idx >> 8, hp = (idx >> 4) & 15, h = idx & 15; float s = 0.f;
                for (int pp = 0; pp < 64; ++pp) { const f32x2 t = cmul(cc[hp * 64 + pp], pw[k * 64 + pp]); const f32x2 b = bb[pp * 16 + h]; s += t.x * b.x - t.y * b.y; }
                kt[idx] = s; }
            __syncthreads();
            unsigned* KI = (unsigned*)(wsb + WS_S5M + (size_t)dg * 256 * KiB); unsigned* BB = KI + 32768; unsigned* CC = BB + 16384;
            const float* dsk = PIN(28) + l * 256 + g * 16;
            for (int i2 = tid; i2 < 32768; i2 += 512) { const int n = i2 >> 7, kp = i2 & 127, kk = 2 * kp, s = kk >> 4, h = kk & 15, t = n >> 4, hp = n & 15;
                const int lag = dir == 0 ? t - s : s - t; float v0 = 0.f, v1 = 0.f;
                if (lag >= 0) { v0 = kt[(lag * 16 + hp) * 16 + h]; v1 = kt[(lag * 16 + hp) * 16 + h + 1]; }
                if (dir == 0 && lag == 0) { if (h == hp) v0 += dsk[hp]; if (h + 1 == hp) v1 += dsk[hp]; }
                KI[i2] = pk2(v0, v1); }
            for (int i2 = tid; i2 < 16384; i2 += 512) { const int col = i2 >> 7, kp = i2 & 127, kk = 2 * kp, s = kk >> 4, h = kk & 15, ri = col >> 6, pp = col & 63;
                const int e = dir == 0 ? 15 - s : s; const f32x2 w = pw[e * 64 + pp]; const f32x2 a = cmul(w, bb[pp * 16 + h]), b = cmul(w, bb[pp * 16 + h + 1]);
                BB[i2] = ri == 0 ? pk2(a.x, b.x) : pk2(a.y, b.y); }
            for (int i2 = tid; i2 < 16384; i2 += 512) { const int n = i2 >> 6, cp = i2 & 63, col = 2 * cp, ri = col >> 6, pp = col & 63, t = n >> 4, hp = n & 15;
                const int e = dir == 0 ? t + 1 : 16 - t; const f32x2 a = cmul(cc[hp * 64 + pp], pw[e * 64 + pp]), b = cmul(cc[hp * 64 + pp + 1], pw[e * 64 + pp + 1]);
                CC[i2] = ri == 0 ? pk2(a.x, b.x) : pk2(-a.y, -b.y); }
            __syncthreads();
        }
    }
    {
        LAS float* w1s = (LAS float*)lds; LAS float* b1s = w1s + 33 * 64; LAS float* w2s = b1s + 64; LAS float* b2s = w2s + 4096;
        __syncthreads();
        for (int i = tid; i < 33 * 64; i += 512) w1s[i] = PIN(14)[l * 33 * 64 + i];
        for (int i = tid; i < 4096; i += 512) w2s[i] = PIN(16)[l * 4096 + i];
        if (tid < 64) { b1s[tid] = PIN(15)[l * 64 + tid]; b2s[tid] = PIN(17)[l * 64 + tid]; }
        __syncthreads();
        bf16_t* H2L = (bf16_t*)(wsb + WS_H2L); float* H2C = (float*)(wsb + WS_H2C);
        for (int item = bidx_; item < 33; item += gridDim.x) {
            const bool isctx = item == 32; const int n = isctx ? tid : item * 512 + tid;
            if (!isctx || tid < 256) {
                const float t = (float)n / (isctx ? 256.0f : 16384.0f);
                float h1[64];
#pragma unroll
                for (int j = 0; j < 64; ++j) h1[j] = b1s[j] + t * w1s[j];
                _Pragma("nounroll") for (int f = 1; f <= 16; ++f) { float cs, sn; sincospif(2.0f * t * (float)f, &sn, &cs);
#pragma unroll
                    for (int j = 0; j < 64; ++j) h1[j] += cs * w1s[f * 64 + j] + sn * w1s[(16 + f) * 64 + j]; }
#pragma unroll
                for (int j = 0; j < 64; ++j) h1[j] = sinpif(h1[j] * 0.3183098861837907f);
                _Pragma("nounroll") for (int j = 0; j < 64; j += 2) { float a0 = b2s[j], a1 = b2s[j + 1];
#pragma unroll
                    for (int i = 0; i < 64; ++i) { a0 += h1[i] * w2s[i * 64 + j]; a1 += h1[i] * w2s[i * 64 + j + 1]; }
                    a0 = sinpif(a0 * 0.3183098861837907f); a1 = sinpif(a1 * 0.3183098861837907f);
                    if (isctx) { H2C[n * 64 + j] = a0; H2C[n * 64 + j + 1] = a1; } else *(unsigned*)(H2L + (size_t)n * 128 + j) = pk2(a0, a1); }
            }
        }
        __syncthreads();
    }
}

__device__ __forceinline__ void pb_attprep(const int wave_s_, const P& p, int l) { unsigned char* const wsb = lndp(p.ws); const int tidx_ = tid_of(wave_s_); const int bidx_ = lnds((int)blockIdx.x);
    const int gt = bidx_ * 512 + tidx_, GT = gridDim.x * 512;
    const bf16_t* U = (const bf16_t*)(wsb + WS_U); bf16_t* QN = (bf16_t*)(wsb + WS_QN); bf16_t* KN = (bf16_t*)(wsb + WS_KN);
    const f32x2* rope = (const f32x2*)(wsb + WS_ROPE);
    for (int idx = gt; idx < R * 6; idx += GT) {
        const int row = idx / 6, slot = idx - row * 6;
        const bf16_t* src = U + (size_t)row * NIN + (slot < 4 ? 1280 + slot * 64 : 1536 + (slot - 4) * 64);
        const float* gain = (slot < 4 ? PIN(33) : PIN(34)) + l * 64;
        float x[64]; float ms = 0.f;
#pragma unroll
        for (int c = 0; c < 8; ++c) { const u32x4 w = *(const u32x4*)(src + c * 8);
            x[c * 8 + 0] = bflo(w.x); x[c * 8 + 1] = bfhi(w.x); x[c * 8 + 2] = bflo(w.y); x[c * 8 + 3] = bfhi(w.y); x[c * 8 + 4] = bflo(w.z); x[c * 8 + 5] = bfhi(w.z); x[c * 8 + 6] = bflo(w.w); x[c * 8 + 7] = bfhi(w.w); }
#pragma unroll
        for (int d = 0; d < 64; ++d) ms += x[d] * x[d];
        const float rs = rsqrtf(ms * (1.0f / 64.0f) + EPS);
#pragma unroll
        for (int d = 0; d < 64; ++d) x[d] = x[d] * rs * gain[d];
        if (row >= LCTX) { const f32x2* rp = rope + (size_t)(row - LCTX) * 32;
#pragma unroll
            for (int i = 0; i < 32; ++i) { const f32x2 cs = rp[i]; const float x0 = x[2 * i], x1 = x[2 * i + 1]; x[2 * i] = x0 * cs.x - x1 * cs.y; x[2 * i + 1] = x0 * cs.y + x1 * cs.x; } }
        const float sc = slot < 4 ? QSCALE : 1.0f;
        bf16_t* dst = slot < 4 ? QN + (size_t)row * 256 + slot * 64 : KN + (size_t)row * 128 + (slot - 4) * 64;
#pragma unroll
        for (int c = 0; c < 8; ++c) { u32x4 w; w.x = pk2(x[c * 8] * sc, x[c * 8 + 1] * sc); w.y = pk2(x[c * 8 + 2] * sc, x[c * 8 + 3] * sc); w.z = pk2(x[c * 8 + 4] * sc, x[c * 8 + 5] * sc); w.w = pk2(x[c * 8 + 6] * sc, x[c * 8 + 7] * sc);
            *(u32x4*)(dst + c * 8) = w; }
    }
}
__device__ __forceinline__ void pb_s5local(const int wave_s_, const P& p) { unsigned char* const wsb = lndp(p.ws); const int tidx_ = tid_of(wave_s_); const int bidx_ = lnds((int)blockIdx.x);
    const int lane = tidx_ & 63, wave = tidx_ >> 6, gw = bidx_ * 8 + wave, NGW = gridDim.x * 8;
    const bf16_t* U = (const bf16_t*)(wsb + WS_U); float* SC = (float*)(wsb + WS_SC);
    const int m = lane & 15, kq = lane >> 4;
    for (int it = gw; it < 32 * 65; it += NGW) {
        const int dg = it / 65, ct = it - dg * 65, g = dg & 15;
        const bf16_t* BB = (const bf16_t*)(wsb + WS_S5M + (size_t)dg * 256 * KiB + 128 * KiB);
        f32x4 acc[8];
#pragma unroll
        for (int n = 0; n < 8; ++n) acc[n] = (f32x4){0.f, 0.f, 0.f, 0.f};
        const int chunk = ct * 16 + m;
        for (int ks = 0; ks < 8; ++ks) {
            const int k0 = ks * 32 + 8 * kq;
            const bf16x8 a = *(const bf16x8*)(U + (size_t)(chunk * 16 + (k0 >> 4)) * NIN + 768 + g * 16 + (k0 & 15));
#pragma unroll
            for (int n = 0; n < 8; ++n) { const bf16x8 b = *(const bf16x8*)(BB + (size_t)(n * 16 + m) * 256 + k0);
                acc[n] = __builtin_amdgcn_mfma_f32_16x16x32_bf16(a, b, acc[n], 0, 0, 0); }
        }
#pragma unroll
        for (int n = 0; n < 8; ++n)
#pragma unroll
            for (int i = 0; i < 4; ++i) SC[((size_t)dg * NCH + ct * 16 + 4 * kq + i) * 128 + n * 16 + m] = acc[n][i];
    }
}
__device__ __forceinline__ void pb_pool(const int wave_s_, const P& p, int l, LAS unsigned char* lds) { unsigned char* const wsb = lndp(p.ws); const int tidx_ = tid_of(wave_s_); const int bidx_ = lnds((int)blockIdx.x);
    const int tid = tidx_;
    const bf16_t* U = (const bf16_t*)(wsb + WS_U); bf16_t* MG = (bf16_t*)(wsb + WS_MERGED);
    LAS float* ut = (LAS float*)lds;
    LAS float* pt = ut + 80 * 64;
    LAS float* wt = pt + 64 * 65;
    for (int item = bidx_; item < 260 * 4; item += gridDim.x) {
        const int g = item & 3, r0 = (item >> 2) * 64; const int win = 2 << g, hw = win >> 1;
        const int seg0 = r0 < LCTX ? 0 : LCTX, seg1 = r0 < LCTX ? LCTX : R;
        __syncthreads();
        for (int i = tid; i < 80 * 8; i += 512) { const int rr = i >> 3, c8 = (i & 7) * 8; const int row = r0 - 8 + rr; f32x4 a = {0.f, 0.f, 0.f, 0.f}, b = a;
            if (row >= seg0 && row < seg1) { const u32x4 w = *(const u32x4*)(U + (size_t)row * NIN + 1024 + g * 64 + c8); a = (f32x4){bflo(w.x), bfhi(w.x), bflo(w.y), bfhi(w.y)}; b = (f32x4){bflo(w.z), bfhi(w.z), bflo(w.w), bfhi(w.w)}; }
            *(LAS f32x4*)(ut + rr * 64 + c8) = a; *(LAS f32x4*)(ut + rr * 64 + c8 + 4) = b; }
        for (int i = tid; i < 4096; i += 512) wt[i] = PIN(31)[(size_t)(l * 4 + g) * 4096 + i];
        __syncthreads();
        { const int t = tid >> 3, c8 = (tid & 7) * 8; const int row = r0 + t;
          int lo = row - hw; if (lo < seg0) lo = seg0; int hi = row + hw; if (hi > seg1) hi = seg1; const float inv = 1.0f / (float)(hi - lo);
#pragma unroll
          for (int c = 0; c < 8; ++c) { float s = 0.f; for (int rr = lo; rr < hi; ++rr) s += ut[(rr - r0 + 8) * 64 + c8 + c]; pt[t * 65 + c8 + c] = s * inv - ut[(t + 8) * 64 + c8 + c]; } }
        __syncthreads();
        { const int t = tid >> 3, d8 = (tid & 7) * 8; float acc[8];
#pragma unroll
          for (int d = 0; d < 8; ++d) acc[d] = 0.f;
          for (int c = 0; c < 64; ++c) { const float pv = pt[t * 65 + c]; const f32x4 w0 = *(const LAS f32x4*)(wt + c * 64 + d8), w1 = *(const LAS f32x4*)(wt + c * 64 + d8 + 4);
              acc[0] += pv * w0[0]; acc[1] += pv * w0[1]; acc[2] += pv * w0[2]; acc[3] += pv * w0[3]; acc[4] += pv * w1[0]; acc[5] += pv * w1[1]; acc[6] += pv * w1[2]; acc[7] += pv * w1[3]; }
          const float* sc = PIN(32) + l * 256 + g * 64 + d8;
          u32x4 w; w.x = pk2(acc[0] * sc[0], acc[1] * sc[1]); w.y = pk2(acc[2] * sc[2], acc[3] * sc[3]); w.z = pk2(acc[4] * sc[4], acc[5] * sc[5]); w.w = pk2(acc[6] * sc[6], acc[7] * sc[7]);
          *(u32x4*)(MG + (size_t)(r0 + t) * 1024 + 512 + g * 64 + d8) = w; }
    }
    __syncthreads();
}
__device__ __forceinline__ void pb_shortconv(const int wave_s_, const P& p, int l, LAS unsigned char* lds) { unsigned char* const wsb = lndp(p.ws); const int tidx_ = tid_of(wave_s_); const int bidx_ = lnds((int)blockIdx.x);
    const int tid = tidx_;
    const bf16_t* U = (const bf16_t*)(wsb + WS_U); bf16_t* VXT = (bf16_t*)(wsb + WS_VXT);
    LAS float* ut = (LAS float*)lds;
    const float* cw = PIN(12) + (size_t)l * 3 * 768; const float* cb = PIN(13) + l * 768;
    for (int item = bidx_; item < 256 * 12; item += gridDim.x) {
        const int cbk = item % 12, t0 = (item / 12) * 64, c0 = cbk * 64;
        __syncthreads();
        for (int i = tid; i < 66 * 8; i += 512) { const int rr = i >> 3, c8 = (i & 7) * 8; const int t = t0 - 1 + rr; f32x4 a = {0.f, 0.f, 0.f, 0.f}, b = a;
            if (t >= 0 && t < LSEQ) { const u32x4 w = *(const u32x4*)(U + (size_t)(LCTX + t) * NIN + c0 + c8); a = (f32x4){bflo(w.x), bfhi(w.x), bflo(w.y), bfhi(w.y)}; b = (f32x4){bflo(w.z), bfhi(w.z), bflo(w.w), bfhi(w.w)}; }
            LAS float* d = ut + rr * 65 + c8; d[0] = a[0]; d[1] = a[1]; d[2] = a[2]; d[3] = a[3]; d[4] = b[0]; d[5] = b[1]; d[6] = b[2]; d[7] = b[3]; }
        __syncthreads();
        { const int c = tid >> 3, t8 = (tid & 7) * 8; const int col = c0 + c; const float w0 = cw[col], w1 = cw[768 + col], w2 = cw[1536 + col], b = cb[col]; float y[8];
#pragma unroll
          for (int i = 0; i < 8; ++i) y[i] = b + w0 * ut[(t8 + i) * 65 + c] + w1 * ut[(t8 + i + 1) * 65 + c] + w2 * ut[(t8 + i + 2) * 65 + c];
          u32x4 w; w.x = pk2(y[0], y[1]); w.y = pk2(y[2], y[3]); w.z = pk2(y[4], y[5]); w.w = pk2(y[6], y[7]);
          *(u32x4*)(VXT + (size_t)col * LSEQ + t0 + t8) = w; }
    }
    __syncthreads();
}
__device__ __forceinline__ void pa_ctxtaps(const int wave_s_, const P& p, int l) { unsigned char* const wsb = lndp(p.ws); const int tidx_ = tid_of(wave_s_); const int bidx_ = lnds((int)blockIdx.x);
    const float* H2C = (const float*)(wsb + WS_H2C); float* KCT = (float*)(wsb + WS_KCT);
    const float* w3 = PIN(18) + (size_t)l * 64 * 1024; const float* dec = PIN(19) + l * 1024;
    for (int idx = bidx_ * 512 + tidx_; idx < 2 * 256 * 256; idx += gridDim.x * 512) {
        const int ch = idx & 255, n = (idx >> 8) & 255, o = idx >> 16;
        float af = 0.f, ab = 0.f;
#pragma unroll 8
        for (int j = 0; j < 64; ++j) { const float hv = H2C[n * 64 + j]; af += hv * w3[j * 1024 + o * 512 + ch]; ab += hv * w3[j * 1024 + o * 512 + 256 + ch]; }
        const float t = (float)n * (1.0f / 256.0f);
        float* kc = KCT + (size_t)(o * 256 + ch) * 512;
        kc[255 + n] = af * expf(-t * __builtin_fabsf(dec[o * 512 + ch])); if (n < 255) kc[254 - n] = ab * expf(-t * __builtin_fabsf(dec[o * 512 + 256 + ch])); else kc[511] = 0.f;
    }
}
__device__ __forceinline__ void pb_ctxhyena(const int wave_s_, const P& p, int l, LAS unsigned char* lds) { unsigned char* const wsb = lndp(p.ws); const int tidx_ = tid_of(wave_s_); const int bidx_ = lnds((int)blockIdx.x);
    const int tid = tidx_;
    const bf16_t* U = (const bf16_t*)(wsb + WS_U); bf16_t* MG = (bf16_t*)(wsb + WS_MERGED); const float* KCT = (const float*)(wsb + WS_KCT);
    LAS float* zc = (LAS float*)lds; LAS float* x1c = zc + 256; LAS float* x2c = zc + 512; LAS float* kc = zc + 768; LAS float* part = zc + 1280;
    const float* cw = PIN(12) + (size_t)l * 3 * 768; const float* cb = PIN(13) + l * 768;
    for (int ch = bidx_; ch < 256; ch += gridDim.x) {
        __syncthreads();
        if (tid < 256) { const int t = tid;
#pragma unroll
            for (int s = 0; s < 3; ++s) { const int col = s * 256 + ch; const float w0 = cw[col], w1 = cw[768 + col], w2 = cw[1536 + col], b = cb[col];
                const float um = t > 0 ? bf1(U[(size_t)(t - 1) * NIN + col]) : 0.f, u0 = bf1(U[(size_t)t * NIN + col]), up = t < 255 ? bf1(U[(size_t)(t + 1) * NIN + col]) : 0.f;
                (s == 0 ? zc : s == 1 ? x1c : x2c)[t] = b + w0 * um + w1 * u0 + w2 * up; } }
        for (int o = 0; o < 2; ++o) {
            kc[tid] = KCT[(size_t)(o * 256 + ch) * 512 + tid];
            __syncthreads();
            const int t = tid & 255, s0 = (tid >> 8) * 128; float y = 0.f;
#pragma unroll 8
            for (int s = 0; s < 128; ++s) y += zc[s0 + s] * kc[255 + t - s0 - s];
            part[tid] = y;
            __syncthreads();
            float zn = 0.f;
            if (tid < 256) zn = (o == 0 ? x1c[t] : x2c[t]) * (part[t] + part[256 + t] + PIN(20)[(l * 2 + o) * 256 + ch] * zc[t]);
            __syncthreads();
            if (tid < 256) zc[t] = zn;
            __syncthreads();
        }
        if (tid < 256) MG[(size_t)tid * 1024 + ch] = (bf16_t)f2bf(zc[tid]);
    }
    __syncthreads();
}

__device__ __forceinline__ void pc_s5carry(const int wave_s_, const P& p, LAS unsigned char* lds) { unsigned char* const wsb = lndp(p.ws); const int tidx_ = tid_of(wave_s_); const int bidx_ = lnds((int)blockIdx.x);
    const float* SC = (const float*)(wsb + WS_SC); float* HIN = (float*)(wsb + WS_HIN); const float* lamT = (const float*)(wsb + WS_LAMT);
    LAS f32x2* ex = (LAS f32x2*)lds;
    const int pl = tidx_ & 31, seg = tidx_ >> 5;
    for (int wb = bidx_; wb < 64; wb += gridDim.x) {
        const int chain = wb * 32 + pl, dg = chain >> 6, pp = chain & 63, dir = dg >> 4;
        const f32x2 lam = {lamT[dg * 128 + pp], lamT[dg * 128 + 64 + pp]};
        const float* sb = SC + (size_t)dg * NCH * 128 + pp; float* hb = HIN + (size_t)dg * NCH * 128 + pp;
        f32x2 h = {0.f, 0.f};
        for (int b0 = 0; b0 < 65; b0 += 13) {
            f32x2 sv[13];
#pragma unroll
            for (int j = 0; j < 13; ++j) { const int q = seg * 65 + b0 + j; const int c = dir == 0 ? q : (q < 16 ? 15 - q : NCH + 15 - q); sv[j] = (f32x2){sb[(size_t)c * 128], sb[(size_t)c * 128 + 64]}; }
#pragma unroll
            for (int j = 0; j < 13; ++j) h = cmul(lam, h) + sv[j];
        }
        __syncthreads();
        ex[seg * 32 + pl] = h;
        __syncthreads();
        f32x2 l65 = {1.f, 0.f};
        for (int k = 0; k < 65; ++k) l65 = cmul(l65, lam);
        f32x2 cin = {0.f, 0.f};
        for (int s2 = 0; s2 < seg; ++s2) cin = cmul(l65, cin) + ex[s2 * 32 + pl];
        h = cin;
        for (int b0 = 0; b0 < 65; b0 += 13) {
            f32x2 sv[13]; int cidx[13];
#pragma unroll
            for (int j = 0; j < 13; ++j) { const int q = seg * 65 + b0 + j; const int c = dir == 0 ? q : (q < 16 ? 15 - q : NCH + 15 - q); cidx[j] = c; sv[j] = (f32x2){sb[(size_t)c * 128], sb[(size_t)c * 128 + 64]}; }
#pragma unroll
            for (int j = 0; j < 13; ++j) { hb[(size_t)cidx[j] * 128] = h.x; hb[(size_t)cidx[j] * 128 + 64] = h.y; h = cmul(lam, h) + sv[j]; }
        }
    }
    __syncthreads();
}
typedef __bf16 bf16x2_t __attribute__((ext_vector_type(2)));
__device__ __forceinline__ unsigned cvtpk(float lo, float hi) { f32x2 v = {lo, hi}; bf16x2_t b = __builtin_convertvector(v, bf16x2_t); return __builtin_bit_cast(unsigned, b); }
constexpr float ATT_THR = 10.0f;
__device__ __forceinline__ void pc_attention(const int wave_s_, const P& p, LAS unsigned char* lds) { unsigned char* const wsb = lndp(p.ws); const int tidx_ = tid_of(wave_s_); const int bidx_ = lnds((int)blockIdx.x);
    const int tid = tidx_, lane = tid & 63, wave = tid >> 6, r32 = lane & 31, hi = lane >> 5;
    const bf16_t* U = (const bf16_t*)(wsb + WS_U); const bf16_t* QN = (const bf16_t*)(wsb + WS_QN); const bf16_t* KN = (const bf16_t*)(wsb + WS_KN); bf16_t* MG = (bf16_t*)(wsb + WS_MERGED);
    constexpr int RS = 72;
    LAS bf16_t* Ks = (LAS bf16_t*)lds;
    LAS bf16_t* Vs = Ks + 2 * 64 * RS;
    for (int unit = bidx_; unit < 260; unit += gridDim.x) {
        int kh, qb; if (unit < 256) { kh = unit & 1; qb = 2 + (unit >> 1); } else { kh = unit & 1; qb = (unit - 256) >> 1; }
        const int nt = qb < 2 ? 4 : 260;
        const int hq = kh * 2 + (wave >> 2); const int qrow = qb * 128 + (wave & 3) * 32 + r32;
        bf16x8 qr[4];
#pragma unroll
        for (int dk = 0; dk < 4; ++dk) qr[dk] = *(const bf16x8*)(QN + (size_t)qrow * 256 + hq * 64 + dk * 16 + hi * 8);
        f32x16 o0, o1, negm;
#pragma unroll
        for (int i = 0; i < 16; ++i) { o0[i] = 0.f; o1[i] = 0.f; negm[i] = 0.f; }
        float mref = 0.f, lsum = 0.f;
        const int klr = tid >> 3, kseg = (tid & 7) * 8;
        const int vlr = lane, vseg = wave * 8;
        const bf16_t* kg = KN + (size_t)klr * 128 + kh * 64 + kseg; const bf16_t* vg = U + (size_t)vlr * NIN + 1664 + kh * 64 + vseg;
        u32x4 kreg = *(const u32x4*)kg, vreg = *(const u32x4*)vg;
        __syncthreads();
        for (int t = 0; t < nt; ++t) {
            const int buf = t & 1;
            LAS bf16_t* Kb = Ks + buf * 64 * RS; LAS bf16_t* Vb = Vs + buf * 64 * RS;
            *(LAS u32x4*)(Kb + klr * RS + kseg) = kreg;
            { LAS bf16_t* vd = Vb + vseg * RS + vlr;
              vd[0 * RS] = (bf16_t)(vreg.x & 0xffffu); vd[1 * RS] = (bf16_t)(vreg.x >> 16); vd[2 * RS] = (bf16_t)(vreg.y & 0xffffu); vd[3 * RS] = (bf16_t)(vreg.y >> 16);
              vd[4 * RS] = (bf16_t)(vreg.z & 0xffffu); vd[5 * RS] = (bf16_t)(vreg.z >> 16); vd[6 * RS] = (bf16_t)(vreg.w & 0xffffu); vd[7 * RS] = (bf16_t)(vreg.w >> 16); }
            if (t + 1 < nt) { kreg = *(const u32x4*)(kg + (size_t)(t + 1) * 64 * 128); vreg = *(const u32x4*)(vg + (size_t)(t + 1) * 64 * NIN); }
            __syncthreads();
            f32x16 p0, p1;
            __builtin_amdgcn_s_setprio(1);
#pragma unroll
            for (int dk = 0; dk < 4; ++dk) {
                const bf16x8 a0 = *(const LAS bf16x8*)(Kb + r32 * RS + dk * 16 + hi * 8);
                const bf16x8 a1 = *(const LAS bf16x8*)(Kb + (32 + r32) * RS + dk * 16 + hi * 8);
                if (dk == 0) { p0 = __builtin_amdgcn_mfma_f32_32x32x16_bf16(a0, qr[0], negm, 0, 0, 0); p1 = __builtin_amdgcn_mfma_f32_32x32x16_bf16(a1, qr[0], negm, 0, 0, 0); }
                else { p0 = __builtin_amdgcn_mfma_f32_32x32x16_bf16(a0, qr[dk], p0, 0, 0, 0); p1 = __builtin_amdgcn_mfma_f32_32x32x16_bf16(a1, qr[dk], p1, 0, 0, 0); }
            }
            __builtin_amdgcn_s_setprio(0);
            float mx = fmaxf(fmaxf(p0[0], p0[1]), p1[0]);
#pragma unroll
            for (int i = 2; i < 16; i += 2) mx = fmaxf(fmaxf(mx, p0[i]), p0[i + 1]);
#pragma unroll
            for (int i = 1; i < 15; i += 2) mx = fmaxf(fmaxf(mx, p1[i]), p1[i + 1]);
            mx = fmaxf(mx, p1[15]);
            mx = fmaxf(mx, __shfl_xor(mx, 32));
            const bool first = (t == 0);
            if (first || __any(mx > ATT_THR)) {
                const float d = first ? mx : fmaxf(mx, 0.f);
                mref += d;
#pragma unroll
                for (int i = 0; i < 16; ++i) { p0[i] -= d; p1[i] -= d; negm[i] = -mref; }
                if (!first) { const float al = __builtin_amdgcn_exp2f(-d); lsum *= al;
#pragma unroll
                    for (int i = 0; i < 16; ++i) { o0[i] *= al; o1[i] *= al; } }
            }
            float ps = 0.f;
#pragma unroll
            for (int i = 0; i < 16; ++i) { p0[i] = __builtin_amdgcn_exp2f(p0[i]); p1[i] = __builtin_amdgcn_exp2f(p1[i]); ps += p0[i] + p1[i]; }
            lsum += ps;
            __builtin_amdgcn_s_setprio(1);
#pragma unroll
            for (int j = 0; j < 4; ++j) {
                const int half = j >> 1, jj = j & 1;
                u32x4 pb;
                if (half == 0) { pb.x = cvtpk(p0[8 * jj + 0], p0[8 * jj + 1]); pb.y = cvtpk(p0[8 * jj + 2], p0[8 * jj + 3]); pb.z = cvtpk(p0[8 * jj + 4], p0[8 * jj + 5]); pb.w = cvtpk(p0[8 * jj + 6], p0[8 * jj + 7]); }
                else { pb.x = cvtpk(p1[8 * jj + 0], p1[8 * jj + 1]); pb.y = cvtpk(p1[8 * jj + 2], p1[8 * jj + 3]); pb.z = cvtpk(p1[8 * jj + 4], p1[8 * jj + 5]); pb.w = cvtpk(p1[8 * jj + 6], p1[8 * jj + 7]); }
                const bf16x8 pf = __builtin_bit_cast(bf16x8, pb);
                const int kvo = half * 32 + jj * 16 + 4 * hi;
                { const u32x2 lo = *(const LAS u32x2*)(Vb + r32 * RS + kvo), hi2 = *(const LAS u32x2*)(Vb + r32 * RS + kvo + 8);
                  const u32x4 av = {lo.x, lo.y, hi2.x, hi2.y}; o0 = __builtin_amdgcn_mfma_f32_32x32x16_bf16(__builtin_bit_cast(bf16x8, av), pf, o0, 0, 0, 0); }
                { const u32x2 lo = *(const LAS u32x2*)(Vb + (32 + r32) * RS + kvo), hi2 = *(const LAS u32x2*)(Vb + (32 + r32) * RS + kvo + 8);
                  const u32x4 av = {lo.x, lo.y, hi2.x, hi2.y}; o1 = __builtin_amdgcn_mfma_f32_32x32x16_bf16(__builtin_bit_cast(bf16x8, av), pf, o1, 0, 0, 0); }
            }
            __builtin_amdgcn_s_setprio(0);
        }
        lsum += __shfl_xor(lsum, 32);
        const float il = 1.0f / lsum;
        bf16_t* op = MG + (size_t)qrow * 1024 + 768 + hq * 64;
#pragma unroll
        for (int a = 0; a < 4; ++a) {
            u32x2 w; w.x = cvtpk(o0[4 * a] * il, o0[4 * a + 1] * il); w.y = cvtpk(o0[4 * a + 2] * il, o0[4 * a + 3] * il); *(u32x2*)(op + 8 * a + 4 * hi) = w;
            u32x2 w2; w2.x = cvtpk(o1[4 * a] * il, o1[4 * a + 1] * il); w2.y = cvtpk(o1[4 * a + 2] * il, o1[4 * a + 3] * il); *(u32x2*)(op + 32 + 8 * a + 4 * hi) = w2;
        }
        __syncthreads();
    }
}
#define FIDX(i) ((i) ^ ((((i) >> 5) & 3) * 5) ^ ((((i) >> 6) & 1) << 4))
constexpr int FFT_BUF_BYTES = NFFT * 8, FFT_WHI_OFF = FFT_BUF_BYTES, FFT_WLO_OFF = FFT_WHI_OFF + 128 * 8;
__device__ __forceinline__ f32x2 fft_tw(const LAS f32x2* whi, const LAS f32x2* wlo, int t) { return cmul(whi[t >> 6], wlo[t & 63]); }
__device__ __forceinline__ void fft_fwd(LAS f32x2* buf, const LAS f32x2* whi, const LAS f32x2* wlo, int tid) {
    for (int s = 0; s < 7; ++s) {
        const int lq = 12 - 2 * s, q = 1 << lq;
        __syncthreads();
#pragma unroll 4
        for (int i = 0; i < 8; ++i) { const int id = tid + 512 * i; const int j = id & (q - 1), blk = id >> lq; const int i0 = (blk << (lq + 2)) + j;
            const int x0 = FIDX(i0), x1 = FIDX(i0 + q), x2 = FIDX(i0 + 2 * q), x3 = FIDX(i0 + 3 * q);
            const f32x2 a0 = buf[x0], a1 = buf[x1], a2 = buf[x2], a3 = buf[x3];
            const f32x2 w1 = fft_tw(whi, wlo, j << (2 * s)); const f32x2 w2 = cmul(w1, w1);
            const f32x2 b0 = a0 + a2, b2 = cmul(a0 - a2, w1), b1 = a1 + a3; const f32x2 t3 = cmul(a1 - a3, w1); const f32x2 b3 = {t3.y, -t3.x};
            buf[x0] = b0 + b1; buf[x1] = cmul(b0 - b1, w2); buf[x2] = b2 + b3; buf[x3] = cmul(b2 - b3, w2); }
    }
    __syncthreads();
}
__device__ __forceinline__ void fft_inv(LAS f32x2* buf, const LAS f32x2* whi, const LAS f32x2* wlo, int tid) {
    for (int s = 6; s >= 0; --s) {
        const int lq = 12 - 2 * s, q = 1 << lq;
        __syncthreads();
#pragma unroll 4
        for (int i = 0; i < 8; ++i) { const int id = tid + 512 * i; const int j = id & (q - 1), blk = id >> lq; const int i0 = (blk << (lq + 2)) + j;
            const int x0 = FIDX(i0), x1 = FIDX(i0 + q), x2 = FIDX(i0 + 2 * q), x3 = FIDX(i0 + 3 * q);
            const f32x2 c0 = buf[x0], c1 = buf[x1], c2 = buf[x2], c3 = buf[x3];
            const f32x2 w1 = fft_tw(whi, wlo, j << (2 * s)); const f32x2 w2 = cmul(w1, w1);
            const f32x2 t1 = cmulc(c1, w2), t3 = cmulc(c3, w2);
            const f32x2 b0 = c0 + t1, b1 = c0 - t1, b2 = c2 + t3, b3 = c2 - t3;
            const f32x2 u2 = cmulc(b2, w1); const f32x2 u3c = cmulc(b3, w1); const f32x2 u3 = {-u3c.y, u3c.x};
            buf[x0] = b0 + u2; buf[x2] = b0 - u2; buf[x1] = b1 + u3; buf[x3] = b1 - u3; }
    }
    __syncthreads();
}
__device__ __forceinline__ int brev14(int k) { return (int)(__builtin_bitreverse32((unsigned)k) >> 18); }
__device__ __forceinline__ void pc_hyena(const int wave_s_, const P& p, int l, LAS unsigned char* lds) { unsigned char* const wsb = lndp(p.ws); const int tidx_ = tid_of(wave_s_); const int bidx_ = lnds((int)blockIdx.x);
    const int tid = tidx_;
    LAS f32x2* buf = (LAS f32x2*)lds; LAS f32x2* whi = (LAS f32x2*)(lds + FFT_WHI_OFF); LAS f32x2* wlo = (LAS f32x2*)(lds + FFT_WLO_OFF);
    const f32x2* tw = (const f32x2*)(wsb + WS_TW);
    __syncthreads();
    if (tid < 128) whi[tid] = tw[tid * 64]; else if (tid < 192) wlo[tid - 128] = tw[tid - 128];
    const bf16_t* VXT = (const bf16_t*)(wsb + WS_VXT); float* Z1 = (float*)(wsb + WS_Z1); bf16_t* Z2T = (bf16_t*)(wsb + WS_Z2T);
    for (int ch = bidx_; ch < 256; ch += gridDim.x) {
        for (int o = 0; o < 2; ++o) {
            float* filt = (float*)(wsb + WS_FILT) + (size_t)(ch * 2 + o) * 2 * LSEQ;
            const float* hf = filt; const float* hb = filt + LSEQ;
            __syncthreads();
            for (int m = tid; m < NFFT; m += 512) { f32x2 v;
                if (m < NFFT / 2) v = *(const f32x2*)(hf + 2 * m);
                else { const int r = 2 * LSEQ - 2 * m - 2; const f32x2 t = *(const f32x2*)(hb + r); v = (f32x2){m == NFFT / 2 ? 0.f : t.y, t.x}; }
                buf[FIDX(m)] = v; }
            fft_fwd(buf, whi, wlo, tid);
            f32x4* ksp = (f32x4*)filt;
            const float sc = 1.0f / (float)NFFT;
            for (int ph2 = tid; ph2 < NFFT / 2; ph2 += 512) {
                if (ph2 == 0) { const f32x2 a = buf[0], b = buf[1]; ksp[0] = (f32x4){a.x * sc, a.y * sc, b.x * sc, b.y * sc}; }
                else { const int k = brev14(2 * ph2); const int q1 = 2 * ph2, q2 = brev14(NFFT - k); const f32x2 A = buf[FIDX(q1)], B = cconj(buf[FIDX(q2)]);
                    const f32x2 E = (A + B) * (0.5f * sc), D = (A - B) * (0.5f * sc); ksp[ph2] = (f32x4){E.x, E.y, D.y, -D.x}; }
            }
            __syncthreads();
            const bf16_t* zb = VXT + (size_t)ch * LSEQ; const float* z1 = Z1 + (size_t)ch * LSEQ;
            for (int m = tid; m < NFFT; m += 512) { f32x2 v = {0.f, 0.f};
                if (m < NFFT / 2) { if (o == 0) { const unsigned w = *(const unsigned*)(zb + 2 * m); v = (f32x2){bflo(w), bfhi(w)}; } else v = *(const f32x2*)(z1 + 2 * m); }
                buf[FIDX(m)] = v; }
            fft_fwd(buf, whi, wlo, tid);
            for (int ph2 = tid; ph2 < NFFT / 2; ph2 += 512) {
                const f32x4 ks = ksp[ph2];
                if (ph2 == 0) { const f32x2 a = buf[0], b = buf[1];
                    buf[0] = (f32x2){a.x * ks[0] + a.y * ks[1], a.x * ks[1] + a.y * ks[0]};
                    buf[1] = (f32x2){b.x * ks[2] - b.y * ks[3], b.x * ks[3] + b.y * ks[2]}; }
                else { const int k = brev14(2 * ph2); const int p1 = FIDX(2 * ph2), p2 = FIDX(brev14(NFFT - k)); const f32x2 A = buf[p1], B = cconj(buf[p2]);
                    const f32x2 Ez = (A + B) * 0.5f, Dz = (A - B) * 0.5f; const f32x2 Oz = {Dz.y, -Dz.x};
                    const f32x2 Ek = {ks[0], ks[1]}, Ok = {ks[2], ks[3]};
                    const f32x2 Ey = cmul(Ez, Ek) + cmul(fft_tw(whi, wlo, k), cmul(Oz, Ok)); const f32x2 Oy = cmul(Ez, Ok) + cmul(Oz, Ek);
                    buf[p1] = (f32x2){Ey.x - Oy.y, Ey.y + Oy.x};
                    buf[p2] = (f32x2){Ey.x + Oy.y, Oy.x - Ey.y}; }
            }
            fft_inv(buf, whi, wlo, tid);
            const float fb = PIN(20)[(l * 2 + o) * 256 + ch];
            const bf16_t* gt = VXT + (size_t)((o + 1) * 256 + ch) * LSEQ;
            for (int m = tid; m < NFFT / 2; m += 512) { const f32x2 y = buf[FIDX(m)]; f32x2 zp;
                if (o == 0) { const unsigned w = *(const unsigned*)(zb + 2 * m); zp = (f32x2){bflo(w), bfhi(w)}; } else zp = *(const f32x2*)(z1 + 2 * m);
                const unsigned gw = *(const unsigned*)(gt + 2 * m);
                const f32x2 zn = {bflo(gw) * (y.x + fb * zp.x), bfhi(gw) * (y.y + fb * zp.y)};
                if (o == 0) *(f32x2*)(Z1 + (size_t)ch * LSEQ + 2 * m) = zn; else *(unsigned*)(Z2T + (size_t)ch * LSEQ + 2 * m) = pk2(zn.x, zn.y); }
            __syncthreads();
        }
    }
}

__device__ __forceinline__ float gelu_tanh(float x) { const float u = 0.7978845608028654f * (x + 0.044715f * x * x * x); return 0.5f * x * (1.0f + tanhf(u)); }
__device__ __forceinline__ void pd_s5out(const int wave_s_, const P& p) { unsigned char* const wsb = lndp(p.ws); const int tidx_ = tid_of(wave_s_); const int bidx_ = lnds((int)blockIdx.x);
    const int lane = tidx_ & 63, wave = tidx_ >> 6, gw = bidx_ * 8 + wave, NGW = gridDim.x * 8;
    const bf16_t* U = (const bf16_t*)(wsb + WS_U); const float* HIN = (const float*)(wsb + WS_HIN); bf16_t* GB = (bf16_t*)(wsb + WS_GBUF);
    const int m = lane & 15, kq = lane >> 4;
    for (int it = gw; it < 16 * 65 * 2; it += NGW) {
        const int nh = it & 1, it2 = it >> 1, g = it2 / 65, ct = it2 - g * 65;
        f32x4 acc[8];
#pragma unroll
        for (int n = 0; n < 8; ++n) acc[n] = (f32x4){0.f, 0.f, 0.f, 0.f};
        const int chunk = ct * 16 + m;
        for (int dir = 0; dir < 2; ++dir) {
            const int dg = dir * 16 + g;
            const bf16_t* KI = (const bf16_t*)(wsb + WS_S5M + (size_t)dg * 256 * KiB) + (size_t)nh * 128 * 256; const bf16_t* CC = (const bf16_t*)(wsb + WS_S5M + (size_t)dg * 256 * KiB) + 65536 + 32768 + (size_t)nh * 128 * 128;
#pragma unroll 2
            for (int ks = 0; ks < 8; ++ks) { const int k0 = ks * 32 + 8 * kq;
                const bf16x8 a = *(const bf16x8*)(U + (size_t)(chunk * 16 + (k0 >> 4)) * NIN + 768 + g * 16 + (k0 & 15));
#pragma unroll
                for (int n = 0; n < 8; ++n) { const bf16x8 b = *(const bf16x8*)(KI + (size_t)(n * 16 + m) * 256 + k0); acc[n] = __builtin_amdgcn_mfma_f32_16x16x32_bf16(a, b, acc[n], 0, 0, 0); } }
#pragma unroll 2
            for (int ks = 0; ks < 4; ++ks) { const int k0 = ks * 32 + 8 * kq;
                const float* hp = HIN + ((size_t)dg * NCH + chunk) * 128 + k0; const f32x4 h0 = *(const f32x4*)hp, h1 = *(const f32x4*)(hp + 4);
                u32x4 aw; aw.x = pk2(h0[0], h0[1]); aw.y = pk2(h0[2], h0[3]); aw.z = pk2(h1[0], h1[1]); aw.w = pk2(h1[2], h1[3]);
                const bf16x8 a = __builtin_bit_cast(bf16x8, aw);
#pragma unroll
                for (int n = 0; n < 8; ++n) { const bf16x8 b = *(const bf16x8*)(CC + (size_t)(n * 16 + m) * 128 + k0); acc[n] = __builtin_amdgcn_mfma_f32_16x16x32_bf16(a, b, acc[n], 0, 0, 0); } }
        }
#pragma unroll
        for (int n = 0; n < 8; ++n)
#pragma unroll
            for (int i = 0; i < 4; ++i) { const int row = (ct * 16 + 4 * kq + i) * 16 + nh * 8 + n; GB[(size_t)row * 256 + g * 16 + m] = (bf16_t)f2bf(gelu_tanh(acc[n][i])); }
    }
}
__device__ __forceinline__ void pd_hytrans(const int wave_s_, const P& p, LAS unsigned char* lds) { unsigned char* const wsb = lndp(p.ws); const int tidx_ = tid_of(wave_s_); const int bidx_ = lnds((int)blockIdx.x);
    const int tid = tidx_;
    const bf16_t* Z2T = (const bf16_t*)(wsb + WS_Z2T); bf16_t* MG = (bf16_t*)(wsb + WS_MERGED);
    LAS bf16_t* tile = (LAS bf16_t*)lds;
    for (int item = bidx_; item < 256 * 4; item += gridDim.x) {
        const int c0 = (item & 3) * 64, t0 = (item >> 2) * 64;
        __syncthreads();
        { const int c = tid >> 3, t8 = (tid & 7) * 8; const u32x4 w = *(const u32x4*)(Z2T + (size_t)(c0 + c) * LSEQ + t0 + t8);
          LAS unsigned* d = (LAS unsigned*)(tile + c * 66 + t8); d[0] = w.x; d[1] = w.y; d[2] = w.z; d[3] = w.w; }
        __syncthreads();
        { const int t = tid >> 3, c8 = (tid & 7) * 8; unsigned short e[8];
#pragma unroll
          for (int i = 0; i < 8; ++i) e[i] = tile[(c8 + i) * 66 + t];
          u32x4 w; w.x = e[0] | ((unsigned)e[1] << 16); w.y = e[2] | ((unsigned)e[3] << 16); w.z = e[4] | ((unsigned)e[5] << 16); w.w = e[6] | ((unsigned)e[7] << 16);
          *(u32x4*)(MG + (size_t)(LCTX + t0 + t) * 1024 + c0 + c8) = w; }
    }
    __syncthreads();
}
__device__ __forceinline__ void pd2_glu(const int wave_s_, const P& p, int l) { unsigned char* const wsb = lndp(p.ws); const int tidx_ = tid_of(wave_s_); const int bidx_ = lnds((int)blockIdx.x);
    const int lane = tidx_ & 63, wave = tidx_ >> 6, gw = bidx_ * 8 + wave, NGW = gridDim.x * 8, r32 = lane & 31, hi = lane >> 5;
    const bf16_t* GB = (const bf16_t*)(wsb + WS_GBUF); const bf16_t* GLUT = (const bf16_t*)(wsb + WS_GLUT); bf16_t* MG = (bf16_t*)(wsb + WS_MERGED);
    const float* gb = PIN(30) + l * 256;
    for (int it = gw; it < 520 * 8; it += NGW) {
        const int rt = it >> 3, ct = it & 7;
        f32x16 acc;
#pragma unroll
        for (int i = 0; i < 16; ++i) acc[i] = 0.f;
#pragma unroll 8
        for (int ks = 0; ks < 16; ++ks) { const int k0 = ks * 16 + 8 * hi;
            const bf16x8 a = *(const bf16x8*)(GB + (size_t)(rt * 32 + r32) * 256 + k0); const bf16x8 b = *(const bf16x8*)(GLUT + (size_t)(ct * 32 + r32) * 256 + k0);
            acc = __builtin_amdgcn_mfma_f32_32x32x16_bf16(a, b, acc, 0, 0, 0); }
        const int col = ct * 32 + r32; const float bias = gb[col];
#pragma unroll
        for (int i = 0; i < 16; ++i) { const int row = rt * 32 + (i & 3) + 8 * (i >> 2) + 4 * hi; const float gv = bf1(GB[(size_t)row * 256 + col]);
            const float sg = 1.0f / (1.0f + expf(-(acc[i] + bias))); MG[(size_t)row * 1024 + 256 + col] = (bf16_t)f2bf(gv * sg); }
    }
}

__device__ __forceinline__ void grid_bar(unsigned* ctr, unsigned target, int tid) {
    asm volatile("s_waitcnt vmcnt(0) lgkmcnt(0)" ::: "memory");
    __syncthreads();
    if (tid == 0) {
        __builtin_amdgcn_fence(__ATOMIC_RELEASE, "agent");
        asm volatile("s_waitcnt vmcnt(0)" ::: "memory");
        __hip_atomic_fetch_add(ctr, 1u, __ATOMIC_RELAXED, __HIP_MEMORY_SCOPE_AGENT);
        while (__hip_atomic_load(ctr, __ATOMIC_RELAXED, __HIP_MEMORY_SCOPE_AGENT) < target) __builtin_amdgcn_s_sleep(2);
        __builtin_amdgcn_fence(__ATOMIC_ACQUIRE, "agent");
        asm volatile("s_waitcnt vmcnt(0)" ::: "memory");
    }
    __syncthreads();
}
#define PH_BEGIN if (ph >= lo && ph < hi) { unsigned char* const wsb = lndp(p.ws); const int tidx_ = tid_of(wave_s_); const int bidx_ = lnds((int)blockIdx.x); (void)tidx_; (void)bidx_;
#define PH_END   if (ph + 1 < hi) { ++nbar; grid_bar((unsigned*)(lndp(p.ws) + WS_BAR), (unsigned)nbar * gridDim.x, tid_of(wave_s_)); } } ++ph;
#define PH_END0  if (ph + 1 < hi) grid.sync(); } ++ph;
template <int l> __device__ __forceinline__ void layer_phases(const int wave_s_, const P& p, LAS unsigned char* lds, const int lo, const int hi, int& ph, int& nbar) {

        PH_BEGIN
            { float* ss1 = (float*)(wsb + WS_SS1); float* ss2 = (float*)(wsb + WS_SS2); const int t0_ = tid_of(wave_s_);
              for (int i = bidx_ * 512 + t0_; i < R; i += gridDim.x * 512) { ss1[i] = 0.f; ss2[i] = 0.f; } }
            { pg8::Gemm g{(const pg8::bf16_t*)(wsb + WS_H), (const pg8::bf16_t*)(wsb + WS_WIN), R, NIN, DM, tidx_}; pg8::StaticOrder S; S.init(R, NIN, gridDim.x, bidx_);
              pg8::EpiBf16<0> E{(pg8::bf16_t*)(wsb + WS_U), NIN};
              pg8::gemm_phase<pg8::EpiBf16<0>, pg8::StaticOrder, true, true>(lds, g, S, E); }
            __syncthreads();
            { pg8::Gemm g{(const pg8::bf16_t*)(wsb + WS_H2L), (const pg8::bf16_t*)(wsb + WS_W3T), LSEQ, 1024, 128, tid_of(wave_s_)}; pg8::StaticOrder S; S.init(LSEQ, 1024, gridDim.x, bidx_);
              pg8::EpiFilt E{(float*)(wsb + WS_FILT), PIN(19) + l * 1024};
              pg8::gemm_phase<pg8::EpiFilt, pg8::StaticOrder, false, false>(lds, g, S, E); }
            __syncthreads();
            pa_ctxtaps(wave_s_, p, l);
        PH_END
        PH_BEGIN
            pb_attprep(wave_s_, p, l); pb_s5local(wave_s_, p); pb_pool(wave_s_, p, l, lds); pb_shortconv(wave_s_, p, l, lds); pb_ctxhyena(wave_s_, p, l, lds);
        PH_END
        PH_BEGIN
            pc_s5carry(wave_s_, p, lds); pc_attention(wave_s_, p, lds); pc_hyena(wave_s_, p, l, lds);
        PH_END
        PH_BEGIN
            pd_s5out(wave_s_, p); pd_hytrans(wave_s_, p, lds);
        PH_END
        PH_BEGIN
            pd2_glu(wave_s_, p, l);
        PH_END
        PH_BEGIN
            { pg8::Gemm g{(const pg8::bf16_t*)(wsb + WS_MERGED), (const pg8::bf16_t*)(wsb + WS_WOUT), R, DM, DM, tidx_}; pg8::StaticOrder S; S.init(R, DM, gridDim.x, bidx_);
              pg8::EpiSumsq E{(pg8::bf16_t*)(wsb + WS_OL), DM, (float*)(wsb + WS_SS1)};
              pg8::gemm_phase<pg8::EpiSumsq, pg8::StaticOrder, true, true>(lds, g, S, E); }
            __syncthreads();
        PH_END
        PH_BEGIN
            ew_phase(wave_s_, p, 1, l);
        PH_END
        PH_BEGIN
            { pg8::Gemm g{(const pg8::bf16_t*)(wsb + WS_H), (const pg8::bf16_t*)(wsb + WS_W1), R, FF, DM, tidx_}; pg8::StaticOrder S; S.init(R, FF, gridDim.x, bidx_);
              pg8::EpiBf16<1> E{(pg8::bf16_t*)(wsb + WS_HID), FF};
              pg8::gemm_phase<pg8::EpiBf16<1>, pg8::StaticOrder, true, true>(lds, g, S, E); }
            __syncthreads();
        PH_END
        PH_BEGIN
            { pg8::Gemm g{(const pg8::bf16_t*)(wsb + WS_HID), (const pg8::bf16_t*)(wsb + WS_W2), R, DM, FF, tidx_}; pg8::StaticOrder S; S.init(R, DM, gridDim.x, bidx_);
              pg8::EpiSumsq E{(pg8::bf16_t*)(wsb + WS_OL), DM, (float*)(wsb + WS_SS2)};
              pg8::gemm_phase<pg8::EpiSumsq, pg8::StaticOrder, true, true>(lds, g, S, E); }
            __syncthreads();
        PH_END
        PH_BEGIN
            ew_phase(wave_s_, p, 2, l);
            if (l + 1 < NLAYER) prep_layer(wave_s_, p, l + 1, lds);
        PH_END
    }
__global__ void __launch_bounds__(512) mega_fwd(P p) {
    extern __shared__ __attribute__((aligned(16))) unsigned char lds_raw[];
    LAS unsigned char* lds = (LAS unsigned char*)lds_raw;
    cg::grid_group grid = cg::this_grid();
    const int wave_s_ = __builtin_amdgcn_readfirstlane((int)threadIdx.x >> 6);
    const int lo = p.lo, hi = p.hi;
    int ph = 0, nbar = 0;
    PH_BEGIN
        pro_mod(wave_s_, p, lds); pro_tables(wave_s_, p); prep_layer(wave_s_, p, 0, lds);
    PH_END0
    PH_BEGIN
        ew_phase(wave_s_, p, 0, 0);
    PH_END
    layer_phases<0>(wave_s_, p, lds, lo, hi, ph, nbar);
    layer_phases<1>(wave_s_, p, lds, lo, hi, ph, nbar);
    layer_phases<2>(wave_s_, p, lds, lo, hi, ph, nbar);
    layer_phases<3>(wave_s_, p, lds, lo, hi, ph, nbar);
#undef PH_BEGIN
#undef PH_END
#undef PH_END0
}
constexpr int N_PHASES = 2 + NLAYER * 10;

#ifndef MK_MULTI
#define MK_MULTI 0
#endif
extern "C" void kernel_launch(void* const* d_in, const int* in_sizes, int n_in, void* d_out, int out_size, void* d_ws, size_t ws_size, hipStream_t stream) {
    static int grid = 0;
    if (grid == 0) {
        if (n_in != 37 || out_size != LSEQ * DM || ws_size < WS_END) { fprintf(stderr, "kernel_launch: unexpected shapes (n_in %d out %d ws %zu)\n", n_in, out_size, ws_size); grid = -1; return; }
        int dev = 0, cus = 0, per_cu = 0;
        (void)hipGetDevice(&dev); (void)hipDeviceGetAttribute(&cus, hipDeviceAttributeMultiprocessorCount, dev);
        if (hipFuncSetAttribute((const void*)mega_fwd, hipFuncAttributeMaxDynamicSharedMemorySize, LDS_BYTES) != hipSuccess) { fprintf(stderr, "kernel_launch: hipFuncSetAttribute failed\n"); grid = -1; return; }
        if (hipOccupancyMaxActiveBlocksPerMultiprocessor(&per_cu, (const void*)mega_fwd, 512, LDS_BYTES) != hipSuccess || per_cu < 1) { fprintf(stderr, "kernel_launch: occupancy query gave %d\n", per_cu); per_cu = 1; }
        (void)hipGetLastError();
        grid = cus * 1;
        if (grid <= 0) grid = 256;
    }
    if (grid < 0) return;
    (void)hipMemsetAsync((unsigned char*)d_ws + WS_BAR, 0, 256, stream);
    P a{};
    for (int i = 0; i < 37; ++i) a.in[i] = (const float*)d_in[i];
    a.out = (float*)d_out; a.ws = (unsigned char*)d_ws;
#if MK_MULTI
    for (int ph = 0; ph < N_PHASES; ++ph) { a.lo = ph; a.hi = ph + 1; hipLaunchKernelGGL(mega_fwd, dim3(grid), dim3(512), LDS_BYTES, stream, a); }
#else
    a.lo = 0; a.hi = N_PHASES;
    void* args[] = {&a};
    hipError_t e = hipLaunchCooperativeKernel((const void*)mega_fwd, dim3(grid), dim3(512), args, LDS_BYTES, stream);
    if (e != hipSuccess) fprintf(stderr, "cooperative launch failed: %s (grid %d)\n", hipGetErrorString(e), grid);
#endif
}
```

```cpp
#include <hip/hip_runtime.h>
#include <hip/hip_cooperative_groups.h>
#include <cstdio>
#include <cstdint>
namespace cg = cooperative_groups;

__device__ __forceinline__ int lndv(int i) { asm volatile("" : "+v"(i)); return i; }
__device__ __forceinline__ int lnds(int i) { asm volatile("" : "+v"(i)); return __builtin_amdgcn_readfirstlane(i); }
__device__ __forceinline__ int tid_of(int wave_s) { int z = 0; asm volatile("" : "+v"(z)); return (wave_s << 6) + (int)__builtin_amdgcn_mbcnt_hi(~0u, __builtin_amdgcn_mbcnt_lo(~0u, (unsigned)z)); }
namespace pg8 {
#define PG8_LAS __attribute__((address_space(3)))
typedef unsigned short bf16_t;
typedef short bf16x8 __attribute__((ext_vector_type(8)));
typedef float f32x4 __attribute__((ext_vector_type(4)));
typedef unsigned u32x4 __attribute__((ext_vector_type(4)));
constexpr int BM = 256, BK = 64, HALF = 128, HTB = HALF * BK * 2  , STAGE_BYTES = 8 * HTB, NXCD = 8, WGM = 8;

__host__ __device__ __forceinline__ int lds_byte(int r, int c) { const int st = (r >> 4) * 2 + (c >> 5), rr = r & 15, cc = c & 31, ob = rr * 64 + cc * 2; return st * 1024 + (ob ^ (((ob >> 9) & 1) << 5)); }
__host__ __device__ __forceinline__ void stage_rc(int b, int& R, int& C) { const int st = b / 1024, sb = b % 1024, swz = sb ^ (((sb >> 9) & 1) << 5); R = (st >> 1) * 16 + swz / 64; C = (st & 1) * 32 + (swz % 64) / 2; }
__host__ __device__ __forceinline__ int perm32(int rho) { const int n = rho >> 4, i = rho & 15; return 8 * (i >> 2) + 4 * n + (i & 3); }

struct Unit { int pm, pn; };
struct Gemm { const bf16_t* A; const bf16_t* Bt; int M, N, K, tid; };

struct StaticOrder {
    int nM, nN, nwg, G, c;
    __host__ __device__ void init(int M, int N, int G_, int c_) { nM = M / BM; nN = N / BM; nwg = nM * nN; G = G_; c = c_; }
    __host__ __device__ bool next(int i, Unit& u) const {
        const long L = (long)i * G + c; if (L >= nwg) return false;
        int wgid = (int)L; { const int q = nwg / NXCD, r = nwg % NXCD, xcd = wgid % NXCD, off = wgid / NXCD; wgid = (xcd < r ? xcd * (q + 1) : r * (q + 1) + (xcd - r) * q) + off; }
        const int nig = WGM * nN, gid = wgid / nig, fm = gid * WGM, gsz = (nM - fm) < WGM ? (nM - fm) : WGM;
        u.pm = fm + ((wgid % nig) % gsz); u.pn = (wgid % nig) / gsz; return true;
    }
    __device__ __forceinline__ void a_ready(const Unit&) const {}
    __device__ __forceinline__ void done(const Unit&) const {}
};

__device__ __forceinline__ unsigned cvt_pk_bf16(float lo, float hi) { unsigned r; asm volatile("v_cvt_pk_bf16_f32 %0, %1, %2" : "=v"(r) : "v"(lo), "v"(hi)); return r; }

template <int ACT> struct EpiBf16 {
    static constexpr bool PERM = true, AFTER_DRAIN = false;
    bf16_t* O; int ldc;
    __device__ __forceinline__ void operator()(const f32x4 (&acc)[2][2][4][2], const Unit& u, int wr, int wc, int fr, int fq) const {
        const int row0 = u.pm * BM + wr * 64 + fr, col0 = u.pn * BM + wc * 32 + 8 * fq;
#pragma unroll
        for (int ai = 0; ai < 2; ++ai)
#pragma unroll
            for (int m = 0; m < 4; ++m) { bf16_t* rowp = O + (size_t)(row0 + ai * HALF + m * 16) * ldc + col0;
#pragma unroll
                for (int bj = 0; bj < 2; ++bj) { f32x4 v0 = acc[ai][bj][m][0], v1 = acc[ai][bj][m][1];
                    if (ACT == 1) {
#pragma unroll
                        for (int e = 0; e < 4; ++e) { float a = v0[e] > 0.f ? v0[e] : 0.f; v0[e] = a * a; float b = v1[e] > 0.f ? v1[e] : 0.f; v1[e] = b * b; } }
                    u32x4 w; w.x = cvt_pk_bf16(v0[0], v0[1]); w.y = cvt_pk_bf16(v0[2], v0[3]); w.z = cvt_pk_bf16(v1[0], v1[1]); w.w = cvt_pk_bf16(v1[2], v1[3]);
                    *(u32x4*)(rowp + bj * HALF) = w; } }
    }
};
struct EpiSumsq {
    static constexpr bool PERM = true, AFTER_DRAIN = false;
    bf16_t* O; int ldc; float* ss;
    __device__ __forceinline__ void operator()(const f32x4 (&acc)[2][2][4][2], const Unit& u, int wr, int wc, int fr, int fq) const {
        const int row0 = u.pm * BM + wr * 64 + fr, col0 = u.pn * BM + wc * 32 + 8 * fq;
#pragma unroll
        for (int ai = 0; ai < 2; ++ai)
#pragma unroll
            for (int m = 0; m < 4; ++m) { const int row = row0 + ai * HALF + m * 16; bf16_t* rowp = O + (size_t)row * ldc + col0; float s = 0.f;
#pragma unroll
                for (int bj = 0; bj < 2; ++bj) { const f32x4 v0 = acc[ai][bj][m][0], v1 = acc[ai][bj][m][1];
                    s += (v0[0] * v0[0] + v0[1] * v0[1]) + (v0[2] * v0[2] + v0[3] * v0[3]) + (v1[0] * v1[0] + v1[1] * v1[1]) + (v1[2] * v1[2] + v1[3] * v1[3]);
                    u32x4 w; w.x = cvt_pk_bf16(v0[0], v0[1]); w.y = cvt_pk_bf16(v0[2], v0[3]); w.z = cvt_pk_bf16(v1[0], v1[1]); w.w = cvt_pk_bf16(v1[2], v1[3]);
                    *(u32x4*)(rowp + bj * HALF) = w; }
                s += __shfl_xor(s, 16); s += __shfl_xor(s, 32);
                if (fq == 0) atomicAdd(ss + row, s); }
    }
};
struct EpiFilt {
    static constexpr bool PERM = false, AFTER_DRAIN = false;
    float* F; const float* decay;
    __device__ __forceinline__ void operator()(const f32x4 (&acc)[2][2][4][2], const Unit& u, int wr, int wc, int fr, int fq) const {
        const int row0 = u.pm * BM + wr * 64 + fr, col0 = u.pn * BM + wc * 32 + 4 * fq;
#pragma unroll
        for (int bj = 0; bj < 2; ++bj)
#pragma unroll
            for (int n = 0; n < 2; ++n) {
                const int cb = col0 + bj * HALF + n * 16;
                const f32x4 dc = *(const f32x4*)(decay + cb);
#pragma unroll
                for (int e = 0; e < 4; ++e) { const int col = cb + e; const float ad = __builtin_fabsf(dc[e]);
                    float* fp = F + (size_t)((((col & 255) * 2 + (col >> 9)) * 2) + ((col >> 8) & 1)) * 16384;
#pragma unroll
                    for (int ai = 0; ai < 2; ++ai)
#pragma unroll
                        for (int m = 0; m < 4; ++m) { const int r = row0 + ai * HALF + m * 16; const float t = (float)r * (1.0f / 16384.0f);
                            fp[r] = acc[ai][bj][m][n][e] * expf(-t * ad); } } }
    }
};

template <class Epi, class Sched, bool ALIGN_EPI = false, bool SP2 = false>
__device__ __forceinline__ void gemm_phase(PG8_LAS unsigned char* lds, const Gemm g, const Sched& S, const Epi& E) {
    const int tid = g.tid, wid = __builtin_amdgcn_readfirstlane(tid >> 6), lane = tid & 63, wr = wid >> 2, wc = wid & 3, fr = lane & 15, fq = lane >> 4;
    const int K = g.K, nt = K / BK;
    unsigned voffA[2], voffB[2];
#pragma unroll
    for (int i = 0; i < 2; ++i) { int R, C; stage_rc(tid * 16 + i * 8192, R, C); const int Rb = Epi::PERM ? ((R & ~31) + perm32(R & 31)) : R;
        voffA[i] = (unsigned)(R * K + C) * 2u; voffB[i] = (unsigned)(Rb * K + C) * 2u; }
    const size_t kstep = (size_t)(BK * 2);
    const size_t hstep = (size_t)HALF * K * 2;
    const size_t tstep = 2 * hstep;
    const unsigned ldsw = (unsigned)wid * 1024u;
    const int aoff = lds_byte(wr * 64 + fr, fq * 8), boff = lds_byte(wc * 32 + fr, fq * 8);
#define PG8_SA(b, h) (((b) * 2 + (h)) * HTB)
#define PG8_SB(b, h) ((4 + (b) * 2 + (h)) * HTB)
#define PG8_STAGE(bufoff, gbase, voff) do { _Pragma("unroll") for (int _i = 0; _i < 2; ++_i) \
        __builtin_amdgcn_global_load_lds((const unsigned*)((const char*)(gbase) + (voff)[_i]), (PG8_LAS unsigned*)(lds + (bufoff) + ldsw + _i * 8192), 16, 0, 0); } while (0)
#define PG8_LDA(dst, b, h) do { _Pragma("unroll") for (int m = 0; m < 4; ++m) _Pragma("unroll") for (int k = 0; k < 2; ++k) dst[m][k] = *(const PG8_LAS bf16x8*)(lds + PG8_SA(b, h) + aoff + m * 2048 + k * 1024); } while (0)
#define PG8_LDB(dst, b, h) do { _Pragma("unroll") for (int n = 0; n < 2; ++n) _Pragma("unroll") for (int k = 0; k < 2; ++k) dst[n][k] = *(const PG8_LAS bf16x8*)(lds + PG8_SB(b, h) + boff + n * 2048 + k * 1024); } while (0)
#define PG8_MMA(ai, bj, At, Bt) do { __builtin_amdgcn_s_setprio(1); _Pragma("unroll") for (int m = 0; m < 4; ++m) _Pragma("unroll") for (int n = 0; n < 2; ++n) _Pragma("unroll") for (int k = 0; k < 2; ++k) \
        acc[ai][bj][m][n] = __builtin_amdgcn_mfma_f32_16x16x32_bf16(Bt[n][k], At[m][k], acc[ai][bj][m][n], 0, 0, 0); __builtin_amdgcn_s_setprio(0); } while (0)
#define PG8_WAIT_V(n) asm volatile("s_waitcnt vmcnt(" #n ")" ::: "memory")
#define PG8_WAIT_L(n) asm volatile("s_waitcnt lgkmcnt(" #n ")" ::: "memory")
#define PG8_BAR __builtin_amdgcn_s_barrier()
#define PG8_SCHED __builtin_amdgcn_sched_barrier(0)
    Unit cur, nxt; int ui = 0;
    if (!S.next(0, cur)) return;
    f32x4 acc[2][2][4][2];
#pragma unroll
    for (int a = 0; a < 2; ++a)
#pragma unroll
        for (int b = 0; b < 2; ++b)
#pragma unroll
            for (int m = 0; m < 4; ++m)
#pragma unroll
                for (int n = 0; n < 2; ++n) acc[a][b][m][n] = (f32x4){0.f, 0.f, 0.f, 0.f};
    bf16x8 At[4][2], B0[2][2], B1[2][2];
    const char* cA = (const char*)g.A + (size_t)cur.pm * tstep; const char* cB = (const char*)g.Bt + (size_t)cur.pn * tstep;
    S.a_ready(cur);
    if constexpr (SP2) {
        PG8_STAGE(PG8_SB(0, 0), cB, voffB); PG8_STAGE(PG8_SB(0, 1), cB + hstep, voffB); PG8_STAGE(PG8_SA(0, 0), cA, voffA); PG8_STAGE(PG8_SA(0, 1), cA + hstep, voffA);
        if (wr == 1) PG8_BAR;
        PG8_WAIT_V(2); PG8_BAR;
        PG8_STAGE(PG8_SB(1, 0), cB + kstep, voffB); PG8_STAGE(PG8_SA(1, 0), cA + kstep, voffA); PG8_STAGE(PG8_SB(1, 1), cB + hstep + kstep, voffB);
        PG8_WAIT_V(6); PG8_BAR;
    } else {
        PG8_STAGE(PG8_SB(0, 0), cB, voffB); PG8_STAGE(PG8_SA(0, 0), cA, voffA); PG8_STAGE(PG8_SB(0, 1), cB + hstep, voffB); PG8_STAGE(PG8_SA(0, 1), cA + hstep, voffA);
        if (wr == 1) PG8_BAR;
        PG8_WAIT_V(4); PG8_BAR;
        PG8_STAGE(PG8_SB(1, 0), cB + kstep, voffB); PG8_STAGE(PG8_SA(1, 0), cA + kstep, voffA); PG8_STAGE(PG8_SB(1, 1), cB + hstep + kstep, voffB);
        PG8_WAIT_V(6); PG8_BAR;
    }
    for (;;) {
        const bool has_next = S.next(ui + 1, nxt);
        const char* nA = has_next ? (const char*)g.A + (size_t)nxt.pm * tstep : cA; const char* nB = has_next ? (const char*)g.Bt + (size_t)nxt.pn * tstep : cB;
        for (int t = 0; t < nt; t += 2) {
            const bool last = (t == nt - 2);
            const char* a1 = cA + (size_t)(t + 1) * kstep;
            const char* a2 = last ? nA : cA + (size_t)(t + 2) * kstep; const char* b2 = last ? nB : cB + (size_t)(t + 2) * kstep;
            const char* a3 = a2 + kstep; const char* b3 = b2 + kstep;
            if (last && has_next) S.a_ready(nxt);
            if constexpr (SP2) {
            PG8_LDB(B0, 0, 0); PG8_LDB(B1, 0, 1); PG8_SCHED; PG8_LDA(At, 0, 0); PG8_STAGE(PG8_SA(1, 1), a1 + hstep, voffA);
            PG8_WAIT_V(8); PG8_WAIT_L(0); PG8_BAR; PG8_MMA(0, 0, At, B0); PG8_MMA(0, 1, At, B1); PG8_BAR; PG8_SCHED;
            PG8_LDA(At, 0, 1); PG8_STAGE(PG8_SB(0, 0), b2, voffB); PG8_STAGE(PG8_SB(0, 1), b2 + hstep, voffB); PG8_STAGE(PG8_SA(0, 0), a2, voffA);
            PG8_WAIT_V(8); PG8_WAIT_L(0); PG8_BAR; PG8_MMA(1, 0, At, B0); PG8_MMA(1, 1, At, B1); PG8_BAR; PG8_SCHED;
            PG8_LDB(B0, 1, 0); PG8_LDB(B1, 1, 1); PG8_SCHED; PG8_LDA(At, 1, 0); PG8_STAGE(PG8_SA(0, 1), a2 + hstep, voffA);
            PG8_WAIT_V(8); PG8_WAIT_L(0); PG8_BAR; PG8_MMA(0, 0, At, B0); PG8_MMA(0, 1, At, B1); PG8_BAR; PG8_SCHED;
            PG8_LDA(At, 1, 1); PG8_STAGE(PG8_SB(1, 0), b3, voffB); PG8_STAGE(PG8_SB(1, 1), b3 + hstep, voffB); PG8_STAGE(PG8_SA(1, 0), a3, voffA);
            PG8_WAIT_V(8); PG8_WAIT_L(0); PG8_BAR; PG8_MMA(1, 0, At, B0); PG8_MMA(1, 1, At, B1); PG8_BAR; PG8_SCHED;
            } else {
            PG8_LDB(B0, 0, 0); PG8_SCHED; PG8_LDA(At, 0, 0); PG8_STAGE(PG8_SA(1, 1), a1 + hstep, voffA);
            PG8_WAIT_L(8); PG8_BAR; PG8_WAIT_L(0); PG8_MMA(0, 0, At, B0); PG8_BAR; PG8_SCHED;
            PG8_LDB(B1, 0, 1); PG8_STAGE(PG8_SB(0, 0), b2, voffB);
            PG8_BAR; PG8_WAIT_L(0); PG8_MMA(0, 1, At, B1); PG8_BAR;
            PG8_LDA(At, 0, 1); PG8_STAGE(PG8_SA(0, 0), a2, voffA);
            PG8_BAR; PG8_WAIT_L(0); PG8_MMA(1, 0, At, B0); PG8_BAR; PG8_SCHED;
            PG8_STAGE(PG8_SB(0, 1), b2 + hstep, voffB);
            PG8_WAIT_V(6); PG8_BAR; PG8_MMA(1, 1, At, B1); PG8_BAR;
            PG8_LDB(B0, 1, 0); PG8_SCHED; PG8_LDA(At, 1, 0); PG8_STAGE(PG8_SA(0, 1), a2 + hstep, voffA);
            PG8_WAIT_L(8); PG8_BAR; PG8_WAIT_L(0); PG8_MMA(0, 0, At, B0); PG8_BAR; PG8_SCHED;
            PG8_LDB(B1, 1, 1); PG8_STAGE(PG8_SB(1, 0), b3, voffB);
            PG8_BAR; PG8_WAIT_L(0); PG8_MMA(0, 1, At, B1); PG8_BAR;
            PG8_LDA(At, 1, 1); PG8_STAGE(PG8_SA(1, 0), a3, voffA);
            PG8_BAR; PG8_WAIT_L(0); PG8_MMA(1, 0, At, B0); PG8_BAR; PG8_SCHED;
            PG8_STAGE(PG8_SB(1, 1), b3 + hstep, voffB);
            PG8_WAIT_V(6); PG8_BAR; PG8_MMA(1, 1, At, B1); PG8_BAR;
            }
        }
        if constexpr (ALIGN_EPI) { if (wr == 0) PG8_BAR; }
        if constexpr (!Epi::AFTER_DRAIN) { E(acc, cur, wr, wc, fr, fq); S.done(cur); }
        if (!has_next) break;
#pragma unroll
        for (int a = 0; a < 2; ++a)
#pragma unroll
            for (int b = 0; b < 2; ++b)
#pragma unroll
                for (int m = 0; m < 4; ++m)
#pragma unroll
                    for (int n = 0; n < 2; ++n) acc[a][b][m][n] = (f32x4){0.f, 0.f, 0.f, 0.f};
        cur = nxt; cA = nA; cB = nB; ++ui;
        if constexpr (ALIGN_EPI) { if (wr == 1) PG8_BAR; }
    }
    PG8_WAIT_V(0);
    if constexpr (!ALIGN_EPI) { if (wr == 0) PG8_BAR; }
    PG8_BAR;
    if constexpr (Epi::AFTER_DRAIN) { E.fused(acc, cur, wr, wc, fr, fq, lds, wid, lane); S.done(cur); }
#undef PG8_SA
#undef PG8_SB
#undef PG8_STAGE
#undef PG8_LDA
#undef PG8_LDB
#undef PG8_MMA
#undef PG8_WAIT_V
#undef PG8_WAIT_L
#undef PG8_BAR
#undef PG8_SCHED
}
}
#define LAS __attribute__((address_space(3)))
typedef unsigned short bf16_t;
typedef short bf16x8 __attribute__((ext_vector_type(8)));
typedef float f32x4 __attribute__((ext_vector_type(4)));
typedef float f32x2 __attribute__((ext_vector_type(2)));
typedef float f32x16 __attribute__((ext_vector_type(16)));
typedef unsigned u32x4 __attribute__((ext_vector_type(4)));
typedef unsigned u32x2 __attribute__((ext_vector_type(2)));

constexpr int LCTX = 256, LSEQ = 16384, R = LCTX + LSEQ;
constexpr int DM = 1024, NIN = 1792, FF = 4096, NLAYER = 4;
constexpr int NFFT = 16384;
constexpr int NCH = R / 16;
constexpr float EPS = 1e-6f;
constexpr float QSCALE = 0.125f * 1.4426950408889634f;
constexpr size_t KiB = 1024, MiB = 1024 * 1024;
constexpr size_t WS_SS1 = 0, WS_SS2 = 128 * KiB, WS_MODV = 256 * KiB, WS_TW = 512 * KiB, WS_LAMT = 640 * KiB, WS_H2C = 704 * KiB;
constexpr size_t WS_BAR = 768 * KiB;
constexpr size_t WS_XC = 1 * MiB;
constexpr size_t WS_WIN = 2 * MiB, WS_WOUT = 6 * MiB, WS_W1 = 8 * MiB, WS_W2 = 16 * MiB, WS_W3T = 24 * MiB, WS_GLUT = 24 * MiB + 512 * KiB;
constexpr size_t WS_S5M = 25 * MiB;
constexpr size_t WS_KCT = 33 * MiB;
constexpr size_t WS_H2L = 34 * MiB;
constexpr size_t WS_H = 38 * MiB;
constexpr size_t WS_VXT = 38 * MiB, WS_Z2T = 62 * MiB;
constexpr size_t WS_OL = 71 * MiB;
constexpr size_t WS_SC = 71 * MiB, WS_HIN = WS_SC + (size_t)32 * NCH * 128 * 4;
constexpr size_t WS_U = 104 * MiB, WS_MERGED = 161 * MiB, WS_QN = 194 * MiB, WS_GBUF = WS_QN, WS_KN = 203 * MiB, WS_FILT = 208 * MiB, WS_Z1 = 272 * MiB;
constexpr size_t WS_HID = 104 * MiB;
constexpr size_t WS_ROPE = 288 * MiB;
constexpr size_t WS_END = 292 * MiB;
constexpr int LDS_BYTES = 138 * 1024, XB_LDS_OFF = 137 * 1024;

struct P { const float* in[37]; float* out; unsigned char* ws; int lo, hi; };
__device__ __forceinline__ int lnd(int i) { asm volatile("" : "+v"(i)); return __builtin_amdgcn_readfirstlane(i); }
#define PIN(i) (p.in[lnd(i)])
__device__ __forceinline__ unsigned char* lndp(unsigned char* q) { unsigned lo = (unsigned)(uintptr_t)q, hi = (unsigned)((uintptr_t)q >> 32); asm volatile("" : "+v"(lo), "+v"(hi)); lo = __builtin_amdgcn_readfirstlane(lo); hi = __builtin_amdgcn_readfirstlane(hi); return (unsigned char*)(((uintptr_t)hi << 32) | (uintptr_t)lo); }


__device__ __forceinline__ unsigned f2bf(float f) { unsigned u = __builtin_bit_cast(unsigned, f); return (u + 0x7fffu + ((u >> 16) & 1u)) >> 16; }
__device__ __forceinline__ unsigned pk2(float lo, float hi) { return f2bf(lo) | (f2bf(hi) << 16); }
__device__ __forceinline__ float bflo(unsigned w) { return __builtin_bit_cast(float, w << 16); }
__device__ __forceinline__ float bfhi(unsigned w) { return __builtin_bit_cast(float, w & 0xffff0000u); }
__device__ __forceinline__ float bf1(bf16_t b) { return __builtin_bit_cast(float, (unsigned)b << 16); }
__device__ __forceinline__ float wave_sum(float v) {
#pragma unroll
    for (int o = 1; o < 64; o <<= 1) v += __shfl_xor(v, o);
    return v;
}
__device__ __forceinline__ f32x2 cmul(f32x2 a, f32x2 b) { return (f32x2){a.x * b.x - a.y * b.y, a.x * b.y + a.y * b.x}; }
__device__ __forceinline__ f32x2 cmulc(f32x2 a, f32x2 b) { return (f32x2){a.x * b.x + a.y * b.y, a.y * b.x - a.x * b.y}; }
__device__ __forceinline__ f32x2 cconj(f32x2 a) { return (f32x2){a.x, -a.y}; }

__device__ __forceinline__ void pro_mod(const int wave_s_, const P& p, LAS unsigned char* lds) { unsigned char* const wsb = lndp(p.ws); const int tidx_ = tid_of(wave_s_); const int bidx_ = lnds((int)blockIdx.x);
    const float* c = PIN(1); const float* cc = PIN(3); const float* mw = PIN(4); const float* mb = PIN(5);
    float* modv = (float*)(wsb + WS_MODV);
    LAS float* red = (LAS float*)lds;
    const int tid = tidx_, cq = tid & 15, ks = tid >> 4;
    for (int item = bidx_; item < 4 * 96; item += gridDim.x) {
        const int layer = item / 96, n0 = (item % 96) * 64;
        f32x4 aL = {0.f, 0.f, 0.f, 0.f}, aC = {0.f, 0.f, 0.f, 0.f};
        const float* wp = mw + ((size_t)layer * 1024 + ks * 32) * 6144 + n0 + 4 * cq;
        for (int k = 0; k < 32; ++k) {
            const float cv = c[ks * 32 + k], xv = cc[ks * 32 + k];
            const float sl = cv / (1.f + expf(-cv)), sc = xv / (1.f + expf(-xv));
            const f32x4 w = *(const f32x4*)(wp + (size_t)k * 6144);
            aL += w * sl; aC += w * sc;
        }
        LAS float* r = red + (ks * 16 + cq) * 8;
        r[0] = aL[0]; r[1] = aL[1]; r[2] = aL[2]; r[3] = aL[3]; r[4] = aC[0]; r[5] = aC[1]; r[6] = aC[2]; r[7] = aC[3];
        __syncthreads();
        if (tid < 128) { const int cq2 = tid & 15, j = tid >> 4; float s = 0.f;
            for (int k2 = 0; k2 < 32; ++k2) s += red[(k2 * 16 + cq2) * 8 + j];
            const int n = n0 + 4 * cq2 + (j & 3), stream = j >> 2;
            modv[(layer * 2 + stream) * 6144 + n] = s + mb[layer * 6144 + n]; }
        __syncthreads();
    }
}
__device__ __forceinline__ void pro_tables(const int wave_s_, const P& p) { unsigned char* const wsb = lndp(p.ws); const int tidx_ = tid_of(wave_s_); const int bidx_ = lnds((int)blockIdx.x);
    const int gt = bidx_ * 512 + tidx_, GT = gridDim.x * 512;
    f32x2* tw = (f32x2*)(wsb + WS_TW);
    for (int t = gt; t <= 8192; t += GT) { float s, c; sincospif((float)t * (1.0f / 8192.0f), &s, &c); tw[t] = (f32x2){c, -s}; }
    f32x2* rope = (f32x2*)(wsb + WS_ROPE);
    for (int i = gt; i < LSEQ * 32; i += GT) { const int t = i >> 5, j = i & 31; const int pos = j < 16 ? (t >> 6) : (t & 63);
        const float inv = powf(10000.0f, -(float)(2 * (j & 15)) / 32.0f); const float ang = (float)pos * inv; float s, c; sincosf(ang, &s, &c); rope[i] = (f32x2){c, s}; }
}
__device__ __forceinline__ void ew_phase(const int wave_s_, const P& p, int mode, int layer) { unsigned char* const wsb = lndp(p.ws); const int tidx_ = tid_of(wave_s_); const int bidx_ = lnds((int)blockIdx.x);
    const int lane = tidx_ & 63, wave = tidx_ >> 6;
    const int gw = bidx_ * 8 + wave, NGW = gridDim.x * 8;
    const float* modv = (const float*)(wsb + WS_MODV);
    const float* ss = (const float*)(wsb + (mode == 1 ? WS_SS1 : WS_SS2));
    const bf16_t* OL = (const bf16_t*)(wsb + WS_OL);
    bf16_t* H = (bf16_t*)(wsb + WS_H);
    float* xc = (float*)(wsb + WS_XC);
    const float* gpost = (mode == 1 ? PIN(7) : PIN(9)) + layer * 1024;
    const int gi = mode == 1 ? 2 : 5;
    const bool donorm = !(mode == 2 && layer == NLAYER - 1);
    const int nl = mode == 2 ? layer + 1 : layer;
    const float* gpre = (mode == 1 ? PIN(8) : PIN(6)) + (donorm ? nl : 0) * 1024;
    const int shi = mode == 1 ? 3 : 0, sci = mode == 1 ? 4 : 1;
    for (int row = gw; row < R; row += NGW) {
        const int stream = row < LCTX ? 1 : 0;
        float* xp = row < LCTX ? xc + (size_t)row * 1024 : p.out + (size_t)(row - LCTX) * 1024;
        const float* src = mode == 0 ? (row < LCTX ? PIN(2) + (size_t)row * 1024 : PIN(0) + (size_t)(row - LCTX) * 1024) : xp;
        f32x4 v[4];
#pragma unroll
        for (int j = 0; j < 4; ++j) v[j] = *(const f32x4*)(src + j * 256 + lane * 4);
        if (mode != 0) {
            const float rs = rsqrtf(ss[row] * (1.0f / 1024.0f) + EPS);
            const float* mg = modv + (layer * 2 + stream) * 6144 + gi * 1024;
#pragma unroll
            for (int j = 0; j < 4; ++j) { const int col = j * 256 + lane * 4;
                const f32x4 g = *(const f32x4*)(mg + col) * *(const f32x4*)(gpost + col) * rs;
                const u32x2 o = *(const u32x2*)(OL + (size_t)row * 1024 + col);
                v[j] += g * (f32x4){bflo(o.x), bfhi(o.x), bflo(o.y), bfhi(o.y)}; }
        }
#pragma unroll
        for (int j = 0; j < 4; ++j) *(f32x4*)(xp + j * 256 + lane * 4) = v[j];
        if (donorm) {
            float s = 0.f;
#pragma unroll
            for (int j = 0; j < 4; ++j) s += (v[j][0] * v[j][0] + v[j][1] * v[j][1]) + (v[j][2] * v[j][2] + v[j][3] * v[j][3]);
            s = wave_sum(s);
            const float rstd = rsqrtf(s * (1.0f / 1024.0f) + EPS);
            const float* msh = modv + (nl * 2 + stream) * 6144 + shi * 1024; const float* msc = modv + (nl * 2 + stream) * 6144 + sci * 1024;
#pragma unroll
            for (int j = 0; j < 4; ++j) { const int col = j * 256 + lane * 4;
                const f32x4 y = v[j] * rstd * *(const f32x4*)(gpre + col) * (*(const f32x4*)(msc + col) + 1.0f) + *(const f32x4*)(msh + col);
                u32x2 w; w.x = pk2(y[0], y[1]); w.y = pk2(y[2], y[3]);
                *(u32x2*)(H + (size_t)row * 1024 + col) = w; }
        }
    }
}
__device__ __forceinline__ void transpose_item(const float* W, int K, int N, bf16_t* WT, int ldo, LAS float* scr, int item, int lane) {
    const int nblk = N / 32, kb = item / nblk, nb = item % nblk, k0 = 64 * kb, n0 = 32 * nb;
#pragma unroll 8
    for (int i = 0; i < 32; ++i) { const int kk = 2 * i + (lane >> 5); scr[kk * 33 + (lane & 31)] = W[(size_t)(k0 + kk) * N + n0 + (lane & 31)]; }
    asm volatile("s_waitcnt lgkmcnt(0)" ::: "memory");
    const int c = lane & 7;
#pragma unroll
    for (int j = 0; j < 4; ++j) { const int n = (lane >> 3) + 8 * j; const LAS float* s = scr + (8 * c) * 33 + n;
        u32x4 o; o.x = pk2(s[0 * 33], s[1 * 33]); o.y = pk2(s[2 * 33], s[3 * 33]); o.z = pk2(s[4 * 33], s[5 * 33]); o.w = pk2(s[6 * 33], s[7 * 33]);
        *(u32x4*)(WT + (size_t)(n0 + n) * ldo + k0 + 8 * c) = o; }
    asm volatile("s_waitcnt lgkmcnt(0)" ::: "memory");
}
__device__ __forceinline__ void prep_layer(const int wave_s_, const P& p, int l, LAS unsigned char* lds) { unsigned char* const wsb = lndp(p.ws); const int tidx_ = tid_of(wave_s_); const int bidx_ = lnds((int)blockIdx.x);
    const int tid = tidx_, lane = tid & 63, wave = tid >> 6;
    const int gt = bidx_ * 512 + tid, GT = gridDim.x * 512;
    bf16_t* WIN = (bf16_t*)(wsb + WS_WIN); bf16_t* WOUT = (bf16_t*)(wsb + WS_WOUT); bf16_t* W1 = (bf16_t*)(wsb + WS_W1); bf16_t* W2 = (bf16_t*)(wsb + WS_W2);
    bf16_t* W3T = (bf16_t*)(wsb + WS_W3T); bf16_t* GLUT = (bf16_t*)(wsb + WS_GLUT); bf16_t* H2L = (bf16_t*)(wsb + WS_H2L); float* H2C = (float*)(wsb + WS_H2C);
    {
        const u32x4 z4 = {0u, 0u, 0u, 0u};
        for (int i = gt; i < 1024 * 8; i += GT) *(u32x4*)(W3T + (size_t)(i >> 3) * 128 + 64 + (i & 7) * 8) = z4;
        for (int i = gt; i < 16384 * 8; i += GT) *(u32x4*)(H2L + (size_t)(i >> 3) * 128 + 64 + (i & 7) * 8) = z4;
    }
    constexpr int I_IN = 16 * 56, I_OUT = 16 * 32, I_1 = 16 * 128, I_2 = 64 * 32, I_3 = 1 * 32, I_G = 4 * 8;
    constexpr int NTILE = I_IN + I_OUT + I_1 + I_2 + I_3 + I_G;
    constexpr int N_S5 = 32, N_H2 = 130, N_TR = (NTILE + 7) / 8, N_ITEMS = N_S5 + N_H2 + N_TR;
    for (int item = bidx_; item < N_ITEMS; item += gridDim.x) {
        __syncthreads();
        if (item < N_S5) {
            LAS f32x2* pw = (LAS f32x2*)lds;
            LAS f32x2* bb = pw + 17 * 64;
            LAS f32x2* cc = bb + 64 * 16;
            LAS f32x2* crci = cc + 16 * 64;
            LAS float* kt = (LAS float*)(crci + 64);
            float* lamT = (float*)(wsb + WS_LAMT);
            const int dg = item, dir = dg >> 4, g = dg & 15; const int pb = ((l * 2 + dir) * 16 + g);
            if (tid < 64) {
                const float are = PIN(21)[pb * 64 + tid], aim = PIN(22)[pb * 64 + tid]; const float dt = expf(PIN(23)[pb]);
                const float mag = expf(are * dt), ang = aim * dt; const float lr = mag * cosf(ang), li = mag * sinf(ang);
                const float den = are * are + aim * aim, nr = lr - 1.0f, ni = li;
                crci[tid] = (f32x2){(nr * are + ni * aim) / den, (ni * are - nr * aim) / den};
                f32x2 w = {1.f, 0.f}; const f32x2 lam = {lr, li};
                for (int k = 0; k <= 16; ++k) { pw[k * 64 + tid] = w; w = cmul(w, lam); }
                const f32x2 l16 = pw[16 * 64 + tid]; lamT[dg * 128 + tid] = l16.x; lamT[dg * 128 + 64 + tid] = l16.y;
            }
            __syncthreads();
            for (int idx = tid; idx < 1024; idx += 512) {
                { const int pp = idx >> 4, h = idx & 15; const float bre = PIN(24)[(size_t)(pb * 64 + pp) * 16 + h], bim = PIN(25)[(size_t)(pb * 64 + pp) * 16 + h]; const f32x2 cr = crci[pp];
                  bb[idx] = (f32x2){cr.x * bre - cr.y * bim, cr.x * bim + cr.y * bre}; }
                { cc[idx] = (f32x2){PIN(26)[(size_t)pb * 1024 + idx], PIN(27)[(size_t)pb * 1024 + idx]}; }
            }
            __syncthreads();
            for (int idx = tid; idx < 4096; idx += 512) { const int k = idx >> 8, hp = (idx >> 4) & 15, h = idx & 15; float s = 0.f;
                for (int pp = 0; pp < 64; ++pp) { const f32x2 t = cmul(cc[hp * 64 + pp], pw[k * 64 + pp]); const f32x2 b = bb[pp * 16 + h]; s += t.x * b.x - t.y * b.y; }
                kt[idx] = s; }
            __syncthreads();
            unsigned* KI = (unsigned*)(wsb + WS_S5M + (size_t)dg * 256 * KiB); unsigned* BB = KI + 32768; unsigned* CC = BB + 16384;
            const float* dsk = PIN(28) + l * 256 + g * 16;
            for (int i2 = tid; i2 < 32768; i2 += 512) { const int n = i2 >> 7, kp = i2 & 127, kk = 2 * kp, s = kk >> 4, h = kk & 15, t = n >> 4, hp = n & 15;
                const int lag = dir == 0 ? t - s : s - t; float v0 = 0.f, v1 = 0.f;
                if (lag >= 0) { v0 = kt[(lag * 16 + hp) * 16 + h]; v1 = kt[(lag * 16 + hp) * 16 + h + 1]; }
                if (dir == 0 && lag == 0) { if (h == hp) v0 += dsk[hp]; if (h + 1 == hp) v1 += dsk[hp]; }
                KI[i2] = pk2(v0, v1); }
            for (int i2 = tid; i2 < 16384; i2 += 512) { const int col = i2 >> 7, kp = i2 & 127, kk = 2 * kp, s = kk >> 4, h = kk & 15, ri = col >> 6, pp = col & 63;
                const int e = dir == 0 ? 15 - s : s; const f32x2 w = pw[e * 64 + pp]; const f32x2 a = cmul(w, bb[pp * 16 + h]), b = cmul(w, bb[pp * 16 + h + 1]);
                BB[i2] = ri == 0 ? pk2(a.x, b.x) : pk2(a.y, b.y); }
            for (int i2 = tid; i2 < 16384; i2 += 512) { const int n = i2 >> 6, cp = i2 & 63, col = 2 * cp, ri = col >> 6, pp = col & 63, t = n >> 4, hp = n & 15;
                const int e = dir == 0 ? t + 1 : 16 - t; const f32x2 a = cmul(cc[hp * 64 + pp], pw[e * 64 + pp]), b = cmul(cc[hp * 64 + pp + 1], pw[e * 64 + pp + 1]);
                CC[i2] = ri == 0 ? pk2(a.x, b.x) : pk2(-a.y, -b.y); }
        } else if (item < N_S5 + N_H2) {
            LAS float* w1s = (LAS float*)lds; LAS float* b1s = w1s + 33 * 64; LAS float* w2s = b1s + 64; LAS float* b2s = w2s + 4096;
            for (int i = tid; i < 33 * 64; i += 512) w1s[i] = PIN(14)[l * 33 * 64 + i];
            for (int i = tid; i < 4096; i += 512) w2s[i] = PIN(16)[l * 4096 + i];
            if (tid < 64) { b1s[tid] = PIN(15)[l * 64 + tid]; b2s[tid] = PIN(17)[l * 64 + tid]; }
            __syncthreads();
            const int rr = (item - N_S5) * 128 + (tid >> 2), part = tid & 3; const bool isctx = rr >= LSEQ; const int n = isctx ? rr - LSEQ : rr;
            const float t = (float)n / (isctx ? 256.0f : 16384.0f);
            float h1[64];
#pragma unroll
            for (int j = 0; j < 64; ++j) h1[j] = b1s[j] + t * w1s[j];
            _Pragma("nounroll") for (int f = 1; f <= 16; ++f) { float cs, sn; sincospif(2.0f * t * (float)f, &sn, &cs);
#pragma unroll
                for (int j = 0; j < 64; ++j) h1[j] += cs * w1s[f * 64 + j] + sn * w1s[(16 + f) * 64 + j]; }
#pragma unroll
            for (int j = 0; j < 64; ++j) h1[j] = sinpif(h1[j] * 0.3183098861837907f);
            _Pragma("nounroll") for (int jj = 0; jj < 16; jj += 2) { const int j = part * 16 + jj; float a0 = b2s[j], a1 = b2s[j + 1];
#pragma unroll
                for (int i = 0; i < 64; ++i) { a0 += h1[i] * w2s[i * 64 + j]; a1 += h1[i] * w2s[i * 64 + j + 1]; }
                a0 = sinpif(a0 * 0.3183098861837907f); a1 = sinpif(a1 * 0.3183098861837907f);
                if (isctx) { H2C[n * 64 + j] = a0; H2C[n * 64 + j + 1] = a1; } else *(unsigned*)(H2L + (size_t)n * 128 + j) = pk2(a0, a1); }
        } else {
            LAS float* scr = (LAS float*)(lds + wave * 16384);
            int r = (item - N_S5 - N_H2) * 8 + wave;
            if (r < NTILE) {
                if (r < I_IN) transpose_item(PIN(10) + (size_t)l * DM * NIN, DM, NIN, WIN, DM, scr, r, lane);
                else if ((r -= I_IN) < I_OUT) transpose_item(PIN(11) + (size_t)l * DM * DM, DM, DM, WOUT, DM, scr, r, lane);
                else if ((r -= I_OUT) < I_1) transpose_item(PIN(35) + (size_t)l * DM * FF, DM, FF, W1, DM, scr, r, lane);
                else if ((r -= I_1) < I_2) transpose_item(PIN(36) + (size_t)l * FF * DM, FF, DM, W2, FF, scr, r, lane);
                else if ((r -= I_2) < I_3) transpose_item(PIN(18) + (size_t)l * 64 * 1024, 64, 1024, W3T, 128, scr, r, lane);
                else { r -= I_3; transpose_item(PIN(29) + (size_t)l * 256 * 256, 256, 256, GLUT, 256, scr, r, lane); }
            }
        }
    }
    __syncthreads();
}

__device__ __forceinline__ void pb_attprep(const int wave_s_, const P& p, int l) { unsigned char* const wsb = lndp(p.ws); const int tidx_ = tid_of(wave_s_); const int bidx_ = lnds((int)blockIdx.x);
    const int gt = bidx_ * 512 + tidx_, GT = gridDim.x * 512;
    const bf16_t* U = (const bf16_t*)(wsb + WS_U); bf16_t* QN = (bf16_t*)(wsb + WS_QN); bf16_t* KN = (bf16_t*)(wsb + WS_KN);
    const f32x2* rope = (const f32x2*)(wsb + WS_ROPE);
    for (int idx = gt; idx < R * 6; idx += GT) {
        const int row = idx / 6, slot = idx - row * 6;
        const bf16_t* src = U + (size_t)row * NIN + (slot < 4 ? 1280 + slot * 64 : 1536 + (slot - 4) * 64);
        const float* gain = (slot < 4 ? PIN(33) : PIN(34)) + l * 64;
        float x[64]; float ms = 0.f;
#pragma unroll
        for (int c = 0; c < 8; ++c) { const u32x4 w = *(const u32x4*)(src + c * 8);
            x[c * 8 + 0] = bflo(w.x); x[c * 8 + 1] = bfhi(w.x); x[c * 8 + 2] = bflo(w.y); x[c * 8 + 3] = bfhi(w.y); x[c * 8 + 4] = bflo(w.z); x[c * 8 + 5] = bfhi(w.z); x[c * 8 + 6] = bflo(w.w); x[c * 8 + 7] = bfhi(w.w); }
#pragma unroll
        for (int d = 0; d < 64; ++d) ms += x[d] * x[d];
        const float rs = rsqrtf(ms * (1.0f / 64.0f) + EPS);
#pragma unroll
        for (int d = 0; d < 64; ++d) x[d] = x[d] * rs * gain[d];
        if (row >= LCTX) { const f32x2* rp = rope + (size_t)(row - LCTX) * 32;
#pragma unroll
            for (int i = 0; i < 32; ++i) { const f32x2 cs = rp[i]; const float x0 = x[2 * i], x1 = x[2 * i + 1]; x[2 * i] = x0 * cs.x - x1 * cs.y; x[2 * i + 1] = x0 * cs.y + x1 * cs.x; } }
        const float sc = slot < 4 ? QSCALE : 1.0f;
        bf16_t* dst = slot < 4 ? QN + (size_t)row * 256 + slot * 64 : KN + (size_t)row * 128 + (slot - 4) * 64;
#pragma unroll
        for (int c = 0; c < 8; ++c) { u32x4 w; w.x = pk2(x[c * 8] * sc, x[c * 8 + 1] * sc); w.y = pk2(x[c * 8 + 2] * sc, x[c * 8 + 3] * sc); w.z = pk2(x[c * 8 + 4] * sc, x[c * 8 + 5] * sc); w.w = pk2(x[c * 8 + 6] * sc, x[c * 8 + 7] * sc);
            *(u32x4*)(dst + c * 8) = w; }
    }
}
__device__ __forceinline__ void pb_s5local(const int wave_s_, const P& p) { unsigned char* const wsb = lndp(p.ws); const int tidx_ = tid_of(wave_s_); const int bidx_ = lnds((int)blockIdx.x);
    const int lane = tidx_ & 63, wave = tidx_ >> 6, gw = bidx_ * 8 + wave, NGW = gridDim.x * 8;
    const bf16_t* U = (const bf16_t*)(wsb + WS_U); float* SC = (float*)(wsb + WS_SC);
    const int m = lane & 15, kq = lane >> 4;
    for (int it = gw; it < 32 * 65; it += NGW) {
        const int dg = it / 65, ct = it - dg * 65, g = dg & 15;
        const bf16_t* BB = (const bf16_t*)(wsb + WS_S5M + (size_t)dg * 256 * KiB + 128 * KiB);
        f32x4 acc[8];
#pragma unroll
        for (int n = 0; n < 8; ++n) acc[n] = (f32x4){0.f, 0.f, 0.f, 0.f};
        const int chunk = ct * 16 + m;
        for (int ks = 0; ks < 8; ++ks) {
            const int k0 = ks * 32 + 8 * kq;
            const bf16x8 a = *(const bf16x8*)(U + (size_t)(chunk * 16 + (k0 >> 4)) * NIN + 768 + g * 16 + (k0 & 15));
#pragma unroll
            for (int n = 0; n < 8; ++n) { const bf16x8 b = *(const bf16x8*)(BB + (size_t)(n * 16 + m) * 256 + k0);
                acc[n] = __builtin_amdgcn_mfma_f32_16x16x32_bf16(a, b, acc[n], 0, 0, 0); }
        }
#pragma unroll
        for (int n = 0; n < 8; ++n)
#pragma unroll
            for (int i = 0; i < 4; ++i) SC[((size_t)dg * NCH + ct * 16 + 4 * kq + i) * 128 + n * 16 + m] = acc[n][i];
    }
}
__device__ __forceinline__ void pb_pool(const int wave_s_, const P& p, int l, LAS unsigned char* lds) { unsigned char* const wsb = lndp(p.ws); const int tidx_ = tid_of(wave_s_); const int bidx_ = lnds((int)blockIdx.x);
    const int tid = tidx_;
    const bf16_t* U = (const bf16_t*)(wsb + WS_U); bf16_t* MG = (bf16_t*)(wsb + WS_MERGED);
    LAS float* ut = (LAS float*)lds;
    LAS float* pt = ut + 80 * 64;
    LAS float* wt = pt + 64 * 65;
    for (int item = bidx_; item < 260 * 4; item += gridDim.x) {
        const int g = item & 3, r0 = (item >> 2) * 64; const int win = 2 << g, hw = win >> 1;
        const int seg0 = r0 < LCTX ? 0 : LCTX, seg1 = r0 < LCTX ? LCTX : R;
        __syncthreads();
        for (int i = tid; i < 80 * 8; i += 512) { const int rr = i >> 3, c8 = (i & 7) * 8; const int row = r0 - 8 + rr; f32x4 a = {0.f, 0.f, 0.f, 0.f}, b = a;
            if (row >= seg0 && row < seg1) { const u32x4 w = *(const u32x4*)(U + (size_t)row * NIN + 1024 + g * 64 + c8); a = (f32x4){bflo(w.x), bfhi(w.x), bflo(w.y), bfhi(w.y)}; b = (f32x4){bflo(w.z), bfhi(w.z), bflo(w.w), bfhi(w.w)}; }
            *(LAS f32x4*)(ut + rr * 64 + c8) = a; *(LAS f32x4*)(ut + rr * 64 + c8 + 4) = b; }
        for (int i = tid; i < 4096; i += 512) wt[i] = PIN(31)[(size_t)(l * 4 + g) * 4096 + i];
        __syncthreads();
        { const int t = tid >> 3, c8 = (tid & 7) * 8; const int row = r0 + t;
          int lo = row - hw; if (lo < seg0) lo = seg0; int hi = row + hw; if (hi > seg1) hi = seg1; const float inv = 1.0f / (float)(hi - lo);
#pragma unroll
          for (int c = 0; c < 8; ++c) { float s = 0.f; for (int rr = lo; rr < hi; ++rr) s += ut[(rr - r0 + 8) * 64 + c8 + c]; pt[t * 65 + c8 + c] = s * inv - ut[(t + 8) * 64 + c8 + c]; } }
        __syncthreads();
        { const int t = tid >> 3, d8 = (tid & 7) * 8; float acc[8];
#pragma unroll
          for (int d = 0; d < 8; ++d) acc[d] = 0.f;
          for (int c = 0; c < 64; ++c) { const float pv = pt[t * 65 + c]; const f32x4 w0 = *(const LAS f32x4*)(wt + c * 64 + d8), w1 = *(const LAS f32x4*)(wt + c * 64 + d8 + 4);
              acc[0] += pv * w0[0]; acc[1] += pv * w0[1]; acc[2] += pv * w0[2]; acc[3] += pv * w0[3]; acc[4] += pv * w1[0]; acc[5] += pv * w1[1]; acc[6] += pv * w1[2]; acc[7] += pv * w1[3]; }
          const float* sc = PIN(32) + l * 256 + g * 64 + d8;
          u32x4 w; w.x = pk2(acc[0] * sc[0], acc[1] * sc[1]); w.y = pk2(acc[2] * sc[2], acc[3] * sc[3]); w.z = pk2(acc[4] * sc[4], acc[5] * sc[5]); w.w = pk2(acc[6] * sc[6], acc[7] * sc[7]);
          *(u32x4*)(MG + (size_t)(r0 + t) * 1024 + 512 + g * 64 + d8) = w; }
    }
    __syncthreads();
}
__device__ __forceinline__ void pb_shortconv(const int wave_s_, const P& p, int l, LAS unsigned char* lds) { unsigned char* const wsb = lndp(p.ws); const int tidx_ = tid_of(wave_s_); const int bidx_ = lnds((int)blockIdx.x);
    const int tid = tidx_;
    const bf16_t* U = (const bf16_t*)(wsb + WS_U); bf16_t* VXT = (bf16_t*)(wsb + WS_VXT);
    LAS float* ut = (LAS float*)lds;
    const float* cw = PIN(12) + (size_t)l * 3 * 768; const float* cb = PIN(13) + l * 768;
    for (int item = bidx_; item < 256 * 12; item += gridDim.x) {
        const int cbk = item % 12, t0 = (item / 12) * 64, c0 = cbk * 64;
        __syncthreads();
        for (int i = tid; i < 66 * 8; i += 512) { const int rr = i >> 3, c8 = (i & 7) * 8; const int t = t0 - 1 + rr; f32x4 a = {0.f, 0.f, 0.f, 0.f}, b = a;
            if (t >= 0 && t < LSEQ) { const u32x4 w = *(const u32x4*)(U + (size_t)(LCTX + t) * NIN + c0 + c8); a = (f32x4){bflo(w.x), bfhi(w.x), bflo(w.y), bfhi(w.y)}; b = (f32x4){bflo(w.z), bfhi(w.z), bflo(w.w), bfhi(w.w)}; }
            LAS float* d = ut + rr * 65 + c8; d[0] = a[0]; d[1] = a[1]; d[2] = a[2]; d[3] = a[3]; d[4] = b[0]; d[5] = b[1]; d[6] = b[2]; d[7] = b[3]; }
        __syncthreads();
        { const int c = tid >> 3, t8 = (tid & 7) * 8; const int col = c0 + c; const float w0 = cw[col], w1 = cw[768 + col], w2 = cw[1536 + col], b = cb[col]; float y[8];
#pragma unroll
          for (int i = 0; i < 8; ++i) y[i] = b + w0 * ut[(t8 + i) * 65 + c] + w1 * ut[(t8 + i + 1) * 65 + c] + w2 * ut[(t8 + i + 2) * 65 + c];
          u32x4 w; w.x = pk2(y[0], y[1]); w.y = pk2(y[2], y[3]); w.z = pk2(y[4], y[5]); w.w = pk2(y[6], y[7]);
          *(u32x4*)(VXT + (size_t)col * LSEQ + t0 + t8) = w; }
    }
    __syncthreads();
}
__device__ __forceinline__ void pa_ctxtaps(const int wave_s_, const P& p, int l) { unsigned char* const wsb = lndp(p.ws); const int tidx_ = tid_of(wave_s_); const int bidx_ = lnds((int)blockIdx.x);
    const float* H2C = (const float*)(wsb + WS_H2C); float* KCT = (float*)(wsb + WS_KCT);
    const float* w3 = PIN(18) + (size_t)l * 64 * 1024; const float* dec = PIN(19) + l * 1024;
    for (int idx = bidx_ * 512 + tidx_; idx < 2 * 256 * 256; idx += gridDim.x * 512) {
        const int ch = idx & 255, n = (idx >> 8) & 255, o = idx >> 16;
        float af = 0.f, ab = 0.f;
#pragma unroll 8
        for (int j = 0; j < 64; ++j) { const float hv = H2C[n * 64 + j]; af += hv * w3[j * 1024 + o * 512 + ch]; ab += hv * w3[j * 1024 + o * 512 + 256 + ch]; }
        const float t = (float)n * (1.0f / 256.0f);
        float* kc = KCT + (size_t)(o * 256 + ch) * 512;
        kc[255 + n] = af * expf(-t * __builtin_fabsf(dec[o * 512 + ch])); if (n < 255) kc[254 - n] = ab * expf(-t * __builtin_fabsf(dec[o * 512 + 256 + ch])); else kc[511] = 0.f;
    }
}
__device__ __forceinline__ void pb_ctxhyena(const int wave_s_, const P& p, int l, LAS unsigned char* lds) { unsigned char* const wsb = lndp(p.ws); const int tidx_ = tid_of(wave_s_); const int bidx_ = lnds((int)blockIdx.x);
    const int tid = tidx_;
    const bf16_t* U = (const bf16_t*)(wsb + WS_U); bf16_t* MG = (bf16_t*)(wsb + WS_MERGED); const float* KCT = (const float*)(wsb + WS_KCT);
    LAS float* zc = (LAS float*)lds; LAS float* x1c = zc + 256; LAS float* x2c = zc + 512; LAS float* kc = zc + 768; LAS float* part = zc + 1280;
    const float* cw = PIN(12) + (size_t)l * 3 * 768; const float* cb = PIN(13) + l * 768;
    for (int ch = bidx_; ch < 256; ch += gridDim.x) {
        __syncthreads();
        if (tid < 256) { const int t = tid;
#pragma unroll
            for (int s = 0; s < 3; ++s) { const int col = s * 256 + ch; const float w0 = cw[col], w1 = cw[768 + col], w2 = cw[1536 + col], b = cb[col];
                const float um = t > 0 ? bf1(U[(size_t)(t - 1) * NIN + col]) : 0.f, u0 = bf1(U[(size_t)t * NIN + col]), up = t < 255 ? bf1(U[(size_t)(t + 1) * NIN + col]) : 0.f;
                (s == 0 ? zc : s == 1 ? x1c : x2c)[t] = b + w0 * um + w1 * u0 + w2 * up; } }
        for (int o = 0; o < 2; ++o) {
            kc[tid] = KCT[(size_t)(o * 256 + ch) * 512 + tid];
            __syncthreads();
            const int t = tid & 255, s0 = (tid >> 8) * 128; float y = 0.f;
#pragma unroll 8
            for (int s = 0; s < 128; ++s) y += zc[s0 + s] * kc[255 + t - s0 - s];
            part[tid] = y;
            __syncthreads();
            float zn = 0.f;
            if (tid < 256) zn = (o == 0 ? x1c[t] : x2c[t]) * (part[t] + part[256 + t] + PIN(20)[(l * 2 + o) * 256 + ch] * zc[t]);
            __syncthreads();
            if (tid < 256) zc[t] = zn;
            __syncthreads();
        }
        if (tid < 256) MG[(size_t)tid * 1024 + ch] = (bf16_t)f2bf(zc[tid]);
    }
    __syncthreads();
}

__device__ __forceinline__ void pc_s5carry(const int wave_s_, const P& p, LAS unsigned char* lds) { unsigned char* const wsb = lndp(p.ws); const int tidx_ = tid_of(wave_s_); const int bidx_ = lnds((int)blockIdx.x);
    const float* SC = (const float*)(wsb + WS_SC); float* HIN = (float*)(wsb + WS_HIN); const float* lamT = (const float*)(wsb + WS_LAMT);
    LAS f32x2* ex = (LAS f32x2*)lds;
    const int pl = tidx_ & 31, seg = tidx_ >> 5;
    for (int wb = bidx_; wb < 64; wb += gridDim.x) {
        const int chain = wb * 32 + pl, dg = chain >> 6, pp = chain & 63, dir = dg >> 4;
        const f32x2 lam = {lamT[dg * 128 + pp], lamT[dg * 128 + 64 + pp]};
        const float* sb = SC + (size_t)dg * NCH * 128 + pp; float* hb = HIN + (size_t)dg * NCH * 128 + pp;
        f32x2 h = {0.f, 0.f};
        for (int b0 = 0; b0 < 65; b0 += 13) {
            f32x2 sv[13];
#pragma unroll
            for (int j = 0; j < 13; ++j) { const int q = seg * 65 + b0 + j; const int c = dir == 0 ? q : (q < 16 ? 15 - q : NCH + 15 - q); sv[j] = (f32x2){sb[(size_t)c * 128], sb[(size_t)c * 128 + 64]}; }
#pragma unroll
            for (int j = 0; j < 13; ++j) h = cmul(lam, h) + sv[j];
        }
        __syncthreads();
        ex[seg * 32 + pl] = h;
        __syncthreads();
        f32x2 l65 = {1.f, 0.f};
        for (int k = 0; k < 65; ++k) l65 = cmul(l65, lam);
        f32x2 cin = {0.f, 0.f};
        for (int s2 = 0; s2 < seg; ++s2) cin = cmul(l65, cin) + ex[s2 * 32 + pl];
        h = cin;
        for (int b0 = 0; b0 < 65; b0 += 13) {
            f32x2 sv[13]; int cidx[13];
#pragma unroll
            for (int j = 0; j < 13; ++j) { const int q = seg * 65 + b0 + j; const int c = dir == 0 ? q : (q < 16 ? 15 - q : NCH + 15 - q); cidx[j] = c; sv[j] = (f32x2){sb[(size_t)c * 128], sb[(size_t)c * 128 + 64]}; }
#pragma unroll
            for (int j = 0; j < 13; ++j) { hb[(size_t)cidx[j] * 128] = h.x; hb[(size_t)cidx[j] * 128 + 64] = h.y; h = cmul(lam, h) + sv[j]; }
        }
    }
    __syncthreads();
}
typedef __bf16 bf16x2_t __attribute__((ext_vector_type(2)));
__device__ __forceinline__ unsigned cvtpk(float lo, float hi) { f32x2 v = {lo, hi}; bf16x2_t b = __builtin_convertvector(v, bf16x2_t); return __builtin_bit_cast(unsigned, b); }
constexpr float ATT_THR = 10.0f;
__device__ __forceinline__ void pc_attention(const int wave_s_, const P& p, LAS unsigned char* lds) { unsigned char* const wsb = lndp(p.ws); const int tidx_ = tid_of(wave_s_); const int bidx_ = lnds((int)blockIdx.x);
    const int tid = tidx_, lane = tid & 63, wave = tid >> 6, r32 = lane & 31, hi = lane >> 5;
    const bf16_t* U = (const bf16_t*)(wsb + WS_U); const bf16_t* QN = (const bf16_t*)(wsb + WS_QN); const bf16_t* KN = (const bf16_t*)(wsb + WS_KN); bf16_t* MG = (bf16_t*)(wsb + WS_MERGED);
    constexpr int RS = 72;
    LAS bf16_t* Ks = (LAS bf16_t*)lds;
    LAS bf16_t* Vs = Ks + 2 * 64 * RS;
    for (int unit = bidx_; unit < 260; unit += gridDim.x) {
        int kh, qb; if (unit < 256) { kh = unit & 1; qb = 2 + (unit >> 1); } else { kh = unit & 1; qb = (unit - 256) >> 1; }
        const int nt = qb < 2 ? 4 : 260;
        const int hq = kh * 2 + (wave >> 2); const int qrow = qb * 128 + (wave & 3) * 32 + r32;
        bf16x8 qr[4];
#pragma unroll
        for (int dk = 0; dk < 4; ++dk) qr[dk] = *(const bf16x8*)(QN + (size_t)qrow * 256 + hq * 64 + dk * 16 + hi * 8);
        f32x16 o0, o1, negm;
#pragma unroll
        for (int i = 0; i < 16; ++i) { o0[i] = 0.f; o1[i] = 0.f; negm[i] = 0.f; }
        float mref = 0.f, lsum = 0.f;
        const int klr = tid >> 3, kseg = (tid & 7) * 8;
        const int vlr = lane, vseg = wave * 8;
        const bf16_t* kg = KN + (size_t)klr * 128 + kh * 64 + kseg; const bf16_t* vg = U + (size_t)vlr * NIN + 1664 + kh * 64 + vseg;
        u32x4 kreg = *(const u32x4*)kg, vreg = *(const u32x4*)vg;
        __syncthreads();
        for (int t = 0; t < nt; ++t) {
            const int buf = t & 1;
            LAS bf16_t* Kb = Ks + buf * 64 * RS; LAS bf16_t* Vb = Vs + buf * 64 * RS;
            *(LAS u32x4*)(Kb + klr * RS + kseg) = kreg;
            { LAS bf16_t* vd = Vb + vseg * RS + vlr;
              vd[0 * RS] = (bf16_t)(vreg.x & 0xffffu); vd[1 * RS] = (bf16_t)(vreg.x >> 16); vd[2 * RS] = (bf16_t)(vreg.y & 0xffffu); vd[3 * RS] = (bf16_t)(vreg.y >> 16);
              vd[4 * RS] = (bf16_t)(vreg.z & 0xffffu); vd[5 * RS] = (bf16_t)(vreg.z >> 16); vd[6 * RS] = (bf16_t)(vreg.w & 0xffffu); vd[7 * RS] = (bf16_t)(vreg.w >> 16); }
            if (t + 1 < nt) { kreg = *(const u32x4*)(kg + (size_t)(t + 1) * 64 * 128); vreg = *(const u32x4*)(vg + (size_t)(t + 1) * 64 * NIN); }
            __syncthreads();
            f32x16 p0, p1;
            __builtin_amdgcn_s_setprio(1);
#pragma unroll
            for (int dk = 0; dk < 4; ++dk) {
                const bf16x8 a0 = *(const LAS bf16x8*)(Kb + r32 * RS + dk * 16 + hi * 8);
                const bf16x8 a1 = *(const LAS bf16x8*)(Kb + (32 + r32) * RS + dk * 16 + hi * 8);
                if (dk == 0) { p0 = __builtin_amdgcn_mfma_f32_32x32x16_bf16(a0, qr[0], negm, 0, 0, 0); p1 = __builtin_amdgcn_mfma_f32_32x32x16_bf16(a1, qr[0], negm, 0, 0, 0); }
                else { p0 = __builtin_amdgcn_mfma_f32_32x32x16_bf16(a0, qr[dk], p0, 0, 0, 0); p1 = __builtin_amdgcn_mfma_f32_32x32x16_bf16(a1, qr[dk], p1, 0, 0, 0); }
            }
            __builtin_amdgcn_s_setprio(0);
            float mx = fmaxf(fmaxf(p0[0], p0[1]), p1[0]);
#pragma unroll
            for (int i = 2; i < 16; i += 2) mx = fmaxf(fmaxf(mx, p0[i]), p0[i + 1]);
#pragma unroll
            for (int i = 1; i < 15; i += 2) mx = fmaxf(fmaxf(mx, p1[i]), p1[i + 1]);
            mx = fmaxf(mx, p1[15]);
            mx = fmaxf(mx, __shfl_xor(mx, 32));
            const bool first = (t == 0);
            if (first || __any(mx > ATT_THR)) {
                const float d = first ? mx : fmaxf(mx, 0.f);
                mref += d;
#pragma unroll
                for (int i = 0; i < 16; ++i) { p0[i] -= d; p1[i] -= d; negm[i] = -mref; }
                if (!first) { const float al = __builtin_amdgcn_exp2f(-d); lsum *= al;
#pragma unroll
                    for (int i = 0; i < 16; ++i) { o0[i] *= al; o1[i] *= al; } }
            }
            float ps = 0.f;
#pragma unroll
            for (int i = 0; i < 16; ++i) { p0[i] = __builtin_amdgcn_exp2f(p0[i]); p1[i] = __builtin_amdgcn_exp2f(p1[i]); ps += p0[i] + p1[i]; }
            lsum += ps;
            __builtin_amdgcn_s_setprio(1);
#pragma unroll
            for (int j = 0; j < 4; ++j) {
                const int half = j >> 1, jj = j & 1;
                u32x4 pb;
                if (half == 0) { pb.x = cvtpk(p0[8 * jj + 0], p0[8 * jj + 1]); pb.y = cvtpk(p0[8 * jj + 2], p0[8 * jj + 3]); pb.z = cvtpk(p0[8 * jj + 4], p0[8 * jj + 5]); pb.w = cvtpk(p0[8 * jj + 6], p0[8 * jj + 7]); }
                else { pb.x = cvtpk(p1[8 * jj + 0], p1[8 * jj + 1]); pb.y = cvtpk(p1[8 * jj + 2], p1[8 * jj + 3]); pb.z = cvtpk(p1[8 * jj + 4], p1[8 * jj + 5]); pb.w = cvtpk(p1[8 * jj + 6], p1[8 * jj + 7]); }
                const bf16x8 pf = __builtin_bit_cast(bf16x8, pb);
                const int kvo = half * 32 + jj * 16 + 4 * hi;
                { const u32x2 lo = *(const LAS u32x2*)(Vb + r32 * RS + kvo), hi2 = *(const LAS u32x2*)(Vb + r32 * RS + kvo + 8);
                  const u32x4 av = {lo.x, lo.y, hi2.x, hi2.y}; o0 = __builtin_amdgcn_mfma_f32_32x32x16_bf16(__builtin_bit_cast(bf16x8, av), pf, o0, 0, 0, 0); }
                { const u32x2 lo = *(const LAS u32x2*)(Vb + (32 + r32) * RS + kvo), hi2 = *(const LAS u32x2*)(Vb + (32 + r32) * RS + kvo + 8);
                  const u32x4 av = {lo.x, lo.y, hi2.x, hi2.y}; o1 = __builtin_amdgcn_mfma_f32_32x32x16_bf16(__builtin_bit_cast(bf16x8, av), pf, o1, 0, 0, 0); }
            }
            __builtin_amdgcn_s_setprio(0);
        }
        lsum += __shfl_xor(lsum, 32);
        const float il = 1.0f / lsum;
        bf16_t* op = MG + (size_t)qrow * 1024 + 768 + hq * 64;
#pragma unroll
        for (int a = 0; a < 4; ++a) {
            u32x2 w; w.x = cvtpk(o0[4 * a] * il, o0[4 * a + 1] * il); w.y = cvtpk(o0[4 * a + 2] * il, o0[4 * a + 3] * il); *(u32x2*)(op + 8 * a + 4 * hi) = w;
            u32x2 w2; w2.x = cvtpk(o1[4 * a] * il, o1[4 * a + 1] * il); w2.y = cvtpk(o1[4 * a + 2] * il, o1[4 * a + 3] * il); *(u32x2*)(op + 32 + 8 * a + 4 * hi) = w2;
        }
        __syncthreads();
    }
}
#define FIDX(i) ((i) ^ ((((i) >> 5) & 3) * 5) ^ ((((i) >> 6) & 1) << 4))
constexpr int FFT_BUF_BYTES = NFFT * 8, FFT_WHI_OFF = FFT_BUF_BYTES, FFT_WLO_OFF = FFT_WHI_OFF + 128 * 8;
__device__ __forceinline__ f32x2 fft_tw(const LAS f32x2* whi, const LAS f32x2* wlo, int t) { return cmul(whi[t >> 6], wlo[t & 63]); }
__device__ __forceinline__ void fft_fwd(LAS f32x2* buf, const LAS f32x2* whi, const LAS f32x2* wlo, int tid) {
    for (int s = 0; s < 7; ++s) {
        const int lq = 12 - 2 * s, q = 1 << lq;
        __syncthreads();
#pragma unroll 4
        for (int i = 0; i < 8; ++i) { const int id = tid + 512 * i; const int j = id & (q - 1), blk = id >> lq; const int i0 = (blk << (lq + 2)) + j;
            const int x0 = FIDX(i0), x1 = FIDX(i0 + q), x2 = FIDX(i0 + 2 * q), x3 = FIDX(i0 + 3 * q);
            const f32x2 a0 = buf[x0], a1 = buf[x1], a2 = buf[x2], a3 = buf[x3];
            const f32x2 w1 = fft_tw(whi, wlo, j << (2 * s)); const f32x2 w2 = cmul(w1, w1);
            const f32x2 b0 = a0 + a2, b2 = cmul(a0 - a2, w1), b1 = a1 + a3; const f32x2 t3 = cmul(a1 - a3, w1); const f32x2 b3 = {t3.y, -t3.x};
            buf[x0] = b0 + b1; buf[x1] = cmul(b0 - b1, w2); buf[x2] = b2 + b3; buf[x3] = cmul(b2 - b3, w2); }
    }
    __syncthreads();
}
__device__ __forceinline__ void fft_inv(LAS f32x2* buf, const LAS f32x2* whi, const LAS f32x2* wlo, int tid) {
    for (int s = 6; s >= 0; --s) {
        const int lq = 12 - 2 * s, q = 1 << lq;
        __syncthreads();
#pragma unroll 4
        for (int i = 0; i < 8; ++i) { const int id = tid + 512 * i; const int j = id & (q - 1), blk = id >> lq; const int i0 = (blk << (lq + 2)) + j;
            const int x0 = FIDX(i0), x1 = FIDX(i0 + q), x2 = FIDX(i0 + 2 * q), x3 = FIDX(i0 + 3 * q);
            const f32x2 c0 = buf[x0], c1 = buf[x1], c2 = buf[x2], c3 = buf[x3];
            const f32x2 w1 = fft_tw(whi, wlo, j << (2 * s)); const f32x2 w2 = cmul(w1, w1);
            const f32x2 t1 = cmulc(c1, w2), t3 = cmulc(c3, w2);
            const f32x2 b0 = c0 + t1, b1 = c0 - t1, b2 = c2 + t3, b3 = c2 - t3;
            const f32x2 u2 = cmulc(b2, w1); const f32x2 u3c = cmulc(b3, w1); const f32x2 u3 = {-u3c.y, u3c.x};
            buf[x0] = b0 + u2; buf[x2] = b0 - u2; buf[x1] = b1 + u3; buf[x3] = b1 - u3; }
    }
    __syncthreads();
}
__device__ __forceinline__ int brev14(int k) { return (int)(__builtin_bitreverse32((unsigned)k) >> 18); }
__device__ __forceinline__ void pc_hyena(const int wave_s_, const P& p, int l, LAS unsigned char* lds) { unsigned char* const wsb = lndp(p.ws); const int tidx_ = tid_of(wave_s_); const int bidx_ = lnds((int)blockIdx.x);
    const int tid = tidx_;
    LAS f32x2* buf = (LAS f32x2*)lds; LAS f32x2* whi = (LAS f32x2*)(lds + FFT_WHI_OFF); LAS f32x2* wlo = (LAS f32x2*)(lds + FFT_WLO_OFF);
    const f32x2* tw = (const f32x2*)(wsb + WS_TW);
    __syncthreads();
    if (tid < 128) whi[tid] = tw[tid * 64]; else if (tid < 192) wlo[tid - 128] = tw[tid - 128];
    const bf16_t* VXT = (const bf16_t*)(wsb + WS_VXT); float* Z1 = (float*)(wsb + WS_Z1); bf16_t* Z2T = (bf16_t*)(wsb + WS_Z2T);
    for (int ch = bidx_; ch < 256; ch += gridDim.x) {
        for (int o = 0; o < 2; ++o) {
            float* filt = (float*)(wsb + WS_FILT) + (size_t)(ch * 2 + o) * 2 * LSEQ;
            const float* hf = filt; const float* hb = filt + LSEQ;
            __syncthreads();
            for (int m = tid; m < NFFT; m += 512) { f32x2 v;
                if (m < NFFT / 2) v = *(const f32x2*)(hf + 2 * m);
                else { const int r = 2 * LSEQ - 2 * m - 2; const f32x2 t = *(const f32x2*)(hb + r); v = (f32x2){m == NFFT / 2 ? 0.f : t.y, t.x}; }
                buf[FIDX(m)] = v; }
            fft_fwd(buf, whi, wlo, tid);
            f32x4* ksp = (f32x4*)filt;
            const float sc = 1.0f / (float)NFFT;
            for (int ph2 = tid; ph2 < NFFT / 2; ph2 += 512) {
                if (ph2 == 0) { const f32x2 a = buf[0], b = buf[1]; ksp[0] = (f32x4){a.x * sc, a.y * sc, b.x * sc, b.y * sc}; }
                else { const int k = brev14(2 * ph2); const int q1 = 2 * ph2, q2 = brev14(NFFT - k); const f32x2 A = buf[FIDX(q1)], B = cconj(buf[FIDX(q2)]);
                    const f32x2 E = (A + B) * (0.5f * sc), D = (A - B) * (0.5f * sc); ksp[ph2] = (f32x4){E.x, E.y, D.y, -D.x}; }
            }
            __syncthreads();
            const bf16_t* zb = VXT + (size_t)ch * LSEQ; const float* z1 = Z1 + (size_t)ch * LSEQ;
            for (int m = tid; m < NFFT; m += 512) { f32x2 v = {0.f, 0.f};
                if (m < NFFT / 2) { if (o == 0) { const unsigned w = *(const unsigned*)(zb + 2 * m); v = (f32x2){bflo(w), bfhi(w)}; } else v = *(const f32x2*)(z1 + 2 * m); }
                buf[FIDX(m)] = v; }
            fft_fwd(buf, whi, wlo, tid);
            for (int ph2 = tid; ph2 < NFFT / 2; ph2 += 512) {
                const f32x4 ks = ksp[ph2];
                if (ph2 == 0) { const f32x2 a = buf[0], b = buf[1];
                    buf[0] = (f32x2){a.x * ks[0] + a.y * ks[1], a.x * ks[1] + a.y * ks[0]};
                    buf[1] = (f32x2){b.x * ks[2] - b.y * ks[3], b.x * ks[3] + b.y * ks[2]}; }
                else { const int k = brev14(2 * ph2); const int p1 = FIDX(2 * ph2), p2 = FIDX(brev14(NFFT - k)); const f32x2 A = buf[p1], B = cconj(buf[p2]);
                    const f32x2 Ez = (A + B) * 0.5f, Dz = (A - B) * 0.5f; const f32x2 Oz = {Dz.y, -Dz.x};
                    const f32x2 Ek = {ks[0], ks[1]}, Ok = {ks[2], ks[3]};
                    const f32x2 Ey = cmul(Ez, Ek) + cmul(fft_tw(whi, wlo, k), cmul(Oz, Ok)); const f32x2 Oy = cmul(Ez, Ok) + cmul(Oz, Ek);
                    buf[p1] = (f32x2){Ey.x - Oy.y, Ey.y + Oy.x};
                    buf[p2] = (f32x2){Ey.x + Oy.y, Oy.x - Ey.y}; }
            }
            fft_inv(buf, whi, wlo, tid);
            const float fb = PIN(20)[(l * 2 + o) * 256 + ch];
            const bf16_t* gt = VXT + (size_t)((o + 1) * 256 + ch) * LSEQ;
            for (int m = tid; m < NFFT / 2; m += 512) { const f32x2 y = buf[FIDX(m)]; f32x2 zp;
                if (o == 0) { const unsigned w = *(const unsigned*)(zb + 2 * m); zp = (f32x2){bflo(w), bfhi(w)}; } else zp = *(const f32x2*)(z1 + 2 * m);
                const unsigned gw = *(const unsigned*)(gt + 2 * m);
                const f32x2 zn = {bflo(gw) * (y.x + fb * zp.x), bfhi(gw) * (y.y + fb * zp.y)};
                if (o == 0) *(f32x2*)(Z1 + (size_t)ch * LSEQ + 2 * m) = zn; else *(unsigned*)(Z2T + (size_t)ch * LSEQ + 2 * m) = pk2(zn.x, zn.y); }
            __syncthreads();
        }
    }
}

__device__ __forceinline__ float gelu_tanh(float x) { const float u = 0.7978845608028654f * (x + 0.044715f * x * x * x); return 0.5f * x * (1.0f + tanhf(u)); }
__device__ __forceinline__ void pd_s5out(const int wave_s_, const P& p) { unsigned char* const wsb = lndp(p.ws); const int tidx_ = tid_of(wave_s_); const int bidx_ = lnds((int)blockIdx.x);
    const int lane = tidx_ & 63, wave = tidx_ >> 6, gw = bidx_ * 8 + wave, NGW = gridDim.x * 8;
    const bf16_t* U = (const bf16_t*)(wsb + WS_U); const float* HIN = (const float*)(wsb + WS_HIN); bf16_t* GB = (bf16_t*)(wsb + WS_GBUF);
    const int m = lane & 15, kq = lane >> 4;
    for (int it = gw; it < 16 * 65 * 2; it += NGW) {
        const int nh = it & 1, it2 = it >> 1, g = it2 / 65, ct = it2 - g * 65;
        f32x4 acc[8];
#pragma unroll
        for (int n = 0; n < 8; ++n) acc[n] = (f32x4){0.f, 0.f, 0.f, 0.f};
        const int chunk = ct * 16 + m;
        for (int dir = 0; dir < 2; ++dir) {
            const int dg = dir * 16 + g;
            const bf16_t* KI = (const bf16_t*)(wsb + WS_S5M + (size_t)dg * 256 * KiB) + (size_t)nh * 128 * 256; const bf16_t* CC = (const bf16_t*)(wsb + WS_S5M + (size_t)dg * 256 * KiB) + 65536 + 32768 + (size_t)nh * 128 * 128;
#pragma unroll 2
            for (int ks = 0; ks < 8; ++ks) { const int k0 = ks * 32 + 8 * kq;
                const bf16x8 a = *(const bf16x8*)(U + (size_t)(chunk * 16 + (k0 >> 4)) * NIN + 768 + g * 16 + (k0 & 15));
#pragma unroll
                for (int n = 0; n < 8; ++n) { const bf16x8 b = *(const bf16x8*)(KI + (size_t)(n * 16 + m) * 256 + k0); acc[n] = __builtin_amdgcn_mfma_f32_16x16x32_bf16(a, b, acc[n], 0, 0, 0); } }
#pragma unroll 2
            for (int ks = 0; ks < 4; ++ks) { const int k0 = ks * 32 + 8 * kq;
                const float* hp = HIN + ((size_t)dg * NCH + chunk) * 128 + k0; const f32x4 h0 = *(const f32x4*)hp, h1 = *(const f32x4*)(hp + 4);
                u32x4 aw; aw.x = pk2(h0[0], h0[1]); aw.y = pk2(h0[2], h0[3]); aw.z = pk2(h1[0], h1[1]); aw.w = pk2(h1[2], h1[3]);
                const bf16x8 a = __builtin_bit_cast(bf16x8, aw);
#pragma unroll
                for (int n = 0; n < 8; ++n) { const bf16x8 b = *(const bf16x8*)(CC + (size_t)(n * 16 + m) * 128 + k0); acc[n] = __builtin_amdgcn_mfma_f32_16x16x32_bf16(a, b, acc[n], 0, 0, 0); } }
        }
#pragma unroll
        for (int n = 0; n < 8; ++n)
#pragma unroll
            for (int i = 0; i < 4; ++i) { const int row = (ct * 16 + 4 * kq + i) * 16 + nh * 8 + n; GB[(size_t)row * 256 + g * 16 + m] = (bf16_t)f2bf(gelu_tanh(acc[n][i])); }
    }
}
__device__ __forceinline__ void pd_hytrans(const int wave_s_, const P& p, LAS unsigned char* lds) { unsigned char* const wsb = lndp(p.ws); const int tidx_ = tid_of(wave_s_); const int bidx_ = lnds((int)blockIdx.x);
    const int tid = tidx_;
    const bf16_t* Z2T = (const bf16_t*)(wsb + WS_Z2T); bf16_t* MG = (bf16_t*)(wsb + WS_MERGED);
    LAS bf16_t* tile = (LAS bf16_t*)lds;
    for (int item = bidx_; item < 256 * 4; item += gridDim.x) {
        const int c0 = (item & 3) * 64, t0 = (item >> 2) * 64;
        __syncthreads();
        { const int c = tid >> 3, t8 = (tid & 7) * 8; const u32x4 w = *(const u32x4*)(Z2T + (size_t)(c0 + c) * LSEQ + t0 + t8);
          LAS unsigned* d = (LAS unsigned*)(tile + c * 66 + t8); d[0] = w.x; d[1] = w.y; d[2] = w.z; d[3] = w.w; }
        __syncthreads();
        { const int t = tid >> 3, c8 = (tid & 7) * 8; unsigned short e[8];
#pragma unroll
          for (int i = 0; i < 8; ++i) e[i] = tile[(c8 + i) * 66 + t];
          u32x4 w; w.x = e[0] | ((unsigned)e[1] << 16); w.y = e[2] | ((unsigned)e[3] << 16); w.z = e[4] | ((unsigned)e[5] << 16); w.w = e[6] | ((unsigned)e[7] << 16);
          *(u32x4*)(MG + (size_t)(LCTX + t0 + t) * 1024 + c0 + c8) = w; }
    }
    __syncthreads();
}
__device__ __forceinline__ void pd2_glu(const int wave_s_, const P& p, int l) { unsigned char* const wsb = lndp(p.ws); const int tidx_ = tid_of(wave_s_); const int bidx_ = lnds((int)blockIdx.x);
    const int lane = tidx_ & 63, wave = tidx_ >> 6, gw = bidx_ * 8 + wave, NGW = gridDim.x * 8, r32 = lane & 31, hi = lane >> 5;
    const bf16_t* GB = (const bf16_t*)(wsb + WS_GBUF); const bf16_t* GLUT = (const bf16_t*)(wsb + WS_GLUT); bf16_t* MG = (bf16_t*)(wsb + WS_MERGED);
    const float* gb = PIN(30) + l * 256;
    for (int it = gw; it < 520 * 8; it += NGW) {
        const int rt = it >> 3, ct = it & 7;
        f32x16 acc;
#pragma unroll
        for (int i = 0; i < 16; ++i) acc[i] = 0.f;
#pragma unroll 8
        for (int ks = 0; ks < 16; ++ks) { const int k0 = ks * 16 + 8 * hi;
            const bf16x8 a = *(const bf16x8*)(GB + (size_t)(rt * 32 + r32) * 256 + k0); const bf16x8 b = *(const bf16x8*)(GLUT + (size_t)(ct * 32 + r32) * 256 + k0);
            acc = __builtin_amdgcn_mfma_f32_32x32x16_bf16(a, b, acc, 0, 0, 0); }
        const int col = ct * 32 + r32; const float bias = gb[col];
#pragma unroll
        for (int i = 0; i < 16; ++i) { const int row = rt * 32 + (i & 3) + 8 * (i >> 2) + 4 * hi; const float gv = bf1(GB[(size_t)row * 256 + col]);
            const float sg = 1.0f / (1.0f + expf(-(acc[i] + bias))); MG[(size_t)row * 1024 + 256 + col] = (bf16_t)f2bf(gv * sg); }
    }
}

#define XB_TMO      128
#define XB_XCNT(j)  (256  + 64 * (j))
#define XB_XSUB(j)  (1280 + 64 * (j))
#define XB_XGEN(j)  (2304 + 64 * (j))
#define XB_TOP      3328
#define XB_TOPGEN   3392
#define XCD_BAR_WORDS 3456
#define XB_SPIN_CAP (1u << 18)

__device__ __forceinline__ unsigned xb_ld(unsigned* p)              { return __hip_atomic_load(p, __ATOMIC_RELAXED, __HIP_MEMORY_SCOPE_AGENT); }
__device__ __forceinline__ unsigned xb_add(unsigned* p, unsigned v) { return __hip_atomic_fetch_add(p, v, __ATOMIC_RELAXED, __HIP_MEMORY_SCOPE_AGENT); }
__device__ __forceinline__ unsigned xb_xcc_id() { return (unsigned)__builtin_amdgcn_s_getreg((3 << 11) | 20) & 0xFu; }
#define XB_SPIN(cond, bar) do { unsigned _sp = 0; while (cond) { __builtin_amdgcn_s_sleep(1); \
    if ((++_sp & 255u) == 0u) { if (xb_ld(&(bar)[XB_TMO])) break; if (_sp > XB_SPIN_CAP) { atomicAdd(&(bar)[XB_TMO], 1u); break; } } } } while (0)

struct XcdBarrier {
    unsigned* bar; unsigned x;
    volatile LAS unsigned* st;
};

__device__ __forceinline__ XcdBarrier xcd_barrier_post(unsigned* bar, volatile LAS unsigned* st, int tid) {
    XcdBarrier b; b.bar = bar; b.x = xb_xcc_id(); b.st = st;
    if (tid == 0) (void)xb_add(&bar[XB_XCNT(b.x)], 1u);
    return b;
}
__device__ __forceinline__ void xcd_barrier_complete(unsigned* bar, unsigned x, unsigned& nloc, unsigned& nx) {
    const unsigned G = gridDim.x * gridDim.y * gridDim.z;
    unsigned sum, cnt, mine, sp = 0u;
    for (;;) {
        sum = 0u; cnt = 0u; mine = 0u;
#pragma unroll
        for (unsigned j = 0; j < 16; ++j) { const unsigned c = xb_ld(&bar[XB_XCNT(j)]); sum += c; cnt += (c > 0u) ? 1u : 0u; mine = (j == x) ? c : mine; }
        if (sum == G) break;
        __builtin_amdgcn_s_sleep(1);
        if ((++sp & 255u) == 0u) { if (xb_ld(&bar[XB_TMO])) break; if (sp > XB_SPIN_CAP) { atomicAdd(&bar[XB_TMO], 1u); break; } }
    }
    nloc = mine > 0u ? mine : 1u; nx = cnt > 0u ? cnt : 1u;
}

__device__ __forceinline__ void xcd_barrier(const XcdBarrier& b, int tid) {
    asm volatile("s_waitcnt vmcnt(0)" ::: "memory");
    __syncthreads();
    if (tid == 0) {
        unsigned* bar = b.bar;
        __builtin_amdgcn_s_waitcnt(0);
        unsigned nloc = b.st[0], nx = b.st[1];
        if (nloc == 0u) { xcd_barrier_complete(bar, b.x, nloc, nx); b.st[0] = nloc; b.st[1] = nx; }
        const unsigned old = xb_add(&bar[XB_XSUB(b.x)], 1u);
        const unsigned gen = old / nloc;
        if (old + 1u == (gen + 1u) * nloc) {
            __builtin_amdgcn_fence(__ATOMIC_RELEASE, "agent");
            asm volatile("s_waitcnt vmcnt(0)" ::: "memory");
            const unsigned og = xb_add(&bar[XB_TOP], 1u);
            const unsigned tg = og / nx;
            if (og + 1u == (tg + 1u) * nx) xb_add(&bar[XB_TOPGEN], 1u);
            else XB_SPIN(xb_ld(&bar[XB_TOPGEN]) == tg, bar);
            __builtin_amdgcn_fence(__ATOMIC_ACQUIRE, "agent");
            xb_add(&bar[XB_XGEN(b.x)], 1u);
            asm volatile("s_waitcnt vmcnt(0)" ::: "memory");
        } else {
            XB_SPIN(xb_ld(&bar[XB_XGEN(b.x)]) == gen, bar);
            __builtin_amdgcn_fence(__ATOMIC_ACQUIRE, "agent");
            asm volatile("s_waitcnt vmcnt(0)" ::: "memory");
        }
    }
    __syncthreads();
}

__device__ __forceinline__ void grid_bar(unsigned* ctr, unsigned target, int tid) {
    asm volatile("s_waitcnt vmcnt(0) lgkmcnt(0)" ::: "memory");
    __syncthreads();
    if (tid == 0) {
        __builtin_amdgcn_fence(__ATOMIC_RELEASE, "agent");
        asm volatile("s_waitcnt vmcnt(0)" ::: "memory");
        __hip_atomic_fetch_add(ctr, 1u, __ATOMIC_RELAXED, __HIP_MEMORY_SCOPE_AGENT);
        while (__hip_atomic_load(ctr, __ATOMIC_RELAXED, __HIP_MEMORY_SCOPE_AGENT) < target) __builtin_amdgcn_s_sleep(2);
        __builtin_amdgcn_fence(__ATOMIC_ACQUIRE, "agent");
        asm volatile("s_waitcnt vmcnt(0)" ::: "memory");
    }
    __syncthreads();
}
#define PH_BEGIN if (ph >= lo && ph < hi) { unsigned char* const wsb = lndp(p.ws); const int tidx_ = tid_of(wave_s_); const int bidx_ = lnds((int)blockIdx.x); (void)tidx_; (void)bidx_;
#define PH_END   if (ph + 1 < hi) { xcd_barrier(xb, tid_of(wave_s_)); } } ++ph;
#define PH_END0  if (ph + 1 < hi) grid.sync(); } ++ph;
template <int l> __device__ __forceinline__ void layer_phases(const int wave_s_, const P& p, LAS unsigned char* lds, const int lo, const int hi, int& ph, const XcdBarrier& xb) {

        PH_BEGIN
            { float* ss1 = (float*)(wsb + WS_SS1); float* ss2 = (float*)(wsb + WS_SS2); const int t0_ = tid_of(wave_s_);
              for (int i = bidx_ * 512 + t0_; i < R; i += gridDim.x * 512) { ss1[i] = 0.f; ss2[i] = 0.f; } }
            { pg8::Gemm g{(const pg8::bf16_t*)(wsb + WS_H), (const pg8::bf16_t*)(wsb + WS_WIN), R, NIN, DM, tidx_}; pg8::StaticOrder S; S.init(R, NIN, gridDim.x, bidx_);
              pg8::EpiBf16<0> E{(pg8::bf16_t*)(wsb + WS_U), NIN};
              pg8::gemm_phase<pg8::EpiBf16<0>, pg8::StaticOrder, true, true>(lds, g, S, E); }
            __syncthreads();
            { pg8::Gemm g{(const pg8::bf16_t*)(wsb + WS_H2L), (const pg8::bf16_t*)(wsb + WS_W3T), LSEQ, 1024, 128, tid_of(wave_s_)}; pg8::StaticOrder S; S.init(LSEQ, 1024, gridDim.x, bidx_);
              pg8::EpiFilt E{(float*)(wsb + WS_FILT), PIN(19) + l * 1024};
              pg8::gemm_phase<pg8::EpiFilt, pg8::StaticOrder, false, false>(lds, g, S, E); }
            __syncthreads();
            pa_ctxtaps(wave_s_, p, l);
        PH_END
        PH_BEGIN
            pb_attprep(wave_s_, p, l); pb_s5local(wave_s_, p); pb_pool(wave_s_, p, l, lds); pb_shortconv(wave_s_, p, l, lds); pb_ctxhyena(wave_s_, p, l, lds);
        PH_END
        PH_BEGIN
            pc_s5carry(wave_s_, p, lds); pc_attention(wave_s_, p, lds); pc_hyena(wave_s_, p, l, lds);
        PH_END
        PH_BEGIN
            pd_s5out(wave_s_, p); pd_hytrans(wave_s_, p, lds);
        PH_END
        PH_BEGIN
            pd2_glu(wave_s_, p, l);
        PH_END
        PH_BEGIN
            { pg8::Gemm g{(const pg8::bf16_t*)(wsb + WS_MERGED), (const pg8::bf16_t*)(wsb + WS_WOUT), R, DM, DM, tidx_}; pg8::StaticOrder S; S.init(R, DM, gridDim.x, bidx_);
              pg8::EpiSumsq E{(pg8::bf16_t*)(wsb + WS_OL), DM, (float*)(wsb + WS_SS1)};
              pg8::gemm_phase<pg8::EpiSumsq, pg8::StaticOrder, true, true>(lds, g, S, E); }
            __syncthreads();
        PH_END
        PH_BEGIN
            ew_phase(wave_s_, p, 1, l);
        PH_END
        PH_BEGIN
            { pg8::Gemm g{(const pg8::bf16_t*)(wsb + WS_H), (const pg8::bf16_t*)(wsb + WS_W1), R, FF, DM, tidx_}; pg8::StaticOrder S; S.init(R, FF, gridDim.x, bidx_);
              pg8::EpiBf16<1> E{(pg8::bf16_t*)(wsb + WS_HID), FF};
              pg8::gemm_phase<pg8::EpiBf16<1>, pg8::StaticOrder, true, true>(lds, g, S, E); }
            __syncthreads();
        PH_END
        PH_BEGIN
            { pg8::Gemm g{(const pg8::bf16_t*)(wsb + WS_HID), (const pg8::bf16_t*)(wsb + WS_W2), R, DM, FF, tidx_}; pg8::StaticOrder S; S.init(R, DM, gridDim.x, bidx_);
              pg8::EpiSumsq E{(pg8::bf16_t*)(wsb + WS_OL), DM, (float*)(wsb + WS_SS2)};
              pg8::gemm_phase<pg8::EpiSumsq, pg8::StaticOrder, true, true>(lds, g, S, E); }
            __syncthreads();
        PH_END
        PH_BEGIN
            ew_phase(wave_s_, p, 2, l);
            if (l + 1 < NLAYER) prep_layer(wave_s_, p, l + 1, lds);
        PH_END
    }
__global__ void __launch_bounds__(512) mega_fwd(P p) {
    extern __shared__ __attribute__((aligned(16))) unsigned char lds_raw[];
    LAS unsigned char* lds = (LAS unsigned char*)lds_raw;
    cg::grid_group grid = cg::this_grid();
    const int wave_s_ = __builtin_amdgcn_readfirstlane((int)threadIdx.x >> 6);
    const int lo = p.lo, hi = p.hi;
    int ph = 0;
    { volatile LAS unsigned* st0 = (volatile LAS unsigned*)(lds + XB_LDS_OFF); if (threadIdx.x < 2) st0[threadIdx.x] = 0u; }
    __syncthreads();
    const XcdBarrier xb = xcd_barrier_post((unsigned*)(p.ws + WS_BAR), (volatile LAS unsigned*)(lds + XB_LDS_OFF), (int)threadIdx.x);
    PH_BEGIN
        pro_mod(wave_s_, p, lds); pro_tables(wave_s_, p); prep_layer(wave_s_, p, 0, lds);
    PH_END0
    PH_BEGIN
        ew_phase(wave_s_, p, 0, 0);
    PH_END
    layer_phases<0>(wave_s_, p, lds, lo, hi, ph, xb);
    layer_phases<1>(wave_s_, p, lds, lo, hi, ph, xb);
    layer_phases<2>(wave_s_, p, lds, lo, hi, ph, xb);
    layer_phases<3>(wave_s_, p, lds, lo, hi, ph, xb);
#undef PH_BEGIN
#undef PH_END
#undef PH_END0
}
constexpr int N_PHASES = 2 + NLAYER * 10;

#ifndef MK_MULTI
#define MK_MULTI 0
#endif
extern "C" void kernel_launch(void* const* d_in, const int* in_sizes, int n_in, void* d_out, int out_size, void* d_ws, size_t ws_size, hipStream_t stream) {
    static int grid = 0;
    if (grid == 0) {
        if (n_in != 37 || out_size != LSEQ * DM || ws_size < WS_END) { fprintf(stderr, "kernel_launch: unexpected shapes (n_in %d out %d ws %zu)\n", n_in, out_size, ws_size); grid = -1; return; }
        int dev = 0, cus = 0, per_cu = 0;
        (void)hipGetDevice(&dev); (void)hipDeviceGetAttribute(&cus, hipDeviceAttributeMultiprocessorCount, dev);
        if (hipFuncSetAttribute((const void*)mega_fwd, hipFuncAttributeMaxDynamicSharedMemorySize, LDS_BYTES) != hipSuccess) { fprintf(stderr, "kernel_launch: hipFuncSetAttribute failed\n"); grid = -1; return; }
        if (hipOccupancyMaxActiveBlocksPerMultiprocessor(&per_cu, (const void*)mega_fwd, 512, LDS_BYTES) != hipSuccess || per_cu < 1) { fprintf(stderr, "kernel_launch: occupancy query gave %d\n", per_cu); per_cu = 1; }
        (void)hipGetLastError();
        grid = cus * 1;
        if (grid <= 0) grid = 256;
    }
    if (grid < 0) return;
    (void)hipMemsetAsync((unsigned char*)d_ws + WS_BAR, 0, 16384, stream);
    P a{};
    for (int i = 0; i < 37; ++i) a.in[i] = (const float*)d_in[i];
    a.out = (float*)d_out; a.ws = (unsigned char*)d_ws;
#if MK_MULTI
    for (int ph = 0; ph < N_PHASES; ++ph) { a.lo = ph; a.hi = ph + 1; hipLaunchKernelGGL(mega_fwd, dim3(grid), dim3(512), LDS_BYTES, stream, a); }
#else
    a.lo = 0; a.hi = N_PHASES;
    void* args[] = {&a};
    hipError_t e = hipLaunchCooperativeKernel((const void*)mega_fwd, dim3(grid), dim3(512), args, LDS_BYTES, stream);
    if (e != hipSuccess) fprintf(stderr, "cooperative launch failed: %s (grid %d)\n", hipGetErrorString(e), grid);
#endif
}
```

```cpp
#include <hip/hip_runtime.h>
#include <hip/hip_cooperative_groups.h>
#include <cstdio>
#include <cstdint>
namespace cg = cooperative_groups;

__device__ __forceinline__ int lndv(int i) { asm volatile("" : "+v"(i)); return i; }
__device__ __forceinline__ int lnds(int i) { asm volatile("" : "+v"(i)); return __builtin_amdgcn_readfirstlane(i); }
__device__ __forceinline__ int tid_of(int wave_s) { int z = 0; asm volatile("" : "+v"(z)); return (wave_s << 6) + (int)__builtin_amdgcn_mbcnt_hi(~0u, __builtin_amdgcn_mbcnt_lo(~0u, (unsigned)z)); }
namespace pg8 {
#define PG8_LAS __attribute__((address_space(3)))
typedef unsigned short bf16_t;
typedef short bf16x8 __attribute__((ext_vector_type(8)));
typedef float f32x4 __attribute__((ext_vector_type(4)));
typedef unsigned u32x4 __attribute__((ext_vector_type(4)));
constexpr int BM = 256, BK = 64, HALF = 128, HTB = HALF * BK * 2  , STAGE_BYTES = 8 * HTB, NXCD = 8, WGM = 8;

__host__ __device__ __forceinline__ int lds_byte(int r, int c) { const int st = (r >> 4) * 2 + (c >> 5), rr = r & 15, cc = c & 31, ob = rr * 64 + cc * 2; return st * 1024 + (ob ^ (((ob >> 9) & 1) << 5)); }
__host__ __device__ __forceinline__ void stage_rc(int b, int& R, int& C) { const int st = b / 1024, sb = b % 1024, swz = sb ^ (((sb >> 9) & 1) << 5); R = (st >> 1) * 16 + swz / 64; C = (st & 1) * 32 + (swz % 64) / 2; }
__host__ __device__ __forceinline__ int perm32(int rho) { const int n = rho >> 4, i = rho & 15; return 8 * (i >> 2) + 4 * n + (i & 3); }

struct Unit { int pm, pn; };
struct Gemm { const bf16_t* A; const bf16_t* Bt; int M, N, K, tid; };

struct StaticOrder {
    int nM, nN, nwg, G, c;
    __host__ __device__ void init(int M, int N, int G_, int c_) { nM = M / BM; nN = N / BM; nwg = nM * nN; G = G_; c = c_; }
    __host__ __device__ bool next(int i, Unit& u) const {
        const long L = (long)i * G + c; if (L >= nwg) return false;
        int wgid = (int)L; { const int q = nwg / NXCD, r = nwg % NXCD, xcd = wgid % NXCD, off = wgid / NXCD; wgid = (xcd < r ? xcd * (q + 1) : r * (q + 1) + (xcd - r) * q) + off; }
        const int nig = WGM * nN, gid = wgid / nig, fm = gid * WGM, gsz = (nM - fm) < WGM ? (nM - fm) : WGM;
        u.pm = fm + ((wgid % nig) % gsz); u.pn = (wgid % nig) / gsz; return true;
    }
    __device__ __forceinline__ void a_ready(const Unit&) const {}
    __device__ __forceinline__ void done(const Unit&) const {}
};

__device__ __forceinline__ unsigned cvt_pk_bf16(float lo, float hi) { unsigned r; asm volatile("v_cvt_pk_bf16_f32 %0, %1, %2" : "=v"(r) : "v"(lo), "v"(hi)); return r; }

template <int ACT> struct EpiBf16 {
    static constexpr bool PERM = true, AFTER_DRAIN = false;
    bf16_t* O; int ldc;
    __device__ __forceinline__ void operator()(const f32x4 (&acc)[2][2][4][2], const Unit& u, int wr, int wc, int fr, int fq) const {
        const int row0 = u.pm * BM + wr * 64 + fr, col0 = u.pn * BM + wc * 32 + 8 * fq;
#pragma unroll
        for (int ai = 0; ai < 2; ++ai)
#pragma unroll
            for (int m = 0; m < 4; ++m) { bf16_t* rowp = O + (size_t)(row0 + ai * HALF + m * 16) * ldc + col0;
#pragma unroll
                for (int bj = 0; bj < 2; ++bj) { f32x4 v0 = acc[ai][bj][m][0], v1 = acc[ai][bj][m][1];
                    if (ACT == 1) {
#pragma unroll
                        for (int e = 0; e < 4; ++e) { float a = v0[e] > 0.f ? v0[e] : 0.f; v0[e] = a * a; float b = v1[e] > 0.f ? v1[e] : 0.f; v1[e] = b * b; } }
                    u32x4 w; w.x = cvt_pk_bf16(v0[0], v0[1]); w.y = cvt_pk_bf16(v0[2], v0[3]); w.z = cvt_pk_bf16(v1[0], v1[1]); w.w = cvt_pk_bf16(v1[2], v1[3]);
                    *(u32x4*)(rowp + bj * HALF) = w; } }
    }
};
struct EpiSumsq {
    static constexpr bool PERM = true, AFTER_DRAIN = false;
    bf16_t* O; int ldc; float* ss;
    __device__ __forceinline__ void operator()(const f32x4 (&acc)[2][2][4][2], const Unit& u, int wr, int wc, int fr, int fq) const {
        const int row0 = u.pm * BM + wr * 64 + fr, col0 = u.pn * BM + wc * 32 + 8 * fq;
#pragma unroll
        for (int ai = 0; ai < 2; ++ai)
#pragma unroll
            for (int m = 0; m < 4; ++m) { const int row = row0 + ai * HALF + m * 16; bf16_t* rowp = O + (size_t)row * ldc + col0; float s = 0.f;
#pragma unroll
                for (int bj = 0; bj < 2; ++bj) { const f32x4 v0 = acc[ai][bj][m][0], v1 = acc[ai][bj][m][1];
                    s += (v0[0] * v0[0] + v0[1] * v0[1]) + (v0[2] * v0[2] + v0[3] * v0[3]) + (v1[0] * v1[0] + v1[1] * v1[1]) + (v1[2] * v1[2] + v1[3] * v1[3]);
                    u32x4 w; w.x = cvt_pk_bf16(v0[0], v0[1]); w.y = cvt_pk_bf16(v0[2], v0[3]); w.z = cvt_pk_bf16(v1[0], v1[1]); w.w = cvt_pk_bf16(v1[2], v1[3]);
                    *(u32x4*)(rowp + bj * HALF) = w; }
                s += __shfl_xor(s, 16); s += __shfl_xor(s, 32);
                if (fq == 0) atomicAdd(ss + row, s); }
    }
};
struct EpiFilt {
    static constexpr bool PERM = false, AFTER_DRAIN = false;
    float* F; const float* decay;
    __device__ __forceinline__ void operator()(const f32x4 (&acc)[2][2][4][2], const Unit& u, int wr, int wc, int fr, int fq) const {
        const int row0 = u.pm * BM + wr * 64 + fr, col0 = u.pn * BM + wc * 32 + 4 * fq;
#pragma unroll
        for (int bj = 0; bj < 2; ++bj)
#pragma unroll
            for (int n = 0; n < 2; ++n) {
                const int cb = col0 + bj * HALF + n * 16;
                const f32x4 dc = *(const f32x4*)(decay + cb);
#pragma unroll
                for (int e = 0; e < 4; ++e) { const int col = cb + e; const float ad = __builtin_fabsf(dc[e]);
                    float* fp = F + (size_t)((((col & 255) * 2 + (col >> 9)) * 2) + ((col >> 8) & 1)) * 16384;
#pragma unroll
                    for (int ai = 0; ai < 2; ++ai)
#pragma unroll
                        for (int m = 0; m < 4; ++m) { const int r = row0 + ai * HALF + m * 16; const float t = (float)r * (1.0f / 16384.0f);
                            fp[r] = acc[ai][bj][m][n][e] * expf(-t * ad); } } }
    }
};

template <class Epi, class Sched, bool ALIGN_EPI = false, bool SP2 = false>
__device__ __forceinline__ void gemm_phase(PG8_LAS unsigned char* lds, const Gemm g, const Sched& S, const Epi& E) {
    const int tid = g.tid, wid = __builtin_amdgcn_readfirstlane(tid >> 6), lane = tid & 63, wr = wid >> 2, wc = wid & 3, fr = lane & 15, fq = lane >> 4;
    const int K = g.K, nt = K / BK;
    unsigned voffA[2], voffB[2];
#pragma unroll
    for (int i = 0; i < 2; ++i) { int R, C; stage_rc(tid * 16 + i * 8192, R, C); const int Rb = Epi::PERM ? ((R & ~31) + perm32(R & 31)) : R;
        voffA[i] = (unsigned)(R * K + C) * 2u; voffB[i] = (unsigned)(Rb * K + C) * 2u; }
    const size_t kstep = (size_t)(BK * 2);
    const size_t hstep = (size_t)HALF * K * 2;
    const size_t tstep = 2 * hstep;
    const unsigned ldsw = (unsigned)wid * 1024u;
    const int aoff = lds_byte(wr * 64 + fr, fq * 8), boff = lds_byte(wc * 32 + fr, fq * 8);
#define PG8_SA(b, h) (((b) * 2 + (h)) * HTB)
#define PG8_SB(b, h) ((4 + (b) * 2 + (h)) * HTB)
#define PG8_STAGE(bufoff, gbase, voff) do { _Pragma("unroll") for (int _i = 0; _i < 2; ++_i) \
        __builtin_amdgcn_global_load_lds((const unsigned*)((const char*)(gbase) + (voff)[_i]), (PG8_LAS unsigned*)(lds + (bufoff) + ldsw + _i * 8192), 16, 0, 0); } while (0)
#define PG8_LDA(dst, b, h) do { _Pragma("unroll") for (int m = 0; m < 4; ++m) _Pragma("unroll") for (int k = 0; k < 2; ++k) dst[m][k] = *(const PG8_LAS bf16x8*)(lds + PG8_SA(b, h) + aoff + m * 2048 + k * 1024); } while (0)
#define PG8_LDB(dst, b, h) do { _Pragma("unroll") for (int n = 0; n < 2; ++n) _Pragma("unroll") for (int k = 0; k < 2; ++k) dst[n][k] = *(const PG8_LAS bf16x8*)(lds + PG8_SB(b, h) + boff + n * 2048 + k * 1024); } while (0)
#define PG8_MMA(ai, bj, At, Bt) do { __builtin_amdgcn_s_setprio(1); _Pragma("unroll") for (int m = 0; m < 4; ++m) _Pragma("unroll") for (int n = 0; n < 2; ++n) _Pragma("unroll") for (int k = 0; k < 2; ++k) \
        acc[ai][bj][m][n] = __builtin_amdgcn_mfma_f32_16x16x32_bf16(Bt[n][k], At[m][k], acc[ai][bj][m][n], 0, 0, 0); __builtin_amdgcn_s_setprio(0); } while (0)
#define PG8_WAIT_V(n) asm volatile("s_waitcnt vmcnt(" #n ")" ::: "memory")
#define PG8_WAIT_L(n) asm volatile("s_waitcnt lgkmcnt(" #n ")" ::: "memory")
#define PG8_BAR __builtin_amdgcn_s_barrier()
#define PG8_SCHED __builtin_amdgcn_sched_barrier(0)
    Unit cur, nxt; int ui = 0;
    if (!S.next(0, cur)) return;
    f32x4 acc[2][2][4][2];
#pragma unroll
    for (int a = 0; a < 2; ++a)
#pragma unroll
        for (int b = 0; b < 2; ++b)
#pragma unroll
            for (int m = 0; m < 4; ++m)
#pragma unroll
                for (int n = 0; n < 2; ++n) acc[a][b][m][n] = (f32x4){0.f, 0.f, 0.f, 0.f};
    bf16x8 At[4][2], B0[2][2], B1[2][2];
    const char* cA = (const char*)g.A + (size_t)cur.pm * tstep; const char* cB = (const char*)g.Bt + (size_t)cur.pn * tstep;
    S.a_ready(cur);
    if constexpr (SP2) {
        PG8_STAGE(PG8_SB(0, 0), cB, voffB); PG8_STAGE(PG8_SB(0, 1), cB + hstep, voffB); PG8_STAGE(PG8_SA(0, 0), cA, voffA); PG8_STAGE(PG8_SA(0, 1), cA + hstep, voffA);
        if (wr == 1) PG8_BAR;
        PG8_WAIT_V(2); PG8_BAR;
        PG8_STAGE(PG8_SB(1, 0), cB + kstep, voffB); PG8_STAGE(PG8_SA(1, 0), cA + kstep, voffA); PG8_STAGE(PG8_SB(1, 1), cB + hstep + kstep, voffB);
        PG8_WAIT_V(6); PG8_BAR;
    } else {
        PG8_STAGE(PG8_SB(0, 0), cB, voffB); PG8_STAGE(PG8_SA(0, 0), cA, voffA); PG8_STAGE(PG8_SB(0, 1), cB + hstep, voffB); PG8_STAGE(PG8_SA(0, 1), cA + hstep, voffA);
        if (wr == 1) PG8_BAR;
        PG8_WAIT_V(4); PG8_BAR;
        PG8_STAGE(PG8_SB(1, 0), cB + kstep, voffB); PG8_STAGE(PG8_SA(1, 0), cA + kstep, voffA); PG8_STAGE(PG8_SB(1, 1), cB + hstep + kstep, voffB);
        PG8_WAIT_V(6); PG8_BAR;
    }
    for (;;) {
        const bool has_next = S.next(ui + 1, nxt);
        const char* nA = has_next ? (const char*)g.A + (size_t)nxt.pm * tstep : cA; const char* nB = has_next ? (const char*)g.Bt + (size_t)nxt.pn * tstep : cB;
        for (int t = 0; t < nt; t += 2) {
            const bool last = (t == nt - 2);
            const char* a1 = cA + (size_t)(t + 1) * kstep;
            const char* a2 = last ? nA : cA + (size_t)(t + 2) * kstep; const char* b2 = last ? nB : cB + (size_t)(t + 2) * kstep;
            const char* a3 = a2 + kstep; const char* b3 = b2 + kstep;
            if (last && has_next) S.a_ready(nxt);
            if constexpr (SP2) {
            PG8_LDB(B0, 0, 0); PG8_LDB(B1, 0, 1); PG8_SCHED; PG8_LDA(At, 0, 0); PG8_STAGE(PG8_SA(1, 1), a1 + hstep, voffA);
            PG8_WAIT_V(8); PG8_WAIT_L(0); PG8_BAR; PG8_MMA(0, 0, At, B0); PG8_MMA(0, 1, At, B1); PG8_BAR; PG8_SCHED;
            PG8_LDA(At, 0, 1); PG8_STAGE(PG8_SB(0, 0), b2, voffB); PG8_STAGE(PG8_SB(0, 1), b2 + hstep, voffB); PG8_STAGE(PG8_SA(0, 0), a2, voffA);
            PG8_WAIT_V(8); PG8_WAIT_L(0); PG8_BAR; PG8_MMA(1, 0, At, B0); PG8_MMA(1, 1, At, B1); PG8_BAR; PG8_SCHED;
            PG8_LDB(B0, 1, 0); PG8_LDB(B1, 1, 1); PG8_SCHED; PG8_LDA(At, 1, 0); PG8_STAGE(PG8_SA(0, 1), a2 + hstep, voffA);
            PG8_WAIT_V(8); PG8_WAIT_L(0); PG8_BAR; PG8_MMA(0, 0, At, B0); PG8_MMA(0, 1, At, B1); PG8_BAR; PG8_SCHED;
            PG8_LDA(At, 1, 1); PG8_STAGE(PG8_SB(1, 0), b3, voffB); PG8_STAGE(PG8_SB(1, 1), b3 + hstep, voffB); PG8_STAGE(PG8_SA(1, 0), a3, voffA);
            PG8_WAIT_V(8); PG8_WAIT_L(0); PG8_BAR; PG8_MMA(1, 0, At, B0); PG8_MMA(1, 1, At, B1); PG8_BAR; PG8_SCHED;
            } else {
            PG8_LDB(B0, 0, 0); PG8_SCHED; PG8_LDA(At, 0, 0); PG8_STAGE(PG8_SA(1, 1), a1 + hstep, voffA);
            PG8_WAIT_L(8); PG8_BAR; PG8_WAIT_L(0); PG8_MMA(0, 0, At, B0); PG8_BAR; PG8_SCHED;
            PG8_LDB(B1, 0, 1); PG8_STAGE(PG8_SB(0, 0), b2, voffB);
            PG8_BAR; PG8_WAIT_L(0); PG8_MMA(0, 1, At, B1); PG8_BAR;
            PG8_LDA(At, 0, 1); PG8_STAGE(PG8_SA(0, 0), a2, voffA);
            PG8_BAR; PG8_WAIT_L(0); PG8_MMA(1, 0, At, B0); PG8_BAR; PG8_SCHED;
            PG8_STAGE(PG8_SB(0, 1), b2 + hstep, voffB);
            PG8_WAIT_V(6); PG8_BAR; PG8_MMA(1, 1, At, B1); PG8_BAR;
            PG8_LDB(B0, 1, 0); PG8_SCHED; PG8_LDA(At, 1, 0); PG8_STAGE(PG8_SA(0, 1), a2 + hstep, voffA);
            PG8_WAIT_L(8); PG8_BAR; PG8_WAIT_L(0); PG8_MMA(0, 0, At, B0); PG8_BAR; PG8_SCHED;
            PG8_LDB(B1, 1, 1); PG8_STAGE(PG8_SB(1, 0), b3, voffB);
            PG8_BAR; PG8_WAIT_L(0); PG8_MMA(0, 1, At, B1); PG8_BAR;
            PG8_LDA(At, 1, 1); PG8_STAGE(PG8_SA(1, 0), a3, voffA);
            PG8_BAR; PG8_WAIT_L(0); PG8_MMA(1, 0, At, B0); PG8_BAR; PG8_SCHED;
            PG8_STAGE(PG8_SB(1, 1), b3 + hstep, voffB);
            PG8_WAIT_V(6); PG8_BAR; PG8_MMA(1, 1, At, B1); PG8_BAR;
            }
        }
        if constexpr (ALIGN_EPI) { if (wr == 0) PG8_BAR; }
        if constexpr (!Epi::AFTER_DRAIN) { E(acc, cur, wr, wc, fr, fq); S.done(cur); }
        if (!has_next) break;
#pragma unroll
        for (int a = 0; a < 2; ++a)
#pragma unroll
            for (int b = 0; b < 2; ++b)
#pragma unroll
                for (int m = 0; m < 4; ++m)
#pragma unroll
                    for (int n = 0; n < 2; ++n) acc[a][b][m][n] = (f32x4){0.f, 0.f, 0.f, 0.f};
        cur = nxt; cA = nA; cB = nB; ++ui;
        if constexpr (ALIGN_EPI) { if (wr == 1) PG8_BAR; }
    }
    PG8_WAIT_V(0);
    if constexpr (!ALIGN_EPI) { if (wr == 0) PG8_BAR; }
    PG8_BAR;
    if constexpr (Epi::AFTER_DRAIN) { E.fused(acc, cur, wr, wc, fr, fq, lds, wid, lane); S.done(cur); }
#undef PG8_SA
#undef PG8_SB
#undef PG8_STAGE
#undef PG8_LDA
#undef PG8_LDB
#undef PG8_MMA
#undef PG8_WAIT_V
#undef PG8_WAIT_L
#undef PG8_BAR
#undef PG8_SCHED
}
}
#define LAS __attribute__((address_space(3)))
typedef unsigned short bf16_t;
typedef short bf16x8 __attribute__((ext_vector_type(8)));
typedef float f32x4 __attribute__((ext_vector_type(4)));
typedef float f32x2 __attribute__((ext_vector_type(2)));
typedef float f32x16 __attribute__((ext_vector_type(16)));
typedef unsigned u32x4 __attribute__((ext_vector_type(4)));
typedef unsigned u32x2 __attribute__((ext_vector_type(2)));

constexpr int LCTX = 256, LSEQ = 16384, R = LCTX + LSEQ;
constexpr int DM = 1024, NIN = 1792, FF = 4096, NLAYER = 4;
constexpr int NFFT = 16384;
constexpr int NCH = R / 16;
constexpr float EPS = 1e-6f;
constexpr float QSCALE = 0.125f * 1.4426950408889634f;
constexpr size_t KiB = 1024, MiB = 1024 * 1024;
constexpr size_t WS_SS1 = 0, WS_SS2 = 128 * KiB, WS_MODV = 256 * KiB, WS_TW = 512 * KiB, WS_LAMT = 640 * KiB, WS_H2C = 704 * KiB;
constexpr size_t WS_BAR = 768 * KiB;
constexpr size_t WS_XC = 1 * MiB;
constexpr size_t WS_WIN = 2 * MiB, WS_WOUT = 6 * MiB, WS_W1 = 8 * MiB, WS_W2 = 16 * MiB, WS_W3T = 24 * MiB, WS_GLUT = 24 * MiB + 512 * KiB;
constexpr size_t WS_S5M = 25 * MiB;
constexpr size_t WS_KCT = 33 * MiB;
constexpr size_t WS_H2L = 34 * MiB;
constexpr size_t WS_H = 38 * MiB;
constexpr size_t WS_VXT = 38 * MiB, WS_Z2T = 62 * MiB;
constexpr size_t WS_OL = 71 * MiB;
constexpr size_t WS_SC = 71 * MiB, WS_HIN = WS_SC + (size_t)32 * NCH * 128 * 4;
constexpr size_t WS_U = 104 * MiB, WS_MERGED = 161 * MiB, WS_QN = 194 * MiB, WS_GBUF = WS_QN, WS_KN = 203 * MiB, WS_FILT = 208 * MiB, WS_Z1 = 272 * MiB;
constexpr size_t WS_HID = 104 * MiB;
constexpr size_t WS_ROPE = 288 * MiB;
constexpr size_t WS_END = 292 * MiB;
constexpr int LDS_BYTES = 138 * 1024, XB_LDS_OFF = 137 * 1024;

struct P { const float* in[37]; float* out; unsigned char* ws; int lo, hi; };
__device__ __forceinline__ int lnd(int i) { asm volatile("" : "+v"(i)); return __builtin_amdgcn_readfirstlane(i); }
#define PIN(i) (p.in[lnd(i)])
__device__ __forceinline__ unsigned char* lndp(unsigned char* q) { unsigned lo = (unsigned)(uintptr_t)q, hi = (unsigned)((uintptr_t)q >> 32); asm volatile("" : "+v"(lo), "+v"(hi)); lo = __builtin_amdgcn_readfirstlane(lo); hi = __builtin_amdgcn_readfirstlane(hi); return (unsigned char*)(((uintptr_t)hi << 32) | (uintptr_t)lo); }


__device__ __forceinline__ unsigned f2bf(float f) { unsigned u = __builtin_bit_cast(unsigned, f); return (u + 0x7fffu + ((u >> 16) & 1u)) >> 16; }
__device__ __forceinline__ unsigned pk2(float lo, float hi) { return f2bf(lo) | (f2bf(hi) << 16); }
__device__ __forceinline__ float bflo(unsigned w) { return __builtin_bit_cast(float, w << 16); }
__device__ __forceinline__ float bfhi(unsigned w) { return __builtin_bit_cast(float, w & 0xffff0000u); }
__device__ __forceinline__ float bf1(bf16_t b) { return __builtin_bit_cast(float, (unsigned)b << 16); }
__device__ __forceinline__ float wave_sum(float v) {
#pragma unroll
    for (int o = 1; o < 64; o <<= 1) v += __shfl_xor(v, o);
    return v;
}
__device__ __forceinline__ f32x2 cmul(f32x2 a, f32x2 b) { return (f32x2){a.x * b.x - a.y * b.y, a.x * b.y + a.y * b.x}; }
__device__ __forceinline__ f32x2 cmulc(f32x2 a, f32x2 b) { return (f32x2){a.x * b.x + a.y * b.y, a.y * b.x - a.x * b.y}; }
__device__ __forceinline__ f32x2 cconj(f32x2 a) { return (f32x2){a.x, -a.y}; }

__device__ __forceinline__ void pro_mod(const int wave_s_, const P& p, LAS unsigned char* lds) { unsigned char* const wsb = lndp(p.ws); const int tidx_ = tid_of(wave_s_); const int bidx_ = lnds((int)blockIdx.x);
    const float* c = PIN(1); const float* cc = PIN(3); const float* mw = PIN(4); const float* mb = PIN(5);
    float* modv = (float*)(wsb + WS_MODV);
    LAS float* red = (LAS float*)lds;
    const int tid = tidx_, cq = tid & 15, ks = tid >> 4;
    for (int item = bidx_; item < 4 * 96; item += gridDim.x) {
        const int layer = item / 96, n0 = (item % 96) * 64;
        f32x4 aL = {0.f, 0.f, 0.f, 0.f}, aC = {0.f, 0.f, 0.f, 0.f};
        const float* wp = mw + ((size_t)layer * 1024 + ks * 32) * 6144 + n0 + 4 * cq;
        for (int k = 0; k < 32; ++k) {
            const float cv = c[ks * 32 + k], xv = cc[ks * 32 + k];
            const float sl = cv / (1.f + expf(-cv)), sc = xv / (1.f + expf(-xv));
            const f32x4 w = *(const f32x4*)(wp + (size_t)k * 6144);
            aL += w * sl; aC += w * sc;
        }
        LAS float* r = red + (ks * 16 + cq) * 8;
        r[0] = aL[0]; r[1] = aL[1]; r[2] = aL[2]; r[3] = aL[3]; r[4] = aC[0]; r[5] = aC[1]; r[6] = aC[2]; r[7] = aC[3];
        __syncthreads();
        if (tid < 128) { const int cq2 = tid & 15, j = tid >> 4; float s = 0.f;
            for (int k2 = 0; k2 < 32; ++k2) s += red[(k2 * 16 + cq2) * 8 + j];
            const int n = n0 + 4 * cq2 + (j & 3), stream = j >> 2;
            modv[(layer * 2 + stream) * 6144 + n] = s + mb[layer * 6144 + n]; }
        __syncthreads();
    }
}
__device__ __forceinline__ void pro_tables(const int wave_s_, const P& p) { unsigned char* const wsb = lndp(p.ws); const int tidx_ = tid_of(wave_s_); const int bidx_ = lnds((int)blockIdx.x);
    const int gt = bidx_ * 512 + tidx_, GT = gridDim.x * 512;
    f32x2* tw = (f32x2*)(wsb + WS_TW);
    for (int t = gt; t <= 8192; t += GT) { float s, c; sincospif((float)t * (1.0f / 8192.0f), &s, &c); tw[t] = (f32x2){c, -s}; }
    f32x2* rope = (f32x2*)(wsb + WS_ROPE);
    for (int i = gt; i < LSEQ * 32; i += GT) { const int t = i >> 5, j = i & 31; const int pos = j < 16 ? (t >> 6) : (t & 63);
        const float inv = powf(10000.0f, -(float)(2 * (j & 15)) / 32.0f); const float ang = (float)pos * inv; float s, c; sincosf(ang, &s, &c); rope[i] = (f32x2){c, s}; }
}
__device__ __forceinline__ void ew_phase(const int wave_s_, const P& p, int mode, int layer) { unsigned char* const wsb = lndp(p.ws); const int tidx_ = tid_of(wave_s_); const int bidx_ = lnds((int)blockIdx.x);
    const int lane = tidx_ & 63, wave = tidx_ >> 6;
    const int gw = bidx_ * 8 + wave, NGW = gridDim.x * 8;
    const float* modv = (const float*)(wsb + WS_MODV);
    const float* ss = (const float*)(wsb + (mode == 1 ? WS_SS1 : WS_SS2));
    const bf16_t* OL = (const bf16_t*)(wsb + WS_OL);
    bf16_t* H = (bf16_t*)(wsb + WS_H);
    float* xc = (float*)(wsb + WS_XC);
    const float* gpost = (mode == 1 ? PIN(7) : PIN(9)) + layer * 1024;
    const int gi = mode == 1 ? 2 : 5;
    const bool donorm = !(mode == 2 && layer == NLAYER - 1);
    const int nl = mode == 2 ? layer + 1 : layer;
    const float* gpre = (mode == 1 ? PIN(8) : PIN(6)) + (donorm ? nl : 0) * 1024;
    const int shi = mode == 1 ? 3 : 0, sci = mode == 1 ? 4 : 1;
    for (int row = gw; row < R; row += NGW) {
        const int stream = row < LCTX ? 1 : 0;
        float* xp = row < LCTX ? xc + (size_t)row * 1024 : p.out + (size_t)(row - LCTX) * 1024;
        const float* src = mode == 0 ? (row < LCTX ? PIN(2) + (size_t)row * 1024 : PIN(0) + (size_t)(row - LCTX) * 1024) : xp;
        f32x4 v[4];
#pragma unroll
        for (int j = 0; j < 4; ++j) v[j] = *(const f32x4*)(src + j * 256 + lane * 4);
        if (mode != 0) {
            const float rs = rsqrtf(ss[row] * (1.0f / 1024.0f) + EPS);
            const float* mg = modv + (layer * 2 + stream) * 6144 + gi * 1024;
#pragma unroll
            for (int j = 0; j < 4; ++j) { const int col = j * 256 + lane * 4;
                const f32x4 g = *(const f32x4*)(mg + col) * *(const f32x4*)(gpost + col) * rs;
                const u32x2 o = *(const u32x2*)(OL + (size_t)row * 1024 + col);
                v[j] += g * (f32x4){bflo(o.x), bfhi(o.x), bflo(o.y), bfhi(o.y)}; }
        }
#pragma unroll
        for (int j = 0; j < 4; ++j) *(f32x4*)(xp + j * 256 + lane * 4) = v[j];
        if (donorm) {
            float s = 0.f;
#pragma unroll
            for (int j = 0; j < 4; ++j) s += (v[j][0] * v[j][0] + v[j][1] * v[j][1]) + (v[j][2] * v[j][2] + v[j][3] * v[j][3]);
            s = wave_sum(s);
            const float rstd = rsqrtf(s * (1.0f / 1024.0f) + EPS);
            const float* msh = modv + (nl * 2 + stream) * 6144 + shi * 1024; const float* msc = modv + (nl * 2 + stream) * 6144 + sci * 1024;
#pragma unroll
            for (int j = 0; j < 4; ++j) { const int col = j * 256 + lane * 4;
                const f32x4 y = v[j] * rstd * *(const f32x4*)(gpre + col) * (*(const f32x4*)(msc + col) + 1.0f) + *(const f32x4*)(msh + col);
                u32x2 w; w.x = pk2(y[0], y[1]); w.y = pk2(y[2], y[3]);
                *(u32x2*)(H + (size_t)row * 1024 + col) = w; }
        }
    }
}
__device__ __forceinline__ void transpose_item(const float* W, int K, int N, bf16_t* WT, int ldo, LAS float* scr, int item, int lane) {
    const int nblk = N / 32, kb = item / nblk, nb = item % nblk, k0 = 64 * kb, n0 = 32 * nb;
#pragma unroll 8
    for (int i = 0; i < 32; ++i) { const int kk = 2 * i + (lane >> 5); scr[kk * 33 + (lane & 31)] = W[(size_t)(k0 + kk) * N + n0 + (lane & 31)]; }
    asm volatile("s_waitcnt lgkmcnt(0)" ::: "memory");
    const int c = lane & 7;
#pragma unroll
    for (int j = 0; j < 4; ++j) { const int n = (lane >> 3) + 8 * j; const LAS float* s = scr + (8 * c) * 33 + n;
        u32x4 o; o.x = pk2(s[0 * 33], s[1 * 33]); o.y = pk2(s[2 * 33], s[3 * 33]); o.z = pk2(s[4 * 33], s[5 * 33]); o.w = pk2(s[6 * 33], s[7 * 33]);
        *(u32x4*)(WT + (size_t)(n0 + n) * ldo + k0 + 8 * c) = o; }
    asm volatile("s_waitcnt lgkmcnt(0)" ::: "memory");
}
__device__ __forceinline__ void prep_layer(const int wave_s_, const P& p, int l, LAS unsigned char* lds) { unsigned char* const wsb = lndp(p.ws); const int tidx_ = tid_of(wave_s_); const int bidx_ = lnds((int)blockIdx.x);
    const int tid = tidx_, lane = tid & 63, wave = tid >> 6;
    const int gt = bidx_ * 512 + tid, GT = gridDim.x * 512;
    bf16_t* WIN = (bf16_t*)(wsb + WS_WIN); bf16_t* WOUT = (bf16_t*)(wsb + WS_WOUT); bf16_t* W1 = (bf16_t*)(wsb + WS_W1); bf16_t* W2 = (bf16_t*)(wsb + WS_W2);
    bf16_t* W3T = (bf16_t*)(wsb + WS_W3T); bf16_t* GLUT = (bf16_t*)(wsb + WS_GLUT); bf16_t* H2L = (bf16_t*)(wsb + WS_H2L); float* H2C = (float*)(wsb + WS_H2C);
    {
        const u32x4 z4 = {0u, 0u, 0u, 0u};
        for (int i = gt; i < 1024 * 8; i += GT) *(u32x4*)(W3T + (size_t)(i >> 3) * 128 + 64 + (i & 7) * 8) = z4;
        for (int i = gt; i < 16384 * 8; i += GT) *(u32x4*)(H2L + (size_t)(i >> 3) * 128 + 64 + (i & 7) * 8) = z4;
    }
    constexpr int I_IN = 16 * 56, I_OUT = 16 * 32, I_1 = 16 * 128, I_2 = 64 * 32, I_3 = 1 * 32, I_G = 4 * 8;
    constexpr int NTILE = I_IN + I_OUT + I_1 + I_2 + I_3 + I_G;
    constexpr int N_S5 = 32, N_H2 = 130, N_TR = (NTILE + 7) / 8, N_ITEMS = N_S5 + N_H2 + N_TR;
    for (int item = bidx_; item < N_ITEMS; item += gridDim.x) {
        __syncthreads();
        if (item < N_S5) {
            LAS f32x2* pw = (LAS f32x2*)lds;
            LAS f32x2* bb = pw + 17 * 64;
            LAS f32x2* cc = bb + 64 * 16;
            LAS f32x2* crci = cc + 16 * 64;
            LAS float* kt = (LAS float*)(crci + 64);
            float* lamT = (float*)(wsb + WS_LAMT);
            const int dg = item, dir = dg >> 4, g = dg & 15; const int pb = ((l * 2 + dir) * 16 + g);
            if (tid < 64) {
                const float are = PIN(21)[pb * 64 + tid], aim = PIN(22)[pb * 64 + tid]; const float dt = expf(PIN(23)[pb]);
                const float mag = expf(are * dt), ang = aim * dt; const float lr = mag * cosf(ang), li = mag * sinf(ang);
                const float den = are * are + aim * aim, nr = lr - 1.0f, ni = li;
                crci[tid] = (f32x2){(nr * are + ni * aim) / den, (ni * are - nr * aim) / den};
                f32x2 w = {1.f, 0.f}; const f32x2 lam = {lr, li};
                for (int k = 0; k <= 16; ++k) { pw[k * 64 + tid] = w; w = cmul(w, lam); }
                const f32x2 l16 = pw[16 * 64 + tid]; lamT[dg * 128 + tid] = l16.x; lamT[dg * 128 + 64 + tid] = l16.y;
            }
            __syncthreads();
            for (int idx = tid; idx < 1024; idx += 512) {
                { const int pp = idx >> 4, h = idx & 15; const float bre = PIN(24)[(size_t)(pb * 64 + pp) * 16 + h], bim = PIN(25)[(size_t)(pb * 64 + pp) * 16 + h]; const f32x2 cr = crci[pp];
                  bb[idx] = (f32x2){cr.x * bre - cr.y * bim, cr.x * bim + cr.y * bre}; }
                { cc[idx] = (f32x2){PIN(26)[(size_t)pb * 1024 + idx], PIN(27)[(size_t)pb * 1024 + idx]}; }
            }
            __syncthreads();
            for (int idx = tid; idx < 4096; idx += 512) { const int k = idx >> 8, hp = (idx >> 4) & 15, h = idx & 15; float s = 0.f;
                for (int pp = 0; pp < 64; ++pp) { const f32x2 t = cmul(cc[hp * 64 + pp], pw[k * 64 + pp]); const f32x2 b = bb[pp * 16 + h]; s += t.x * b.x - t.y * b.y; }
                kt[idx] = s; }
            __syncthreads();
            unsigned* KI = (unsigned*)(wsb + WS_S5M + (size_t)dg * 256 * KiB); unsigned* BB = KI + 32768; unsigned* CC = BB + 16384;
            const float* dsk = PIN(28) + l * 256 + g * 16;
            for (int i2 = tid; i2 < 32768; i2 += 512) { const int n = i2 >> 7, kp = i2 & 127, kk = 2 * kp, s = kk >> 4, h = kk & 15, t = n >> 4, hp = n & 15;
                const int lag = dir == 0 ? t - s : s - t; float v0 = 0.f, v1 = 0.f;
                if (lag >= 0) { v0 = kt[(lag * 16 + hp) * 16 + h]; v1 = kt[(lag * 16 + hp) * 16 + h + 1]; }
                if (dir == 0 && lag == 0) { if (h == hp) v0 += dsk[hp]; if (h + 1 == hp) v1 += dsk[hp]; }
                KI[i2] = pk2(v0, v1); }
            for (int i2 = tid; i2 < 16384; i2 += 512) { const int col = i2 >> 7, kp = i2 & 127, kk = 2 * kp, s = kk >> 4, h = kk & 15, ri = col >> 6, pp = col & 63;
                const int e = dir == 0 ? 15 - s : s; const f32x2 w = pw[e * 64 + pp]; const f32x2 a = cmul(w, bb[pp * 16 + h]), b = cmul(w, bb[pp * 16 + h + 1]);
                BB[i2] = ri == 0 ? pk2(a.x, b.x) : pk2(a.y, b.y); }
            for (int i2 = tid; i2 < 16384; i2 += 512) { const int n = i2 >> 6, cp = i2 & 63, col = 2 * cp, ri = col >> 6, pp = col & 63, t = n >> 4, hp = n & 15;
                const int e = dir == 0 ? t + 1 : 16 - t; const f32x2 a = cmul(cc[hp * 64 + pp], pw[e * 64 + pp]), b = cmul(cc[hp * 64 + pp + 1], pw[e * 64 + pp + 1]);
                CC[i2] = ri == 0 ? pk2(a.x, b.x) : pk2(-a.y, -b.y); }
        } else if (item < N_S5 + N_H2) {
            LAS float* w1s = (LAS float*)lds; LAS float* b1s = w1s + 33 * 64; LAS float* w2s = b1s + 64; LAS float* b2s = w2s + 4096;
            for (int i = tid; i < 33 * 64; i += 512) w1s[i] = PIN(14)[l * 33 * 64 + i];
            for (int i = tid; i < 4096; i += 512) w2s[i] = PIN(16)[l * 4096 + i];
            if (tid < 64) { b1s[tid] = PIN(15)[l * 64 + tid]; b2s[tid] = PIN(17)[l * 64 + tid]; }
            __syncthreads();
            const int rr = (item - N_S5) * 128 + (tid >> 2), part = tid & 3; const bool isctx = rr >= LSEQ; const int n = isctx ? rr - LSEQ : rr;
            const float t = (float)n / (isctx ? 256.0f : 16384.0f);
            float h1[64];
#pragma unroll
            for (int j = 0; j < 64; ++j) h1[j] = b1s[j] + t * w1s[j];
            _Pragma("nounroll") for (int f = 1; f <= 16; ++f) { float cs, sn; sincospif(2.0f * t * (float)f, &sn, &cs);
#pragma unroll
                for (int j = 0; j < 64; ++j) h1[j] += cs * w1s[f * 64 + j] + sn * w1s[(16 + f) * 64 + j]; }
#pragma unroll
            for (int j = 0; j < 64; ++j) h1[j] = sinpif(h1[j] * 0.3183098861837907f);
            _Pragma("nounroll") for (int jj = 0; jj < 16; jj += 2) { const int j = part * 16 + jj; float a0 = b2s[j], a1 = b2s[j + 1];
#pragma unroll
                for (int i = 0; i < 64; ++i) { a0 += h1[i] * w2s[i * 64 + j]; a1 += h1[i] * w2s[i * 64 + j + 1]; }
                a0 = sinpif(a0 * 0.3183098861837907f); a1 = sinpif(a1 * 0.3183098861837907f);
                if (isctx) { H2C[n * 64 + j] = a0; H2C[n * 64 + j + 1] = a1; } else *(unsigned*)(H2L + (size_t)n * 128 + j) = pk2(a0, a1); }
        } else {
            LAS float* scr = (LAS float*)(lds + wave * 16384);
            int r = (item - N_S5 - N_H2) * 8 + wave;
            if (r < NTILE) {
                if (r < I_IN) transpose_item(PIN(10) + (size_t)l * DM * NIN, DM, NIN, WIN, DM, scr, r, lane);
                else if ((r -= I_IN) < I_OUT) transpose_item(PIN(11) + (size_t)l * DM * DM, DM, DM, WOUT, DM, scr, r, lane);
                else if ((r -= I_OUT) < I_1) transpose_item(PIN(35) + (size_t)l * DM * FF, DM, FF, W1, DM, scr, r, lane);
                else if ((r -= I_1) < I_2) transpose_item(PIN(36) + (size_t)l * FF * DM, FF, DM, W2, FF, scr, r, lane);
                else if ((r -= I_2) < I_3) transpose_item(PIN(18) + (size_t)l * 64 * 1024, 64, 1024, W3T, 128, scr, r, lane);
                else { r -= I_3; transpose_item(PIN(29) + (size_t)l * 256 * 256, 256, 256, GLUT, 256, scr, r, lane); }
            }
        }
    }
    __syncthreads();
}

template <int EPI> __device__ __forceinline__ void ctx_gemm16(const bf16_t* A, int lda, const bf16_t* Bt, int N, int K, bf16_t* O, int ldo, float* ss, const bf16_t* aux, const float* bias, int gw, int NGW, int lane) {
    const int m = lane & 15, kq = lane >> 4; const int ntile = 16 * (N >> 4);
    for (int it = gw; it < ntile; it += NGW) {
        const int rt = it & 15, ctile = it >> 4;
        f32x4 acc = {0.f, 0.f, 0.f, 0.f};
        const bf16_t* ap = A + (size_t)(rt * 16 + m) * lda + 8 * kq; const bf16_t* bp = Bt + (size_t)(ctile * 16 + m) * K + 8 * kq;
#pragma unroll 8
        for (int ks = 0; ks < (K >> 5); ++ks) { const bf16x8 a = *(const bf16x8*)(ap + ks * 32); const bf16x8 b = *(const bf16x8*)(bp + ks * 32); acc = __builtin_amdgcn_mfma_f32_16x16x32_bf16(a, b, acc, 0, 0, 0); }
        const int col = ctile * 16 + m;
#pragma unroll
        for (int i = 0; i < 4; ++i) { const int row = rt * 16 + 4 * kq + i; float v = acc[i];
            if (EPI == 0) { float s = v * v; s += __shfl_xor(s, 1); s += __shfl_xor(s, 2); s += __shfl_xor(s, 4); s += __shfl_xor(s, 8); if (m == 0) atomicAdd(ss + row, s); }
            if (EPI == 1) { v = v > 0.f ? v * v : 0.f; }
            if (EPI == 2) { const float gv = bf1(aux[(size_t)row * 256 + col]); v = gv / (1.0f + expf(-(v + bias[col]))); }
            O[(size_t)row * ldo + col] = (bf16_t)f2bf(v); }
    }
}
__device__ __forceinline__ void pb_attprep(const int wave_s_, const P& p, int l) { unsigned char* const wsb = lndp(p.ws); const int tidx_ = tid_of(wave_s_); const int bidx_ = lnds((int)blockIdx.x);
    const int gt = bidx_ * 512 + tidx_, GT = gridDim.x * 512;
    const bf16_t* U = (const bf16_t*)(wsb + WS_U); bf16_t* QN = (bf16_t*)(wsb + WS_QN); bf16_t* KN = (bf16_t*)(wsb + WS_KN);
    const f32x2* rope = (const f32x2*)(wsb + WS_ROPE);
    for (int idx = gt; idx < R * 6; idx += GT) {
        const int row = idx / 6, slot = idx - row * 6;
        const bf16_t* src = U + (size_t)row * NIN + (slot < 4 ? 1280 + slot * 64 : 1536 + (slot - 4) * 64);
        const float* gain = (slot < 4 ? PIN(33) : PIN(34)) + l * 64;
        float x[64]; float ms = 0.f;
#pragma unroll
        for (int c = 0; c < 8; ++c) { const u32x4 w = *(const u32x4*)(src + c * 8);
            x[c * 8 + 0] = bflo(w.x); x[c * 8 + 1] = bfhi(w.x); x[c * 8 + 2] = bflo(w.y); x[c * 8 + 3] = bfhi(w.y); x[c * 8 + 4] = bflo(w.z); x[c * 8 + 5] = bfhi(w.z); x[c * 8 + 6] = bflo(w.w); x[c * 8 + 7] = bfhi(w.w); }
#pragma unroll
        for (int d = 0; d < 64; ++d) ms += x[d] * x[d];
        const float rs = rsqrtf(ms * (1.0f / 64.0f) + EPS);
#pragma unroll
        for (int d = 0; d < 64; ++d) x[d] = x[d] * rs * gain[d];
        if (row >= LCTX) { const f32x2* rp = rope + (size_t)(row - LCTX) * 32;
#pragma unroll
            for (int i = 0; i < 32; ++i) { const f32x2 cs = rp[i]; const float x0 = x[2 * i], x1 = x[2 * i + 1]; x[2 * i] = x0 * cs.x - x1 * cs.y; x[2 * i + 1] = x0 * cs.y + x1 * cs.x; } }
        const float sc = slot < 4 ? QSCALE : 1.0f;
        bf16_t* dst = slot < 4 ? QN + (size_t)row * 256 + slot * 64 : KN + (size_t)row * 128 + (slot - 4) * 64;
#pragma unroll
        for (int c = 0; c < 8; ++c) { u32x4 w; w.x = pk2(x[c * 8] * sc, x[c * 8 + 1] * sc); w.y = pk2(x[c * 8 + 2] * sc, x[c * 8 + 3] * sc); w.z = pk2(x[c * 8 + 4] * sc, x[c * 8 + 5] * sc); w.w = pk2(x[c * 8 + 6] * sc, x[c * 8 + 7] * sc);
            *(u32x4*)(dst + c * 8) = w; }
    }
}
template <int NT> __device__ __forceinline__ void s5local_item(unsigned char* wsb, int dg, int ct, int n0, int lane) {
    const bf16_t* U = (const bf16_t*)(wsb + WS_U); float* SC = (float*)(wsb + WS_SC);
    const int m = lane & 15, kq = lane >> 4, g = dg & 15;
    const bf16_t* BB = (const bf16_t*)(wsb + WS_S5M + (size_t)dg * 256 * KiB + 128 * KiB) + (size_t)n0 * 16 * 256;
    f32x4 acc[NT];
#pragma unroll
    for (int n = 0; n < NT; ++n) acc[n] = (f32x4){0.f, 0.f, 0.f, 0.f};
    const int chunk = ct * 16 + m;
#pragma unroll 2
    for (int ks = 0; ks < 8; ++ks) {
        const int k0 = ks * 32 + 8 * kq;
        const bf16x8 a = *(const bf16x8*)(U + (size_t)(chunk * 16 + (k0 >> 4)) * NIN + 768 + g * 16 + (k0 & 15));
#pragma unroll
        for (int n = 0; n < NT; ++n) { const bf16x8 b = *(const bf16x8*)(BB + (size_t)(n * 16 + m) * 256 + k0);
            acc[n] = __builtin_amdgcn_mfma_f32_16x16x32_bf16(a, b, acc[n], 0, 0, 0); }
    }
#pragma unroll
    for (int n = 0; n < NT; ++n)
#pragma unroll
        for (int i = 0; i < 4; ++i) SC[((size_t)dg * NCH + ct * 16 + 4 * kq + i) * 128 + (n0 + n) * 16 + m] = acc[n][i];
}
__device__ __forceinline__ void pb_s5local(const int wave_s_, const P& p) { unsigned char* const wsb = lndp(p.ws); const int tidx_ = tid_of(wave_s_); const int bidx_ = lnds((int)blockIdx.x);
    const int lane = tidx_ & 63, wave = tidx_ >> 6, gw = bidx_ * 8 + wave, NGW = gridDim.x * 8;
    for (int it = gw; it < 32 * 64; it += NGW) s5local_item<8>(wsb, it >> 6, 1 + (it & 63), 0, lane);
    if (wave == 0) for (int it = bidx_; it < 32 * 8; it += gridDim.x) s5local_item<1>(wsb, it >> 3, 0, it & 7, lane);
}
__device__ __forceinline__ void pb_pool(const int wave_s_, const P& p, int l, LAS unsigned char* lds) { unsigned char* const wsb = lndp(p.ws); const int tidx_ = tid_of(wave_s_); const int bidx_ = lnds((int)blockIdx.x);
    const int tid = tidx_;
    const bf16_t* U = (const bf16_t*)(wsb + WS_U); bf16_t* MG = (bf16_t*)(wsb + WS_MERGED);
    LAS float* ut = (LAS float*)lds;
    LAS float* pt = ut + 80 * 64;
    LAS float* wt = pt + 64 * 65;
    for (int item = bidx_; item < 260 * 4; item += gridDim.x) {
        const int g = item & 3, r0 = (item >> 2) * 64; const int win = 2 << g, hw = win >> 1;
        const int seg0 = r0 < LCTX ? 0 : LCTX, seg1 = r0 < LCTX ? LCTX : R;
        __syncthreads();
        for (int i = tid; i < 80 * 8; i += 512) { const int rr = i >> 3, c8 = (i & 7) * 8; const int row = r0 - 8 + rr; f32x4 a = {0.f, 0.f, 0.f, 0.f}, b = a;
            if (row >= seg0 && row < seg1) { const u32x4 w = *(const u32x4*)(U + (size_t)row * NIN + 1024 + g * 64 + c8); a = (f32x4){bflo(w.x), bfhi(w.x), bflo(w.y), bfhi(w.y)}; b = (f32x4){bflo(w.z), bfhi(w.z), bflo(w.w), bfhi(w.w)}; }
            *(LAS f32x4*)(ut + rr * 64 + c8) = a; *(LAS f32x4*)(ut + rr * 64 + c8 + 4) = b; }
        for (int i = tid; i < 4096; i += 512) wt[i] = PIN(31)[(size_t)(l * 4 + g) * 4096 + i];
        __syncthreads();
        { const int t = tid >> 3, c8 = (tid & 7) * 8; const int row = r0 + t;
          int lo = row - hw; if (lo < seg0) lo = seg0; int hi = row + hw; if (hi > seg1) hi = seg1; const float inv = 1.0f / (float)(hi - lo);
#pragma unroll
          for (int c = 0; c < 8; ++c) { float s = 0.f; for (int rr = lo; rr < hi; ++rr) s += ut[(rr - r0 + 8) * 64 + c8 + c]; pt[t * 65 + c8 + c] = s * inv - ut[(t + 8) * 64 + c8 + c]; } }
        __syncthreads();
        { const int t = tid >> 3, d8 = (tid & 7) * 8; float acc[8];
#pragma unroll
          for (int d = 0; d < 8; ++d) acc[d] = 0.f;
          for (int c = 0; c < 64; ++c) { const float pv = pt[t * 65 + c]; const f32x4 w0 = *(const LAS f32x4*)(wt + c * 64 + d8), w1 = *(const LAS f32x4*)(wt + c * 64 + d8 + 4);
              acc[0] += pv * w0[0]; acc[1] += pv * w0[1]; acc[2] += pv * w0[2]; acc[3] += pv * w0[3]; acc[4] += pv * w1[0]; acc[5] += pv * w1[1]; acc[6] += pv * w1[2]; acc[7] += pv * w1[3]; }
          const float* sc = PIN(32) + l * 256 + g * 64 + d8;
          u32x4 w; w.x = pk2(acc[0] * sc[0], acc[1] * sc[1]); w.y = pk2(acc[2] * sc[2], acc[3] * sc[3]); w.z = pk2(acc[4] * sc[4], acc[5] * sc[5]); w.w = pk2(acc[6] * sc[6], acc[7] * sc[7]);
          *(u32x4*)(MG + (size_t)(r0 + t) * 1024 + 512 + g * 64 + d8) = w; }
    }
    __syncthreads();
}
__device__ __forceinline__ void pb_shortconv(const int wave_s_, const P& p, int l, LAS unsigned char* lds) { unsigned char* const wsb = lndp(p.ws); const int tidx_ = tid_of(wave_s_); const int bidx_ = lnds((int)blockIdx.x);
    const int tid = tidx_;
    const bf16_t* U = (const bf16_t*)(wsb + WS_U); bf16_t* VXT = (bf16_t*)(wsb + WS_VXT);
    LAS float* ut = (LAS float*)lds;
    const float* cw = PIN(12) + (size_t)l * 3 * 768; const float* cb = PIN(13) + l * 768;
    for (int item = bidx_; item < 256 * 12; item += gridDim.x) {
        const int cbk = item % 12, t0 = (item / 12) * 64, c0 = cbk * 64;
        __syncthreads();
        for (int i = tid; i < 66 * 8; i += 512) { const int rr = i >> 3, c8 = (i & 7) * 8; const int t = t0 - 1 + rr; f32x4 a = {0.f, 0.f, 0.f, 0.f}, b = a;
            if (t >= 0 && t < LSEQ) { const u32x4 w = *(const u32x4*)(U + (size_t)(LCTX + t) * NIN + c0 + c8); a = (f32x4){bflo(w.x), bfhi(w.x), bflo(w.y), bfhi(w.y)}; b = (f32x4){bflo(w.z), bfhi(w.z), bflo(w.w), bfhi(w.w)}; }
            LAS float* d = ut + rr * 65 + c8; d[0] = a[0]; d[1] = a[1]; d[2] = a[2]; d[3] = a[3]; d[4] = b[0]; d[5] = b[1]; d[6] = b[2]; d[7] = b[3]; }
        __syncthreads();
        { const int c = tid >> 3, t8 = (tid & 7) * 8; const int col = c0 + c; const float w0 = cw[col], w1 = cw[768 + col], w2 = cw[1536 + col], b = cb[col]; float y[8];
#pragma unroll
          for (int i = 0; i < 8; ++i) y[i] = b + w0 * ut[(t8 + i) * 65 + c] + w1 * ut[(t8 + i + 1) * 65 + c] + w2 * ut[(t8 + i + 2) * 65 + c];
          u32x4 w; w.x = pk2(y[0], y[1]); w.y = pk2(y[2], y[3]); w.z = pk2(y[4], y[5]); w.w = pk2(y[6], y[7]);
          *(u32x4*)(VXT + (size_t)col * LSEQ + t0 + t8) = w; }
    }
    __syncthreads();
}
__device__ __forceinline__ void pa_ctxtaps(const int wave_s_, const P& p, int l) { unsigned char* const wsb = lndp(p.ws); const int tidx_ = tid_of(wave_s_); const int bidx_ = lnds((int)blockIdx.x);
    const float* H2C = (const float*)(wsb + WS_H2C); float* KCT = (float*)(wsb + WS_KCT);
    const float* w3 = PIN(18) + (size_t)l * 64 * 1024; const float* dec = PIN(19) + l * 1024;
    for (int idx = bidx_ * 512 + tidx_; idx < 2 * 256 * 256; idx += gridDim.x * 512) {
        const int ch = idx & 255, n = (idx >> 8) & 255, o = idx >> 16;
        float af = 0.f, ab = 0.f;
#pragma unroll 8
        for (int j = 0; j < 64; ++j) { const float hv = H2C[n * 64 + j]; af += hv * w3[j * 1024 + o * 512 + ch]; ab += hv * w3[j * 1024 + o * 512 + 256 + ch]; }
        const float t = (float)n * (1.0f / 256.0f);
        float* kc = KCT + (size_t)(o * 256 + ch) * 512;
        kc[255 + n] = af * expf(-t * __builtin_fabsf(dec[o * 512 + ch])); if (n < 255) kc[254 - n] = ab * expf(-t * __builtin_fabsf(dec[o * 512 + 256 + ch])); else kc[511] = 0.f;
    }
}
__device__ __forceinline__ void pb_ctxhyena(const int wave_s_, const P& p, int l, LAS unsigned char* lds) { unsigned char* const wsb = lndp(p.ws); const int tidx_ = tid_of(wave_s_); const int bidx_ = lnds((int)blockIdx.x);
    const int tid = tidx_;
    const bf16_t* U = (const bf16_t*)(wsb + WS_U); bf16_t* MG = (bf16_t*)(wsb + WS_MERGED); const float* KCT = (const float*)(wsb + WS_KCT);
    LAS float* zc = (LAS float*)lds; LAS float* x1c = zc + 256; LAS float* x2c = zc + 512; LAS float* kc = zc + 768; LAS float* part = zc + 1280;
    const float* cw = PIN(12) + (size_t)l * 3 * 768; const float* cb = PIN(13) + l * 768;
    for (int ch = bidx_; ch < 256; ch += gridDim.x) {
        __syncthreads();
        if (tid < 256) { const int t = tid;
#pragma unroll
            for (int s = 0; s < 3; ++s) { const int col = s * 256 + ch; const float w0 = cw[col], w1 = cw[768 + col], w2 = cw[1536 + col], b = cb[col];
                const float um = t > 0 ? bf1(U[(size_t)(t - 1) * NIN + col]) : 0.f, u0 = bf1(U[(size_t)t * NIN + col]), up = t < 255 ? bf1(U[(size_t)(t + 1) * NIN + col]) : 0.f;
                (s == 0 ? zc : s == 1 ? x1c : x2c)[t] = b + w0 * um + w1 * u0 + w2 * up; } }
        for (int o = 0; o < 2; ++o) {
            kc[tid] = KCT[(size_t)(o * 256 + ch) * 512 + tid];
            __syncthreads();
            const int t = tid & 255, s0 = (tid >> 8) * 128; float y = 0.f;
#pragma unroll 8
            for (int s = 0; s < 128; ++s) y += zc[s0 + s] * kc[255 + t - s0 - s];
            part[tid] = y;
            __syncthreads();
            float zn = 0.f;
            if (tid < 256) zn = (o == 0 ? x1c[t] : x2c[t]) * (part[t] + part[256 + t] + PIN(20)[(l * 2 + o) * 256 + ch] * zc[t]);
            __syncthreads();
            if (tid < 256) zc[t] = zn;
            __syncthreads();
        }
        if (tid < 256) MG[(size_t)tid * 1024 + ch] = (bf16_t)f2bf(zc[tid]);
    }
    __syncthreads();
}

__device__ __forceinline__ void pc_s5carry(const int wave_s_, const P& p, LAS unsigned char* lds) { unsigned char* const wsb = lndp(p.ws); const int tidx_ = tid_of(wave_s_); const int bidx_ = lnds((int)blockIdx.x);
    const float* SC = (const float*)(wsb + WS_SC); float* HIN = (float*)(wsb + WS_HIN); const float* lamT = (const float*)(wsb + WS_LAMT);
    LAS f32x2* ex = (LAS f32x2*)lds;
    const int pl = tidx_ & 31, seg = tidx_ >> 5;
    for (int wb = bidx_; wb < 64; wb += gridDim.x) {
        const int chain = wb * 32 + pl, dg = chain >> 6, pp = chain & 63, dir = dg >> 4;
        const f32x2 lam = {lamT[dg * 128 + pp], lamT[dg * 128 + 64 + pp]};
        const float* sb = SC + (size_t)dg * NCH * 128 + pp; float* hb = HIN + (size_t)dg * NCH * 128 + pp;
        f32x2 h = {0.f, 0.f};
        for (int b0 = 0; b0 < 65; b0 += 13) {
            f32x2 sv[13];
#pragma unroll
            for (int j = 0; j < 13; ++j) { const int q = seg * 65 + b0 + j; const int c = dir == 0 ? q : (q < 16 ? 15 - q : NCH + 15 - q); sv[j] = (f32x2){sb[(size_t)c * 128], sb[(size_t)c * 128 + 64]}; }
#pragma unroll
            for (int j = 0; j < 13; ++j) h = cmul(lam, h) + sv[j];
        }
        __syncthreads();
        ex[seg * 32 + pl] = h;
        __syncthreads();
        f32x2 l65 = {1.f, 0.f};
        for (int k = 0; k < 65; ++k) l65 = cmul(l65, lam);
        f32x2 cin = {0.f, 0.f};
        for (int s2 = 0; s2 < seg; ++s2) cin = cmul(l65, cin) + ex[s2 * 32 + pl];
        h = cin;
        for (int b0 = 0; b0 < 65; b0 += 13) {
            f32x2 sv[13]; int cidx[13];
#pragma unroll
            for (int j = 0; j < 13; ++j) { const int q = seg * 65 + b0 + j; const int c = dir == 0 ? q : (q < 16 ? 15 - q : NCH + 15 - q); cidx[j] = c; sv[j] = (f32x2){sb[(size_t)c * 128], sb[(size_t)c * 128 + 64]}; }
#pragma unroll
            for (int j = 0; j < 13; ++j) { hb[(size_t)cidx[j] * 128] = h.x; hb[(size_t)cidx[j] * 128 + 64] = h.y; h = cmul(lam, h) + sv[j]; }
        }
    }
    __syncthreads();
}
typedef __bf16 bf16x2_t __attribute__((ext_vector_type(2)));
__device__ __forceinline__ unsigned cvtpk(float lo, float hi) { f32x2 v = {lo, hi}; bf16x2_t b = __builtin_convertvector(v, bf16x2_t); return __builtin_bit_cast(unsigned, b); }
constexpr float ATT_THR = 10.0f;
__device__ __forceinline__ void pc_attention(const int wave_s_, const P& p, LAS unsigned char* lds) { unsigned char* const wsb = lndp(p.ws); const int tidx_ = tid_of(wave_s_); const int bidx_ = lnds((int)blockIdx.x);
    const int tid = tidx_, lane = tid & 63, wave = tid >> 6, r32 = lane & 31, hi = lane >> 5;
    const bf16_t* U = (const bf16_t*)(wsb + WS_U); const bf16_t* QN = (const bf16_t*)(wsb + WS_QN); const bf16_t* KN = (const bf16_t*)(wsb + WS_KN); bf16_t* MG = (bf16_t*)(wsb + WS_MERGED);
    constexpr int RS = 72;
    LAS bf16_t* Ks = (LAS bf16_t*)lds;
    LAS bf16_t* Vs = Ks + 2 * 64 * RS;
    for (int unit = bidx_; unit < 260; unit += gridDim.x) {
        int kh, qb; if (unit < 256) { kh = unit & 1; qb = 2 + (unit >> 1); } else { kh = unit & 1; qb = (unit - 256) >> 1; }
        const int nt = qb < 2 ? 4 : 260;
        const int hq = kh * 2 + (wave >> 2); const int qrow = qb * 128 + (wave & 3) * 32 + r32;
        bf16x8 qr[4];
#pragma unroll
        for (int dk = 0; dk < 4; ++dk) qr[dk] = *(const bf16x8*)(QN + (size_t)qrow * 256 + hq * 64 + dk * 16 + hi * 8);
        f32x16 o0, o1, negm;
#pragma unroll
        for (int i = 0; i < 16; ++i) { o0[i] = 0.f; o1[i] = 0.f; negm[i] = 0.f; }
        float mref = 0.f, lsum = 0.f;
        const int klr = tid >> 3, kseg = (tid & 7) * 8;
        const int vlr = lane, vseg = wave * 8;
        const bf16_t* kg = KN + (size_t)klr * 128 + kh * 64 + kseg; const bf16_t* vg = U + (size_t)vlr * NIN + 1664 + kh * 64 + vseg;
        u32x4 kreg = *(const u32x4*)kg, vreg = *(const u32x4*)vg;
        __syncthreads();
        for (int t = 0; t < nt; ++t) {
            const int buf = t & 1;
            LAS bf16_t* Kb = Ks + buf * 64 * RS; LAS bf16_t* Vb = Vs + buf * 64 * RS;
            *(LAS u32x4*)(Kb + klr * RS + kseg) = kreg;
            { LAS bf16_t* vd = Vb + vseg * RS + vlr;
              vd[0 * RS] = (bf16_t)(vreg.x & 0xffffu); vd[1 * RS] = (bf16_t)(vreg.x >> 16); vd[2 * RS] = (bf16_t)(vreg.y & 0xffffu); vd[3 * RS] = (bf16_t)(vreg.y >> 16);
              vd[4 * RS] = (bf16_t)(vreg.z & 0xffffu); vd[5 * RS] = (bf16_t)(vreg.z >> 16); vd[6 * RS] = (bf16_t)(vreg.w & 0xffffu); vd[7 * RS] = (bf16_t)(vreg.w >> 16); }
            if (t + 1 < nt) { kreg = *(const u32x4*)(kg + (size_t)(t + 1) * 64 * 128); vreg = *(const u32x4*)(vg + (size_t)(t + 1) * 64 * NIN); }
            __syncthreads();
            f32x16 p0, p1;
            __builtin_amdgcn_s_setprio(1);
#pragma unroll
            for (int dk = 0; dk < 4; ++dk) {
                const bf16x8 a0 = *(const LAS bf16x8*)(Kb + r32 * RS + dk * 16 + hi * 8);
                const bf16x8 a1 = *(const LAS bf16x8*)(Kb + (32 + r32) * RS + dk * 16 + hi * 8);
                if (dk == 0) { p0 = __builtin_amdgcn_mfma_f32_32x32x16_bf16(a0, qr[0], negm, 0, 0, 0); p1 = __builtin_amdgcn_mfma_f32_32x32x16_bf16(a1, qr[0], negm, 0, 0, 0); }
                else { p0 = __builtin_amdgcn_mfma_f32_32x32x16_bf16(a0, qr[dk], p0, 0, 0, 0); p1 = __builtin_amdgcn_mfma_f32_32x32x16_bf16(a1, qr[dk], p1, 0, 0, 0); }
            }
            __builtin_amdgcn_s_setprio(0);
            float mx = fmaxf(fmaxf(p0[0], p0[1]), p1[0]);
#pragma unroll
            for (int i = 2; i < 16; i += 2) mx = fmaxf(fmaxf(mx, p0[i]), p0[i + 1]);
#pragma unroll
            for (int i = 1; i < 15; i += 2) mx = fmaxf(fmaxf(mx, p1[i]), p1[i + 1]);
            mx = fmaxf(mx, p1[15]);
            mx = fmaxf(mx, __shfl_xor(mx, 32));
            const bool first = (t == 0);
            if (first || __any(mx > ATT_THR)) {
                const float d = first ? mx : fmaxf(mx, 0.f);
                mref += d;
#pragma unroll
                for (int i = 0; i < 16; ++i) { p0[i] -= d; p1[i] -= d; negm[i] = -mref; }
                if (!first) { const float al = __builtin_amdgcn_exp2f(-d); lsum *= al;
#pragma unroll
                    for (int i = 0; i < 16; ++i) { o0[i] *= al; o1[i] *= al; } }
            }
            float ps = 0.f;
#pragma unroll
            for (int i = 0; i < 16; ++i) { p0[i] = __builtin_amdgcn_exp2f(p0[i]); p1[i] = __builtin_amdgcn_exp2f(p1[i]); ps += p0[i] + p1[i]; }
            lsum += ps;
            __builtin_amdgcn_s_setprio(1);
#pragma unroll
            for (int j = 0; j < 4; ++j) {
                const int half = j >> 1, jj = j & 1;
                u32x4 pb;
                if (half == 0) { pb.x = cvtpk(p0[8 * jj + 0], p0[8 * jj + 1]); pb.y = cvtpk(p0[8 * jj + 2], p0[8 * jj + 3]); pb.z = cvtpk(p0[8 * jj + 4], p0[8 * jj + 5]); pb.w = cvtpk(p0[8 * jj + 6], p0[8 * jj + 7]); }
                else { pb.x = cvtpk(p1[8 * jj + 0], p1[8 * jj + 1]); pb.y = cvtpk(p1[8 * jj + 2], p1[8 * jj + 3]); pb.z = cvtpk(p1[8 * jj + 4], p1[8 * jj + 5]); pb.w = cvtpk(p1[8 * jj + 6], p1[8 * jj + 7]); }
                const bf16x8 pf = __builtin_bit_cast(bf16x8, pb);
                const int kvo = half * 32 + jj * 16 + 4 * hi;
                { const u32x2 lo = *(const LAS u32x2*)(Vb + r32 * RS + kvo), hi2 = *(const LAS u32x2*)(Vb + r32 * RS + kvo + 8);
                  const u32x4 av = {lo.x, lo.y, hi2.x, hi2.y}; o0 = __builtin_amdgcn_mfma_f32_32x32x16_bf16(__builtin_bit_cast(bf16x8, av), pf, o0, 0, 0, 0); }
                { const u32x2 lo = *(const LAS u32x2*)(Vb + (32 + r32) * RS + kvo), hi2 = *(const LAS u32x2*)(Vb + (32 + r32) * RS + kvo + 8);
                  const u32x4 av = {lo.x, lo.y, hi2.x, hi2.y}; o1 = __builtin_amdgcn_mfma_f32_32x32x16_bf16(__builtin_bit_cast(bf16x8, av), pf, o1, 0, 0, 0); }
            }
            __builtin_amdgcn_s_setprio(0);
        }
        lsum += __shfl_xor(lsum, 32);
        const float il = 1.0f / lsum;
        bf16_t* op = MG + (size_t)qrow * 1024 + 768 + hq * 64;
#pragma unroll
        for (int a = 0; a < 4; ++a) {
            u32x2 w; w.x = cvtpk(o0[4 * a] * il, o0[4 * a + 1] * il); w.y = cvtpk(o0[4 * a + 2] * il, o0[4 * a + 3] * il); *(u32x2*)(op + 8 * a + 4 * hi) = w;
            u32x2 w2; w2.x = cvtpk(o1[4 * a] * il, o1[4 * a + 1] * il); w2.y = cvtpk(o1[4 * a + 2] * il, o1[4 * a + 3] * il); *(u32x2*)(op + 32 + 8 * a + 4 * hi) = w2;
        }
        __syncthreads();
    }
}
#define FIDX(i) ((i) ^ ((((i) >> 5) & 3) * 5) ^ ((((i) >> 6) & 1) << 4))
constexpr int FFT_BUF_BYTES = NFFT * 8, FFT_WHI_OFF = FFT_BUF_BYTES, FFT_WLO_OFF = FFT_WHI_OFF + 128 * 8;
__device__ __forceinline__ f32x2 fft_tw(const LAS f32x2* whi, const LAS f32x2* wlo, int t) { return cmul(whi[t >> 6], wlo[t & 63]); }
__device__ __forceinline__ void fft_fwd(LAS f32x2* buf, const LAS f32x2* whi, const LAS f32x2* wlo, int tid) {
    for (int s = 0; s < 7; ++s) {
        const int lq = 12 - 2 * s, q = 1 << lq;
        __syncthreads();
#pragma unroll 4
        for (int i = 0; i < 8; ++i) { const int id = tid + 512 * i; const int j = id & (q - 1), blk = id >> lq; const int i0 = (blk << (lq + 2)) + j;
            const int x0 = FIDX(i0), x1 = FIDX(i0 + q), x2 = FIDX(i0 + 2 * q), x3 = FIDX(i0 + 3 * q);
            const f32x2 a0 = buf[x0], a1 = buf[x1], a2 = buf[x2], a3 = buf[x3];
            const f32x2 w1 = fft_tw(whi, wlo, j << (2 * s)); const f32x2 w2 = cmul(w1, w1);
            const f32x2 b0 = a0 + a2, b2 = cmul(a0 - a2, w1), b1 = a1 + a3; const f32x2 t3 = cmul(a1 - a3, w1); const f32x2 b3 = {t3.y, -t3.x};
            buf[x0] = b0 + b1; buf[x1] = cmul(b0 - b1, w2); buf[x2] = b2 + b3; buf[x3] = cmul(b2 - b3, w2); }
    }
    __syncthreads();
}
__device__ __forceinline__ void fft_inv(LAS f32x2* buf, const LAS f32x2* whi, const LAS f32x2* wlo, int tid) {
    for (int s = 6; s >= 0; --s) {
        const int lq = 12 - 2 * s, q = 1 << lq;
        __syncthreads();
#pragma unroll 4
        for (int i = 0; i < 8; ++i) { const int id = tid + 512 * i; const int j = id & (q - 1), blk = id >> lq; const int i0 = (blk << (lq + 2)) + j;
            const int x0 = FIDX(i0), x1 = FIDX(i0 + q), x2 = FIDX(i0 + 2 * q), x3 = FIDX(i0 + 3 * q);
            const f32x2 c0 = buf[x0], c1 = buf[x1], c2 = buf[x2], c3 = buf[x3];
            const f32x2 w1 = fft_tw(whi, wlo, j << (2 * s)); const f32x2 w2 = cmul(w1, w1);
            const f32x2 t1 = cmulc(c1, w2), t3 = cmulc(c3, w2);
            const f32x2 b0 = c0 + t1, b1 = c0 - t1, b2 = c2 + t3, b3 = c2 - t3;
            const f32x2 u2 = cmulc(b2, w1); const f32x2 u3c = cmulc(b3, w1); const f32x2 u3 = {-u3c.y, u3c.x};
            buf[x0] = b0 + u2; buf[x2] = b0 - u2; buf[x1] = b1 + u3; buf[x3] = b1 - u3; }
    }
    __syncthreads();
}
__device__ __forceinline__ int brev14(int k) { return (int)(__builtin_bitreverse32((unsigned)k) >> 18); }
__device__ __forceinline__ void pc_hyena(const int wave_s_, const P& p, int l, LAS unsigned char* lds) { unsigned char* const wsb = lndp(p.ws); const int tidx_ = tid_of(wave_s_); const int bidx_ = lnds((int)blockIdx.x);
    const int tid = tidx_;
    LAS f32x2* buf = (LAS f32x2*)lds; LAS f32x2* whi = (LAS f32x2*)(lds + FFT_WHI_OFF); LAS f32x2* wlo = (LAS f32x2*)(lds + FFT_WLO_OFF);
    const f32x2* tw = (const f32x2*)(wsb + WS_TW);
    __syncthreads();
    if (tid < 128) whi[tid] = tw[tid * 64]; else if (tid < 192) wlo[tid - 128] = tw[tid - 128];
    const bf16_t* VXT = (const bf16_t*)(wsb + WS_VXT); float* Z1 = (float*)(wsb + WS_Z1); bf16_t* Z2T = (bf16_t*)(wsb + WS_Z2T);
    for (int ch = bidx_; ch < 256; ch += gridDim.x) {
        for (int o = 0; o < 2; ++o) {
            float* filt = (float*)(wsb + WS_FILT) + (size_t)(ch * 2 + o) * 2 * LSEQ;
            const float* hf = filt; const float* hb = filt + LSEQ;
            __syncthreads();
            for (int m = tid; m < NFFT; m += 512) { f32x2 v;
                if (m < NFFT / 2) v = *(const f32x2*)(hf + 2 * m);
                else { const int r = 2 * LSEQ - 2 * m - 2; const f32x2 t = *(const f32x2*)(hb + r); v = (f32x2){m == NFFT / 2 ? 0.f : t.y, t.x}; }
                buf[FIDX(m)] = v; }
            fft_fwd(buf, whi, wlo, tid);
            f32x4* ksp = (f32x4*)filt;
            const float sc = 1.0f / (float)NFFT;
            for (int ph2 = tid; ph2 < NFFT / 2; ph2 += 512) {
                if (ph2 == 0) { const f32x2 a = buf[0], b = buf[1]; ksp[0] = (f32x4){a.x * sc, a.y * sc, b.x * sc, b.y * sc}; }
                else { const int k = brev14(2 * ph2); const int q1 = 2 * ph2, q2 = brev14(NFFT - k); const f32x2 A = buf[FIDX(q1)], B = cconj(buf[FIDX(q2)]);
                    const f32x2 E = (A + B) * (0.5f * sc), D = (A - B) * (0.5f * sc); ksp[ph2] = (f32x4){E.x, E.y, D.y, -D.x}; }
            }
            __syncthreads();
            const bf16_t* zb = VXT + (size_t)ch * LSEQ; const float* z1 = Z1 + (size_t)ch * LSEQ;
            for (int m = tid; m < NFFT; m += 512) { f32x2 v = {0.f, 0.f};
                if (m < NFFT / 2) { if (o == 0) { const unsigned w = *(const unsigned*)(zb + 2 * m); v = (f32x2){bflo(w), bfhi(w)}; } else v = *(const f32x2*)(z1 + 2 * m); }
                buf[FIDX(m)] = v; }
            fft_fwd(buf, whi, wlo, tid);
            for (int ph2 = tid; ph2 < NFFT / 2; ph2 += 512) {
                const f32x4 ks = ksp[ph2];
                if (ph2 == 0) { const f32x2 a = buf[0], b = buf[1];
                    buf[0] = (f32x2){a.x * ks[0] + a.y * ks[1], a.x * ks[1] + a.y * ks[0]};
                    buf[1] = (f32x2){b.x * ks[2] - b.y * ks[3], b.x * ks[3] + b.y * ks[2]}; }
                else { const int k = brev14(2 * ph2); const int p1 = FIDX(2 * ph2), p2 = FIDX(brev14(NFFT - k)); const f32x2 A = buf[p1], B = cconj(buf[p2]);
                    const f32x2 Ez = (A + B) * 0.5f, Dz = (A - B) * 0.5f; const f32x2 Oz = {Dz.y, -Dz.x};
                    const f32x2 Ek = {ks[0], ks[1]}, Ok = {ks[2], ks[3]};
                    const f32x2 Ey = cmul(Ez, Ek) + cmul(fft_tw(whi, wlo, k), cmul(Oz, Ok)); const f32x2 Oy = cmul(Ez, Ok) + cmul(Oz, Ek);
                    buf[p1] = (f32x2){Ey.x - Oy.y, Ey.y + Oy.x};
                    buf[p2] = (f32x2){Ey.x + Oy.y, Oy.x - Ey.y}; }
            }
            fft_inv(buf, whi, wlo, tid);
            const float fb = PIN(20)[(l * 2 + o) * 256 + ch];
            const bf16_t* gt = VXT + (size_t)((o + 1) * 256 + ch) * LSEQ;
            for (int m = tid; m < NFFT / 2; m += 512) { const f32x2 y = buf[FIDX(m)]; f32x2 zp;
                if (o == 0) { const unsigned w = *(const unsigned*)(zb + 2 * m); zp = (f32x2){bflo(w), bfhi(w)}; } else zp = *(const f32x2*)(z1 + 2 * m);
                const unsigned gw = *(const unsigned*)(gt + 2 * m);
                const f32x2 zn = {bflo(gw) * (y.x + fb * zp.x), bfhi(gw) * (y.y + fb * zp.y)};
                if (o == 0) *(f32x2*)(Z1 + (size_t)ch * LSEQ + 2 * m) = zn; else *(unsigned*)(Z2T + (size_t)ch * LSEQ + 2 * m) = pk2(zn.x, zn.y); }
            __syncthreads();
        }
    }
}

__device__ __forceinline__ float gelu_tanh(float x) { const float u = 0.7978845608028654f * (x + 0.044715f * x * x * x); return 0.5f * x * (1.0f + tanhf(u)); }
template <int NT> __device__ __forceinline__ void s5out_item(unsigned char* wsb, int g, int ct, int n0, int lane) {
    const bf16_t* U = (const bf16_t*)(wsb + WS_U); const float* HIN = (const float*)(wsb + WS_HIN); bf16_t* GB = (bf16_t*)(wsb + WS_GBUF);
    const int m = lane & 15, kq = lane >> 4;
    f32x4 acc[NT];
#pragma unroll
    for (int n = 0; n < NT; ++n) acc[n] = (f32x4){0.f, 0.f, 0.f, 0.f};
    const int chunk = ct * 16 + m;
    for (int dir = 0; dir < 2; ++dir) {
        const int dg = dir * 16 + g;
        const bf16_t* KI = (const bf16_t*)(wsb + WS_S5M + (size_t)dg * 256 * KiB) + (size_t)n0 * 16 * 256; const bf16_t* CC = (const bf16_t*)(wsb + WS_S5M + (size_t)dg * 256 * KiB) + 65536 + 32768 + (size_t)n0 * 16 * 128;
#pragma unroll 2
        for (int ks = 0; ks < 8; ++ks) { const int k0 = ks * 32 + 8 * kq;
            const bf16x8 a = *(const bf16x8*)(U + (size_t)(chunk * 16 + (k0 >> 4)) * NIN + 768 + g * 16 + (k0 & 15));
#pragma unroll
            for (int n = 0; n < NT; ++n) { const bf16x8 b = *(const bf16x8*)(KI + (size_t)(n * 16 + m) * 256 + k0); acc[n] = __builtin_amdgcn_mfma_f32_16x16x32_bf16(a, b, acc[n], 0, 0, 0); } }
#pragma unroll 2
        for (int ks = 0; ks < 4; ++ks) { const int k0 = ks * 32 + 8 * kq;
            const float* hp = HIN + ((size_t)dg * NCH + chunk) * 128 + k0; const f32x4 h0 = *(const f32x4*)hp, h1 = *(const f32x4*)(hp + 4);
            u32x4 aw; aw.x = pk2(h0[0], h0[1]); aw.y = pk2(h0[2], h0[3]); aw.z = pk2(h1[0], h1[1]); aw.w = pk2(h1[2], h1[3]);
            const bf16x8 a = __builtin_bit_cast(bf16x8, aw);
#pragma unroll
            for (int n = 0; n < NT; ++n) { const bf16x8 b = *(const bf16x8*)(CC + (size_t)(n * 16 + m) * 128 + k0); acc[n] = __builtin_amdgcn_mfma_f32_16x16x32_bf16(a, b, acc[n], 0, 0, 0); } }
    }
#pragma unroll
    for (int n = 0; n < NT; ++n)
#pragma unroll
        for (int i = 0; i < 4; ++i) { const int row = (ct * 16 + 4 * kq + i) * 16 + n0 + n; GB[(size_t)row * 256 + g * 16 + m] = (bf16_t)f2bf(gelu_tanh(acc[n][i])); }
}
__device__ __forceinline__ void pd_s5out(const int wave_s_, const P& p, int l) { unsigned char* const wsb = lndp(p.ws); const int tidx_ = tid_of(wave_s_); const int bidx_ = lnds((int)blockIdx.x);
    const int lane = tidx_ & 63, wave = tidx_ >> 6, gw = bidx_ * 8 + wave, NGW = gridDim.x * 8;
    for (int it = gw; it < 16 * 64 * 2; it += NGW) s5out_item<8>(wsb, it >> 7, 1 + ((it >> 1) & 63), (it & 1) * 8, lane);
    if (wave == 0 && l + 1 < NLAYER) for (int it = bidx_; it < 16 * 16; it += gridDim.x) s5out_item<1>(wsb, it >> 4, 0, it & 15, lane);
}
__device__ __forceinline__ void pd_hytrans(const int wave_s_, const P& p, LAS unsigned char* lds) { unsigned char* const wsb = lndp(p.ws); const int tidx_ = tid_of(wave_s_); const int bidx_ = lnds((int)blockIdx.x);
    const int tid = tidx_;
    const bf16_t* Z2T = (const bf16_t*)(wsb + WS_Z2T); bf16_t* MG = (bf16_t*)(wsb + WS_MERGED);
    LAS bf16_t* tile = (LAS bf16_t*)lds;
    for (int item = bidx_; item < 256 * 4; item += gridDim.x) {
        const int c0 = (item & 3) * 64, t0 = (item >> 2) * 64;
        __syncthreads();
        { const int c = tid >> 3, t8 = (tid & 7) * 8; const u32x4 w = *(const u32x4*)(Z2T + (size_t)(c0 + c) * LSEQ + t0 + t8);
          LAS unsigned* d = (LAS unsigned*)(tile + c * 66 + t8); d[0] = w.x; d[1] = w.y; d[2] = w.z; d[3] = w.w; }
        __syncthreads();
        { const int t = tid >> 3, c8 = (tid & 7) * 8; unsigned short e[8];
#pragma unroll
          for (int i = 0; i < 8; ++i) e[i] = tile[(c8 + i) * 66 + t];
          u32x4 w; w.x = e[0] | ((unsigned)e[1] << 16); w.y = e[2] | ((unsigned)e[3] << 16); w.z = e[4] | ((unsigned)e[5] << 16); w.w = e[6] | ((unsigned)e[7] << 16);
          *(u32x4*)(MG + (size_t)(LCTX + t0 + t) * 1024 + c0 + c8) = w; }
    }
    __syncthreads();
}
__device__ __forceinline__ void pd2_glu(const int wave_s_, const P& p, int l) { unsigned char* const wsb = lndp(p.ws); const int tidx_ = tid_of(wave_s_); const int bidx_ = lnds((int)blockIdx.x);
    const int lane = tidx_ & 63, wave = tidx_ >> 6, gw = bidx_ * 8 + wave, NGW = gridDim.x * 8, r32 = lane & 31, hi = lane >> 5;
    const bf16_t* GB = (const bf16_t*)(wsb + WS_GBUF); const bf16_t* GLUT = (const bf16_t*)(wsb + WS_GLUT); bf16_t* MG = (bf16_t*)(wsb + WS_MERGED);
    const float* gb = PIN(30) + l * 256;
    if (l + 1 < NLAYER) ctx_gemm16<2>(GB, 256, GLUT, 256, 256, MG + 256, 1024, nullptr, GB, gb, (wave == 1 ? bidx_ : 1 << 30), gridDim.x, lane);
    for (int it = gw; it < 512 * 8; it += NGW) {
        const int rt = 8 + (it >> 3), ct = it & 7;
        f32x16 acc;
#pragma unroll
        for (int i = 0; i < 16; ++i) acc[i] = 0.f;
#pragma unroll 8
        for (int ks = 0; ks < 16; ++ks) { const int k0 = ks * 16 + 8 * hi;
            const bf16x8 a = *(const bf16x8*)(GB + (size_t)(rt * 32 + r32) * 256 + k0); const bf16x8 b = *(const bf16x8*)(GLUT + (size_t)(ct * 32 + r32) * 256 + k0);
            acc = __builtin_amdgcn_mfma_f32_32x32x16_bf16(a, b, acc, 0, 0, 0); }
        const int col = ct * 32 + r32; const float bias = gb[col];
#pragma unroll
        for (int i = 0; i < 16; ++i) { const int row = rt * 32 + (i & 3) + 8 * (i >> 2) + 4 * hi; const float gv = bf1(GB[(size_t)row * 256 + col]);
            const float sg = 1.0f / (1.0f + expf(-(acc[i] + bias))); MG[(size_t)row * 1024 + 256 + col] = (bf16_t)f2bf(gv * sg); }
    }
}

#define XB_TMO      128
#define XB_XCNT(j)  (256  + 64 * (j))
#define XB_XSUB(j)  (1280 + 64 * (j))
#define XB_XGEN(j)  (2304 + 64 * (j))
#define XB_TOP      3328
#define XB_TOPGEN   3392
#define XCD_BAR_WORDS 3456
#define XB_SPIN_CAP (1u << 18)

__device__ __forceinline__ unsigned xb_ld(unsigned* p)              { return __hip_atomic_load(p, __ATOMIC_RELAXED, __HIP_MEMORY_SCOPE_AGENT); }
__device__ __forceinline__ unsigned xb_add(unsigned* p, unsigned v) { return __hip_atomic_fetch_add(p, v, __ATOMIC_RELAXED, __HIP_MEMORY_SCOPE_AGENT); }
__device__ __forceinline__ unsigned xb_xcc_id() { return (unsigned)__builtin_amdgcn_s_getreg((3 << 11) | 20) & 0xFu; }
#define XB_SPIN(cond, bar) do { unsigned _sp = 0; while (cond) { __builtin_amdgcn_s_sleep(1); \
    if ((++_sp & 255u) == 0u) { if (xb_ld(&(bar)[XB_TMO])) break; if (_sp > XB_SPIN_CAP) { atomicAdd(&(bar)[XB_TMO], 1u); break; } } } } while (0)

struct XcdBarrier {
    unsigned* bar; unsigned x;
    volatile LAS unsigned* st;
};

__device__ __forceinline__ XcdBarrier xcd_barrier_post(unsigned* bar, volatile LAS unsigned* st, int tid) {
    XcdBarrier b; b.bar = bar; b.x = xb_xcc_id(); b.st = st;
    if (tid == 0) (void)xb_add(&bar[XB_XCNT(b.x)], 1u);
    return b;
}
__device__ __forceinline__ void xcd_barrier_complete(unsigned* bar, unsigned x, unsigned& nloc, unsigned& nx) {
    const unsigned G = gridDim.x * gridDim.y * gridDim.z;
    unsigned sum, cnt, mine, sp = 0u;
    for (;;) {
        sum = 0u; cnt = 0u; mine = 0u;
#pragma unroll
        for (unsigned j = 0; j < 16; ++j) { const unsigned c = xb_ld(&bar[XB_XCNT(j)]); sum += c; cnt += (c > 0u) ? 1u : 0u; mine = (j == x) ? c : mine; }
        if (sum == G) break;
        __builtin_amdgcn_s_sleep(1);
        if ((++sp & 255u) == 0u) { if (xb_ld(&bar[XB_TMO])) break; if (sp > XB_SPIN_CAP) { atomicAdd(&bar[XB_TMO], 1u); break; } }
    }
    nloc = mine > 0u ? mine : 1u; nx = cnt > 0u ? cnt : 1u;
}

__device__ __forceinline__ void xcd_barrier(const XcdBarrier& b, int tid) {
    asm volatile("s_waitcnt vmcnt(0)" ::: "memory");
    __syncthreads();
    if (tid == 0) {
        unsigned* bar = b.bar;
        __builtin_amdgcn_s_waitcnt(0);
        unsigned nloc = b.st[0], nx = b.st[1];
        if (nloc == 0u) { xcd_barrier_complete(bar, b.x, nloc, nx); b.st[0] = nloc; b.st[1] = nx; }
        const unsigned old = xb_add(&bar[XB_XSUB(b.x)], 1u);
        const unsigned gen = old / nloc;
        if (old + 1u == (gen + 1u) * nloc) {
            __builtin_amdgcn_fence(__ATOMIC_RELEASE, "agent");
            asm volatile("s_waitcnt vmcnt(0)" ::: "memory");
            const unsigned og = xb_add(&bar[XB_TOP], 1u);
            const unsigned tg = og / nx;
            if (og + 1u == (tg + 1u) * nx) xb_add(&bar[XB_TOPGEN], 1u);
            else XB_SPIN(xb_ld(&bar[XB_TOPGEN]) == tg, bar);
            __builtin_amdgcn_fence(__ATOMIC_ACQUIRE, "agent");
            xb_add(&bar[XB_XGEN(b.x)], 1u);
            asm volatile("s_waitcnt vmcnt(0)" ::: "memory");
        } else {
            XB_SPIN(xb_ld(&bar[XB_XGEN(b.x)]) == gen, bar);
            __builtin_amdgcn_fence(__ATOMIC_ACQUIRE, "agent");
            asm volatile("s_waitcnt vmcnt(0)" ::: "memory");
        }
    }
    __syncthreads();
}

__device__ __forceinline__ void grid_bar(unsigned* ctr, unsigned target, int tid) {
    asm volatile("s_waitcnt vmcnt(0) lgkmcnt(0)" ::: "memory");
    __syncthreads();
    if (tid == 0) {
        __builtin_amdgcn_fence(__ATOMIC_RELEASE, "agent");
        asm volatile("s_waitcnt vmcnt(0)" ::: "memory");
        __hip_atomic_fetch_add(ctr, 1u, __ATOMIC_RELAXED, __HIP_MEMORY_SCOPE_AGENT);
        while (__hip_atomic_load(ctr, __ATOMIC_RELAXED, __HIP_MEMORY_SCOPE_AGENT) < target) __builtin_amdgcn_s_sleep(2);
        __builtin_amdgcn_fence(__ATOMIC_ACQUIRE, "agent");
        asm volatile("s_waitcnt vmcnt(0)" ::: "memory");
    }
    __syncthreads();
}
#define PH_BEGIN if (ph >= lo && ph < hi) { unsigned char* const wsb = lndp(p.ws); const int tidx_ = tid_of(wave_s_); const int bidx_ = lnds((int)blockIdx.x); (void)tidx_; (void)bidx_;
#define PH_END   if (ph + 1 < hi) { xcd_barrier(xb, tid_of(wave_s_)); } } ++ph;
#define PH_END0  if (ph + 1 < hi) grid.sync(); } ++ph;
template <int l> __device__ __forceinline__ void layer_phases(const int wave_s_, const P& p, LAS unsigned char* lds, const int lo, const int hi, int& ph, const XcdBarrier& xb) {

        PH_BEGIN
            { float* ss1 = (float*)(wsb + WS_SS1); float* ss2 = (float*)(wsb + WS_SS2); const int t0_ = tid_of(wave_s_);
              for (int i = bidx_ * 512 + t0_; i < R; i += gridDim.x * 512) { ss1[i] = 0.f; ss2[i] = 0.f; } }
            { pg8::Gemm g{(const pg8::bf16_t*)(wsb + WS_H), (const pg8::bf16_t*)(wsb + WS_WIN), R, NIN, DM, tidx_}; pg8::StaticOrder S; S.init(R, NIN, gridDim.x, bidx_);
              pg8::EpiBf16<0> E{(pg8::bf16_t*)(wsb + WS_U), NIN};
              pg8::gemm_phase<pg8::EpiBf16<0>, pg8::StaticOrder, true, true>(lds, g, S, E); }
            __syncthreads();
            { pg8::Gemm g{(const pg8::bf16_t*)(wsb + WS_H2L), (const pg8::bf16_t*)(wsb + WS_W3T), LSEQ, 1024, 128, tid_of(wave_s_)}; pg8::StaticOrder S; S.init(LSEQ, 1024, gridDim.x, bidx_);
              pg8::EpiFilt E{(float*)(wsb + WS_FILT), PIN(19) + l * 1024};
              pg8::gemm_phase<pg8::EpiFilt, pg8::StaticOrder, false, false>(lds, g, S, E); }
            __syncthreads();
            pa_ctxtaps(wave_s_, p, l);
        PH_END
        PH_BEGIN
            pb_attprep(wave_s_, p, l); pb_s5local(wave_s_, p); pb_pool(wave_s_, p, l, lds); pb_shortconv(wave_s_, p, l, lds); pb_ctxhyena(wave_s_, p, l, lds);
        PH_END
        PH_BEGIN
            pc_s5carry(wave_s_, p, lds); pc_attention(wave_s_, p, lds); pc_hyena(wave_s_, p, l, lds);
        PH_END
        PH_BEGIN
            pd_s5out(wave_s_, p, l); pd_hytrans(wave_s_, p, lds);
        PH_END
        PH_BEGIN
            pd2_glu(wave_s_, p, l);
        PH_END
        PH_BEGIN
            { pg8::Gemm g{(const pg8::bf16_t*)(wsb + WS_MERGED) + (size_t)LCTX * DM, (const pg8::bf16_t*)(wsb + WS_WOUT), LSEQ, DM, DM, tidx_}; pg8::StaticOrder S; S.init(LSEQ, DM, gridDim.x, bidx_);
              pg8::EpiSumsq E{(pg8::bf16_t*)(wsb + WS_OL) + (size_t)LCTX * DM, DM, (float*)(wsb + WS_SS1) + LCTX};
              pg8::gemm_phase<pg8::EpiSumsq, pg8::StaticOrder, true, true>(lds, g, S, E); }
            __syncthreads();
            if (l + 1 < NLAYER) { const int t2_ = tid_of(wave_s_); unsigned char* const ws2 = lndp(p.ws);
              ctx_gemm16<0>((const bf16_t*)(ws2 + WS_MERGED), DM, (const bf16_t*)(ws2 + WS_WOUT), DM, DM, (bf16_t*)(ws2 + WS_OL), DM, (float*)(ws2 + WS_SS1), nullptr, nullptr, bidx_ * 8 + (t2_ >> 6), gridDim.x * 8, t2_ & 63); }
        PH_END
        PH_BEGIN
            ew_phase(wave_s_, p, 1, l);
        PH_END
        PH_BEGIN
            { pg8::Gemm g{(const pg8::bf16_t*)(wsb + WS_H) + (size_t)LCTX * DM, (const pg8::bf16_t*)(wsb + WS_W1), LSEQ, FF, DM, tidx_}; pg8::StaticOrder S; S.init(LSEQ, FF, gridDim.x, bidx_);
              pg8::EpiBf16<1> E{(pg8::bf16_t*)(wsb + WS_HID) + (size_t)LCTX * FF, FF};
              pg8::gemm_phase<pg8::EpiBf16<1>, pg8::StaticOrder, true, true>(lds, g, S, E); }
            __syncthreads();
            if (l + 1 < NLAYER) { const int t2_ = tid_of(wave_s_); unsigned char* const ws2 = lndp(p.ws);
              ctx_gemm16<1>((const bf16_t*)(ws2 + WS_H), DM, (const bf16_t*)(ws2 + WS_W1), FF, DM, (bf16_t*)(ws2 + WS_HID), FF, nullptr, nullptr, nullptr, bidx_ * 8 + (t2_ >> 6), gridDim.x * 8, t2_ & 63); }
        PH_END
        PH_BEGIN
            { pg8::Gemm g{(const pg8::bf16_t*)(wsb + WS_HID) + (size_t)LCTX * FF, (const pg8::bf16_t*)(wsb + WS_W2), LSEQ, DM, FF, tidx_}; pg8::StaticOrder S; S.init(LSEQ, DM, gridDim.x, bidx_);
              pg8::EpiSumsq E{(pg8::bf16_t*)(wsb + WS_OL) + (size_t)LCTX * DM, DM, (float*)(wsb + WS_SS2) + LCTX};
              pg8::gemm_phase<pg8::EpiSumsq, pg8::StaticOrder, true, true>(lds, g, S, E); }
            __syncthreads();
            if (l + 1 < NLAYER) { const int t2_ = tid_of(wave_s_); unsigned char* const ws2 = lndp(p.ws);
              ctx_gemm16<0>((const bf16_t*)(ws2 + WS_HID), FF, (const bf16_t*)(ws2 + WS_W2), DM, FF, (bf16_t*)(ws2 + WS_OL), DM, (float*)(ws2 + WS_SS2), nullptr, nullptr, bidx_ * 8 + (t2_ >> 6), gridDim.x * 8, t2_ & 63); }
        PH_END
        PH_BEGIN
            ew_phase(wave_s_, p, 2, l);
            if (l + 1 < NLAYER) prep_layer(wave_s_, p, l + 1, lds);
        PH_END
    }
__global__ void __launch_bounds__(512) mega_fwd(P p) {
    extern __shared__ __attribute__((aligned(16))) unsigned char lds_raw[];
    LAS unsigned char* lds = (LAS unsigned char*)lds_raw;
    cg::grid_group grid = cg::this_grid();
    const int wave_s_ = __builtin_amdgcn_readfirstlane((int)threadIdx.x >> 6);
    const int lo = p.lo, hi = p.hi;
    int ph = 0;
    { volatile LAS unsigned* st0 = (volatile LAS unsigned*)(lds + XB_LDS_OFF); if (threadIdx.x < 2) st0[threadIdx.x] = 0u; }
    __syncthreads();
    const XcdBarrier xb = xcd_barrier_post((unsigned*)(p.ws + WS_BAR), (volatile LAS unsigned*)(lds + XB_LDS_OFF), (int)threadIdx.x);
    PH_BEGIN
        pro_mod(wave_s_, p, lds); pro_tables(wave_s_, p); prep_layer(wave_s_, p, 0, lds);
    PH_END0
    PH_BEGIN
        ew_phase(wave_s_, p, 0, 0);
    PH_END
    layer_phases<0>(wave_s_, p, lds, lo, hi, ph, xb);
    layer_phases<1>(wave_s_, p, lds, lo, hi, ph, xb);
    layer_phases<2>(wave_s_, p, lds, lo, hi, ph, xb);
    layer_phases<3>(wave_s_, p, lds, lo, hi, ph, xb);
#undef PH_BEGIN
#undef PH_END
#undef PH_END0
}
constexpr int N_PHASES = 2 + NLAYER * 10;

#ifndef MK_MULTI
#define MK_MULTI 0
#endif
extern "C" void kernel_launch(void* const* d_in, const int* in_sizes, int n_in, void* d_out, int out_size, void* d_ws, size_t ws_size, hipStream_t stream) {
    static int grid = 0;
    if (grid == 0) {
        if (n_in != 37 || out_size != LSEQ * DM || ws_size < WS_END) { fprintf(stderr, "kernel_launch: unexpected shapes (n_in %d out %d ws %zu)\n", n_in, out_size, ws_size); grid = -1; return; }
        int dev = 0, cus = 0, per_cu = 0;
        (void)hipGetDevice(&dev); (void)hipDeviceGetAttribute(&cus, hipDeviceAttributeMultiprocessorCount, dev);
        if (hipFuncSetAttribute((const void*)mega_fwd, hipFuncAttributeMaxDynamicSharedMemorySize, LDS_BYTES) != hipSuccess) { fprintf(stderr, "kernel_launch: hipFuncSetAttribute failed\n"); grid = -1; return; }
        if (hipOccupancyMaxActiveBlocksPerMultiprocessor(&per_cu, (const void*)mega_fwd, 512, LDS_BYTES) != hipSuccess || per_cu < 1) { fprintf(stderr, "kernel_launch: occupancy query gave %d\n", per_cu); per_cu = 1; }
        (void)hipGetLastError();
        grid = cus * 1;
        if (grid <= 0) grid = 256;
    }
    if (grid < 0) return;
    (void)hipMemsetAsync((unsigned char*)d_ws + WS_BAR, 0, 16384, stream);
    P a{};
    for (int i = 0; i < 37; ++i) a.in[i] = (const float*)d_in[i];
    a.out = (float*)d_out; a.ws = (unsigned char*)d_ws;
#if MK_MULTI
    for (int ph = 0; ph < N_PHASES; ++ph) { a.lo = ph; a.hi = ph + 1; hipLaunchKernelGGL(mega_fwd, dim3(grid), dim3(512), LDS_BYTES, stream, a); }
#else
    a.lo = 0; a.hi = N_PHASES;
    void* args[] = {&a};
    hipError_t e = hipLaunchCooperativeKernel((const void*)mega_fwd, dim3(grid), dim3(512), args, LDS_BYTES, stream);
    if (e != hipSuccess) fprintf(stderr, "cooperative launch failed: %s (grid %d)\n", hipGetErrorString(e), grid);
#endif
}
```

```cpp
#include <hip/hip_runtime.h>
#include <hip/hip_cooperative_groups.h>
#include <cstdio>
#include <cstdint>
namespace cg = cooperative_groups;

__device__ __forceinline__ int lndv(int i) { asm volatile("" : "+v"(i)); return i; }
__device__ __forceinline__ int lnds(int i) { asm volatile("" : "+v"(i)); return __builtin_amdgcn_readfirstlane(i); }
__device__ __forceinline__ int tid_of(int wave_s) { int z = 0; asm volatile("" : "+v"(z)); return (wave_s << 6) + (int)__builtin_amdgcn_mbcnt_hi(~0u, __builtin_amdgcn_mbcnt_lo(~0u, (unsigned)z)); }
namespace pg8 {
#define PG8_LAS __attribute__((address_space(3)))
typedef unsigned short bf16_t;
typedef short bf16x8 __attribute__((ext_vector_type(8)));
typedef float f32x4 __attribute__((ext_vector_type(4)));
typedef unsigned u32x4 __attribute__((ext_vector_type(4)));
constexpr int BM = 256, BK = 64, HALF = 128, HTB = HALF * BK * 2  , STAGE_BYTES = 8 * HTB, NXCD = 8, WGM = 8;

__host__ __device__ __forceinline__ int lds_byte(int r, int c) { const int st = (r >> 4) * 2 + (c >> 5), rr = r & 15, cc = c & 31, ob = rr * 64 + cc * 2; return st * 1024 + (ob ^ (((ob >> 9) & 1) << 5)); }
__host__ __device__ __forceinline__ void stage_rc(int b, int& R, int& C) { const int st = b / 1024, sb = b % 1024, swz = sb ^ (((sb >> 9) & 1) << 5); R = (st >> 1) * 16 + swz / 64; C = (st & 1) * 32 + (swz % 64) / 2; }
__host__ __device__ __forceinline__ int perm32(int rho) { const int n = rho >> 4, i = rho & 15; return 8 * (i >> 2) + 4 * n + (i & 3); }

struct Unit { int pm, pn; };
struct Gemm { const bf16_t* A; const bf16_t* Bt; int M, N, K, tid; };

struct StaticOrder {
    int nM, nN, nwg, G, c;
    __host__ __device__ void init(int M, int N, int G_, int c_) { nM = M / BM; nN = N / BM; nwg = nM * nN; G = G_; c = c_; }
    __host__ __device__ bool next(int i, Unit& u) const {
        const long L = (long)i * G + c; if (L >= nwg) return false;
        int wgid = (int)L; { const int q = nwg / NXCD, r = nwg % NXCD, xcd = wgid % NXCD, off = wgid / NXCD; wgid = (xcd < r ? xcd * (q + 1) : r * (q + 1) + (xcd - r) * q) + off; }
        const int nig = WGM * nN, gid = wgid / nig, fm = gid * WGM, gsz = (nM - fm) < WGM ? (nM - fm) : WGM;
        u.pm = fm + ((wgid % nig) % gsz); u.pn = (wgid % nig) / gsz; return true;
    }
    __device__ __forceinline__ void a_ready(const Unit&) const {}
    __device__ __forceinline__ void done(const Unit&) const {}
};

__device__ __forceinline__ unsigned cvt_pk_bf16(float lo, float hi) { unsigned r; asm volatile("v_cvt_pk_bf16_f32 %0, %1, %2" : "=v"(r) : "v"(lo), "v"(hi)); return r; }

template <int ACT> struct EpiBf16 {
    static constexpr bool PERM = true, AFTER_DRAIN = false;
    bf16_t* O; int ldc;
    __device__ __forceinline__ void operator()(const f32x4 (&acc)[2][2][4][2], const Unit& u, int wr, int wc, int fr, int fq) const {
        const int row0 = u.pm * BM + wr * 64 + fr, col0 = u.pn * BM + wc * 32 + 8 * fq;
#pragma unroll
        for (int ai = 0; ai < 2; ++ai)
#pragma unroll
            for (int m = 0; m < 4; ++m) { bf16_t* rowp = O + (size_t)(row0 + ai * HALF + m * 16) * ldc + col0;
#pragma unroll
                for (int bj = 0; bj < 2; ++bj) { f32x4 v0 = acc[ai][bj][m][0], v1 = acc[ai][bj][m][1];
                    if (ACT == 1) {
#pragma unroll
                        for (int e = 0; e < 4; ++e) { float a = v0[e] > 0.f ? v0[e] : 0.f; v0[e] = a * a; float b = v1[e] > 0.f ? v1[e] : 0.f; v1[e] = b * b; } }
                    u32x4 w; w.x = cvt_pk_bf16(v0[0], v0[1]); w.y = cvt_pk_bf16(v0[2], v0[3]); w.z = cvt_pk_bf16(v1[0], v1[1]); w.w = cvt_pk_bf16(v1[2], v1[3]);
                    *(u32x4*)(rowp + bj * HALF) = w; } }
    }
};
struct EpiSumsq {
    static constexpr bool PERM = true, AFTER_DRAIN = false;
    bf16_t* O; int ldc; float* ss;
    __device__ __forceinline__ void operator()(const f32x4 (&acc)[2][2][4][2], const Unit& u, int wr, int wc, int fr, int fq) const {
        const int row0 = u.pm * BM + wr * 64 + fr, col0 = u.pn * BM + wc * 32 + 8 * fq;
#pragma unroll
        for (int ai = 0; ai < 2; ++ai)
#pragma unroll
            for (int m = 0; m < 4; ++m) { const int row = row0 + ai * HALF + m * 16; bf16_t* rowp = O + (size_t)row * ldc + col0; float s = 0.f;
#pragma unroll
                for (int bj = 0; bj < 2; ++bj) { const f32x4 v0 = acc[ai][bj][m][0], v1 = acc[ai][bj][m][1];
                    s += (v0[0] * v0[0] + v0[1] * v0[1]) + (v0[2] * v0[2] + v0[3] * v0[3]) + (v1[0] * v1[0] + v1[1] * v1[1]) + (v1[2] * v1[2] + v1[3] * v1[3]);
                    u32x4 w; w.x = cvt_pk_bf16(v0[0], v0[1]); w.y = cvt_pk_bf16(v0[2], v0[3]); w.z = cvt_pk_bf16(v1[0], v1[1]); w.w = cvt_pk_bf16(v1[2], v1[3]);
                    *(u32x4*)(rowp + bj * HALF) = w; }
                s += __shfl_xor(s, 16); s += __shfl_xor(s, 32);
                if (fq == 0) atomicAdd(ss + row, s); }
    }
};
struct EpiFilt {
    static constexpr bool PERM = false, AFTER_DRAIN = false;
    float* F; const float* decay;
    __device__ __forceinline__ void operator()(const f32x4 (&acc)[2][2][4][2], const Unit& u, int wr, int wc, int fr, int fq) const {
        const int row0 = u.pm * BM + wr * 64 + fr, col0 = u.pn * BM + wc * 32 + 4 * fq;
#pragma unroll
        for (int bj = 0; bj < 2; ++bj)
#pragma unroll
            for (int n = 0; n < 2; ++n) {
                const int cb = col0 + bj * HALF + n * 16;
                const f32x4 dc = *(const f32x4*)(decay + cb);
#pragma unroll
                for (int e = 0; e < 4; ++e) { const int col = cb + e; const float ad = __builtin_fabsf(dc[e]);
                    float* fp = F + (size_t)((((col & 255) * 2 + (col >> 9)) * 2) + ((col >> 8) & 1)) * 16384;
#pragma unroll
                    for (int ai = 0; ai < 2; ++ai)
#pragma unroll
                        for (int m = 0; m < 4; ++m) { const int r = row0 + ai * HALF + m * 16; const float t = (float)r * (1.0f / 16384.0f);
                            fp[r] = acc[ai][bj][m][n][e] * expf(-t * ad); } } }
    }
};

template <class Epi, class Sched, bool ALIGN_EPI = false, bool SP2 = false>
__device__ __forceinline__ void gemm_phase(PG8_LAS unsigned char* lds, const Gemm g, const Sched& S, const Epi& E) {
    const int tid = g.tid, wid = __builtin_amdgcn_readfirstlane(tid >> 6), lane = tid & 63, wr = wid >> 2, wc = wid & 3, fr = lane & 15, fq = lane >> 4;
    const int K = g.K, nt = K / BK;
    unsigned voffA[2], voffB[2];
#pragma unroll
    for (int i = 0; i < 2; ++i) { int R, C; stage_rc(tid * 16 + i * 8192, R, C); const int Rb = Epi::PERM ? ((R & ~31) + perm32(R & 31)) : R;
        voffA[i] = (unsigned)(R * K + C) * 2u; voffB[i] = (unsigned)(Rb * K + C) * 2u; }
    const size_t kstep = (size_t)(BK * 2);
    const size_t hstep = (size_t)HALF * K * 2;
    const size_t tstep = 2 * hstep;
    const unsigned ldsw = (unsigned)wid * 1024u;
    const int aoff = lds_byte(wr * 64 + fr, fq * 8), boff = lds_byte(wc * 32 + fr, fq * 8);
#define PG8_SA(b, h) (((b) * 2 + (h)) * HTB)
#define PG8_SB(b, h) ((4 + (b) * 2 + (h)) * HTB)
#define PG8_STAGE(bufoff, gbase, voff) do { _Pragma("unroll") for (int _i = 0; _i < 2; ++_i) \
        __builtin_amdgcn_global_load_lds((const unsigned*)((const char*)(gbase) + (voff)[_i]), (PG8_LAS unsigned*)(lds + (bufoff) + ldsw + _i * 8192), 16, 0, 0); } while (0)
#define PG8_LDA(dst, b, h) do { _Pragma("unroll") for (int m = 0; m < 4; ++m) _Pragma("unroll") for (int k = 0; k < 2; ++k) dst[m][k] = *(const PG8_LAS bf16x8*)(lds + PG8_SA(b, h) + aoff + m * 2048 + k * 1024); } while (0)
#define PG8_LDB(dst, b, h) do { _Pragma("unroll") for (int n = 0; n < 2; ++n) _Pragma("unroll") for (int k = 0; k < 2; ++k) dst[n][k] = *(const PG8_LAS bf16x8*)(lds + PG8_SB(b, h) + boff + n * 2048 + k * 1024); } while (0)
#define PG8_MMA(ai, bj, At, Bt) do { __builtin_amdgcn_s_setprio(1); _Pragma("unroll") for (int m = 0; m < 4; ++m) _Pragma("unroll") for (int n = 0; n < 2; ++n) _Pragma("unroll") for (int k = 0; k < 2; ++k) \
        acc[ai][bj][m][n] = __builtin_amdgcn_mfma_f32_16x16x32_bf16(Bt[n][k], At[m][k], acc[ai][bj][m][n], 0, 0, 0); __builtin_amdgcn_s_setprio(0); } while (0)
#define PG8_WAIT_V(n) asm volatile("s_waitcnt vmcnt(" #n ")" ::: "memory")
#define PG8_WAIT_L(n) asm volatile("s_waitcnt lgkmcnt(" #n ")" ::: "memory")
#define PG8_BAR __builtin_amdgcn_s_barrier()
#define PG8_SCHED __builtin_amdgcn_sched_barrier(0)
    Unit cur, nxt; int ui = 0;
    if (!S.next(0, cur)) return;
    f32x4 acc[2][2][4][2];
#pragma unroll
    for (int a = 0; a < 2; ++a)
#pragma unroll
        for (int b = 0; b < 2; ++b)
#pragma unroll
            for (int m = 0; m < 4; ++m)
#pragma unroll
                for (int n = 0; n < 2; ++n) acc[a][b][m][n] = (f32x4){0.f, 0.f, 0.f, 0.f};
    bf16x8 At[4][2], B0[2][2], B1[2][2];
    const char* cA = (const char*)g.A + (size_t)cur.pm * tstep; const char* cB = (const char*)g.Bt + (size_t)cur.pn * tstep;
    S.a_ready(cur);
    if constexpr (SP2) {
        PG8_STAGE(PG8_SB(0, 0), cB, voffB); PG8_STAGE(PG8_SB(0, 1), cB + hstep, voffB); PG8_STAGE(PG8_SA(0, 0), cA, voffA); PG8_STAGE(PG8_SA(0, 1), cA + hstep, voffA);
        if (wr == 1) PG8_BAR;
        PG8_WAIT_V(2); PG8_BAR;
        PG8_STAGE(PG8_SB(1, 0), cB + kstep, voffB); PG8_STAGE(PG8_SA(1, 0), cA + kstep, voffA); PG8_STAGE(PG8_SB(1, 1), cB + hstep + kstep, voffB);
        PG8_WAIT_V(6); PG8_BAR;
    } else {
        PG8_STAGE(PG8_SB(0, 0), cB, voffB); PG8_STAGE(PG8_SA(0, 0), cA, voffA); PG8_STAGE(PG8_SB(0, 1), cB + hstep, voffB); PG8_STAGE(PG8_SA(0, 1), cA + hstep, voffA);
        if (wr == 1) PG8_BAR;
        PG8_WAIT_V(4); PG8_BAR;
        PG8_STAGE(PG8_SB(1, 0), cB + kstep, voffB); PG8_STAGE(PG8_SA(1, 0), cA + kstep, voffA); PG8_STAGE(PG8_SB(1, 1), cB + hstep + kstep, voffB);
        PG8_WAIT_V(6); PG8_BAR;
    }
    for (;;) {
        const bool has_next = S.next(ui + 1, nxt);
        const char* nA = has_next ? (const char*)g.A + (size_t)nxt.pm * tstep : cA; const char* nB = has_next ? (const char*)g.Bt + (size_t)nxt.pn * tstep : cB;
        for (int t = 0; t < nt; t += 2) {
            const bool last = (t == nt - 2);
            const char* a1 = cA + (size_t)(t + 1) * kstep;
            const char* a2 = last ? nA : cA + (size_t)(t + 2) * kstep; const char* b2 = last ? nB : cB + (size_t)(t + 2) * kstep;
            const char* a3 = a2 + kstep; const char* b3 = b2 + kstep;
            if (last && has_next) S.a_ready(nxt);
            if constexpr (SP2) {
            PG8_LDB(B0, 0, 0); PG8_LDB(B1, 0, 1); PG8_SCHED; PG8_LDA(At, 0, 0); PG8_STAGE(PG8_SA(1, 1), a1 + hstep, voffA);
            PG8_WAIT_V(8); PG8_WAIT_L(0); PG8_BAR; PG8_MMA(0, 0, At, B0); PG8_MMA(0, 1, At, B1); PG8_BAR; PG8_SCHED;
            PG8_LDA(At, 0, 1); PG8_STAGE(PG8_SB(0, 0), b2, voffB); PG8_STAGE(PG8_SB(0, 1), b2 + hstep, voffB); PG8_STAGE(PG8_SA(0, 0), a2, voffA);
            PG8_WAIT_V(8); PG8_WAIT_L(0); PG8_BAR; PG8_MMA(1, 0, At, B0); PG8_MMA(1, 1, At, B1); PG8_BAR; PG8_SCHED;
            PG8_LDB(B0, 1, 0); PG8_LDB(B1, 1, 1); PG8_SCHED; PG8_LDA(At, 1, 0); PG8_STAGE(PG8_SA(0, 1), a2 + hstep, voffA);
            PG8_WAIT_V(8); PG8_WAIT_L(0); PG8_BAR; PG8_MMA(0, 0, At, B0); PG8_MMA(0, 1, At, B1); PG8_BAR; PG8_SCHED;
            PG8_LDA(At, 1, 1); PG8_STAGE(PG8_SB(1, 0), b3, voffB); PG8_STAGE(PG8_SB(1, 1), b3 + hstep, voffB); PG8_STAGE(PG8_SA(1, 0), a3, voffA);
            PG8_WAIT_V(8); PG8_WAIT_L(0); PG8_BAR; PG8_MMA(1, 0, At, B0); PG8_MMA(1, 1, At, B1); PG8_BAR; PG8_SCHED;
            } else {
            PG8_LDB(B0, 0, 0); PG8_SCHED; PG8_LDA(At, 0, 0); PG8_STAGE(PG8_SA(1, 1), a1 + hstep, voffA);
            PG8_WAIT_L(8); PG8_BAR; PG8_WAIT_L(0); PG8_MMA(0, 0, At, B0); PG8_BAR; PG8_SCHED;
            PG8_LDB(B1, 0, 1); PG8_STAGE(PG8_SB(0, 0), b2, voffB);
            PG8_BAR; PG8_WAIT_L(0); PG8_MMA(0, 1, At, B1); PG8_BAR;
            PG8_LDA(At, 0, 1); PG8_STAGE(PG8_SA(0, 0), a2, voffA);
            PG8_BAR; PG8_WAIT_L(0); PG8_MMA(1, 0, At, B0); PG8_BAR; PG8_SCHED;
            PG8_STAGE(PG8_SB(0, 1), b2 + hstep, voffB);
            PG8_WAIT_V(6); PG8_BAR; PG8_MMA(1, 1, At, B1); PG8_BAR;
            PG8_LDB(B0, 1, 0); PG8_SCHED; PG8_LDA(At, 1, 0); PG8_STAGE(PG8_SA(0, 1), a2 + hstep, voffA);
            PG8_WAIT_L(8); PG8_BAR; PG8_WAIT_L(0); PG8_MMA(0, 0, At, B0); PG8_BAR; PG8_SCHED;
            PG8_LDB(B1, 1, 1); PG8_STAGE(PG8_SB(1, 0), b3, voffB);
            PG8_BAR; PG8_WAIT_L(0); PG8_MMA(0, 1, At, B1); PG8_BAR;
            PG8_LDA(At, 1, 1); PG8_STAGE(PG8_SA(1, 0), a3, voffA);
            PG8_BAR; PG8_WAIT_L(0); PG8_MMA(1, 0, At, B0); PG8_BAR; PG8_SCHED;
            PG8_STAGE(PG8_SB(1, 1), b3 + hstep, voffB);
            PG8_WAIT_V(6); PG8_BAR; PG8_MMA(1, 1, At, B1); PG8_BAR;
            }
        }
        if constexpr (ALIGN_EPI) { if (wr == 0) PG8_BAR; }
        if constexpr (!Epi::AFTER_DRAIN) { E(acc, cur, wr, wc, fr, fq); S.done(cur); }
        if (!has_next) break;
#pragma unroll
        for (int a = 0; a < 2; ++a)
#pragma unroll
            for (int b = 0; b < 2; ++b)
#pragma unroll
                for (int m = 0; m < 4; ++m)
#pragma unroll
                    for (int n = 0; n < 2; ++n) acc[a][b][m][n] = (f32x4){0.f, 0.f, 0.f, 0.f};
        cur = nxt; cA = nA; cB = nB; ++ui;
        if constexpr (ALIGN_EPI) { if (wr == 1) PG8_BAR; }
    }
    PG8_WAIT_V(0);
    if constexpr (!ALIGN_EPI) { if (wr == 0) PG8_BAR; }
    PG8_BAR;
    if constexpr (Epi::AFTER_DRAIN) { E.fused(acc, cur, wr, wc, fr, fq, lds, wid, lane); S.done(cur); }
#undef PG8_SA
#undef PG8_SB
#undef PG8_STAGE
#undef PG8_LDA
#undef PG8_LDB
#undef PG8_MMA
#undef PG8_WAIT_V
#undef PG8_WAIT_L
#undef PG8_BAR
#undef PG8_SCHED
}
}
#define LAS __attribute__((address_space(3)))
typedef unsigned short bf16_t;
typedef short bf16x8 __attribute__((ext_vector_type(8)));
typedef float f32x4 __attribute__((ext_vector_type(4)));
typedef float f32x2 __attribute__((ext_vector_type(2)));
typedef float f32x16 __attribute__((ext_vector_type(16)));
typedef unsigned u32x4 __attribute__((ext_vector_type(4)));
typedef unsigned u32x2 __attribute__((ext_vector_type(2)));

constexpr int LCTX = 256, LSEQ = 16384, R = LCTX + LSEQ;
constexpr int DM = 1024, NIN = 1792, FF = 4096, NLAYER = 4;
constexpr int NFFT = 16384;
constexpr int NCH = R / 16;
constexpr float EPS = 1e-6f;
constexpr float QSCALE = 0.125f * 1.4426950408889634f;
constexpr size_t KiB = 1024, MiB = 1024 * 1024;
constexpr size_t WS_SS1 = 0, WS_SS2 = 128 * KiB, WS_MODV = 256 * KiB, WS_TW = 512 * KiB, WS_LAMT = 640 * KiB, WS_H2C = 704 * KiB;
constexpr size_t WS_BAR = 768 * KiB;
constexpr size_t WS_XC = 1 * MiB;
constexpr size_t WS_WIN = 2 * MiB, WS_WOUT = 6 * MiB, WS_W1 = 8 * MiB, WS_W2 = 16 * MiB, WS_W3T = 24 * MiB, WS_GLUT = 24 * MiB + 512 * KiB;
constexpr size_t WS_S5M = 25 * MiB;
constexpr size_t WS_KCT = 33 * MiB;
constexpr size_t WS_H2L = 34 * MiB;
constexpr size_t WS_H = 38 * MiB;
constexpr size_t WS_VXT = 38 * MiB, WS_Z2T = 62 * MiB;
constexpr size_t WS_OL = 71 * MiB;
constexpr size_t WS_SC = 71 * MiB, WS_HIN = WS_SC + (size_t)32 * NCH * 128 * 4;
constexpr size_t WS_U = 104 * MiB, WS_MERGED = 161 * MiB, WS_QN = 194 * MiB, WS_GBUF = WS_QN, WS_KN = 203 * MiB, WS_FILT = 208 * MiB, WS_Z1 = 272 * MiB;
constexpr size_t WS_HID = 104 * MiB;
constexpr size_t WS_ROPE = 288 * MiB;
constexpr size_t WS_END = 292 * MiB;
constexpr int LDS_BYTES = 138 * 1024, XB_LDS_OFF = 137 * 1024;

struct P { const float* in[37]; float* out; unsigned char* ws; int lo, hi; };
__device__ __forceinline__ int lnd(int i) { asm volatile("" : "+v"(i)); return __builtin_amdgcn_readfirstlane(i); }
#define PIN(i) ((const float*)(const __attribute__((address_space(1))) float*)(p.in[lnd(i)]))
__device__ __forceinline__ unsigned char* lndp(unsigned char* q) { unsigned lo = (unsigned)(uintptr_t)q, hi = (unsigned)((uintptr_t)q >> 32); asm volatile("" : "+v"(lo), "+v"(hi)); lo = __builtin_amdgcn_readfirstlane(lo); hi = __builtin_amdgcn_readfirstlane(hi); return (unsigned char*)(__attribute__((address_space(1))) unsigned char*)(((uintptr_t)hi << 32) | (uintptr_t)lo); }


__device__ __forceinline__ unsigned f2bf(float f) { unsigned u = __builtin_bit_cast(unsigned, f); return (u + 0x7fffu + ((u >> 16) & 1u)) >> 16; }
__device__ __forceinline__ unsigned pk2(float lo, float hi) { return f2bf(lo) | (f2bf(hi) << 16); }
__device__ __forceinline__ float bflo(unsigned w) { return __builtin_bit_cast(float, w << 16); }
__device__ __forceinline__ float bfhi(unsigned w) { return __builtin_bit_cast(float, w & 0xffff0000u); }
__device__ __forceinline__ float bf1(bf16_t b) { return __builtin_bit_cast(float, (unsigned)b << 16); }
__device__ __forceinline__ float wave_sum(float v) {
#pragma unroll
    for (int o = 1; o < 64; o <<= 1) v += __shfl_xor(v, o);
    return v;
}
__device__ __forceinline__ f32x2 cmul(f32x2 a, f32x2 b) { return (f32x2){a.x * b.x - a.y * b.y, a.x * b.y + a.y * b.x}; }
__device__ __forceinline__ f32x2 cmulc(f32x2 a, f32x2 b) { return (f32x2){a.x * b.x + a.y * b.y, a.y * b.x - a.x * b.y}; }
__device__ __forceinline__ f32x2 cconj(f32x2 a) { return (f32x2){a.x, -a.y}; }

__device__ __forceinline__ void pro_mod(const int wave_s_, const P& p, LAS unsigned char* lds) { unsigned char* const wsb = lndp(p.ws); const int tidx_ = tid_of(wave_s_); const int bidx_ = lnds((int)blockIdx.x);
    const float* c = PIN(1); const float* cc = PIN(3); const float* mw = PIN(4); const float* mb = PIN(5);
    float* modv = (float*)(wsb + WS_MODV);
    LAS float* red = (LAS float*)lds;
    const int tid = tidx_, cq = tid & 15, ks = tid >> 4;
    for (int item = bidx_; item < 4 * 96; item += gridDim.x) {
        const int layer = item / 96, n0 = (item % 96) * 64;
        f32x4 aL = {0.f, 0.f, 0.f, 0.f}, aC = {0.f, 0.f, 0.f, 0.f};
        const float* wp = mw + ((size_t)layer * 1024 + ks * 32) * 6144 + n0 + 4 * cq;
        for (int k = 0; k < 32; ++k) {
            const float cv = c[ks * 32 + k], xv = cc[ks * 32 + k];
            const float sl = cv / (1.f + expf(-cv)), sc = xv / (1.f + expf(-xv));
            const f32x4 w = *(const f32x4*)(wp + (size_t)k * 6144);
            aL += w * sl; aC += w * sc;
        }
        LAS float* r = red + (ks * 16 + cq) * 8;
        r[0] = aL[0]; r[1] = aL[1]; r[2] = aL[2]; r[3] = aL[3]; r[4] = aC[0]; r[5] = aC[1]; r[6] = aC[2]; r[7] = aC[3];
        __syncthreads();
        if (tid < 128) { const int cq2 = tid & 15, j = tid >> 4; float s = 0.f;
            for (int k2 = 0; k2 < 32; ++k2) s += red[(k2 * 16 + cq2) * 8 + j];
            const int n = n0 + 4 * cq2 + (j & 3), stream = j >> 2;
            modv[(layer * 2 + stream) * 6144 + n] = s + mb[layer * 6144 + n]; }
        __syncthreads();
    }
}
__device__ __forceinline__ void pro_tables(const int wave_s_, const P& p) { unsigned char* const wsb = lndp(p.ws); const int tidx_ = tid_of(wave_s_); const int bidx_ = lnds((int)blockIdx.x);
    const int gt = bidx_ * 512 + tidx_, GT = gridDim.x * 512;
    f32x2* tw = (f32x2*)(wsb + WS_TW);
    for (int t = gt; t <= 8192; t += GT) { float s, c; sincospif((float)t * (1.0f / 8192.0f), &s, &c); tw[t] = (f32x2){c, -s}; }
    f32x2* rope = (f32x2*)(wsb + WS_ROPE);
    for (int i = gt; i < LSEQ * 32; i += GT) { const int t = i >> 5, j = i & 31; const int pos = j < 16 ? (t >> 6) : (t & 63);
        const float inv = powf(10000.0f, -(float)(2 * (j & 15)) / 32.0f); const float ang = (float)pos * inv; float s, c; sincosf(ang, &s, &c); rope[i] = (f32x2){c, s}; }
}
__device__ __forceinline__ void ew_phase(const int wave_s_, const P& p, int mode, int layer) { unsigned char* const wsb = lndp(p.ws); const int tidx_ = tid_of(wave_s_); const int bidx_ = lnds((int)blockIdx.x);
    const int lane = tidx_ & 63, wave = tidx_ >> 6;
    const int gw = bidx_ * 8 + wave, NGW = gridDim.x * 8;
    const float* modv = (const float*)(wsb + WS_MODV);
    const float* ss = (const float*)(wsb + (mode == 1 ? WS_SS1 : WS_SS2));
    const bf16_t* OL = (const bf16_t*)(wsb + WS_OL);
    bf16_t* H = (bf16_t*)(wsb + WS_H);
    float* xc = (float*)(wsb + WS_XC);
    const float* gpost = (mode == 1 ? PIN(7) : PIN(9)) + layer * 1024;
    const int gi = mode == 1 ? 2 : 5;
    const bool donorm = !(mode == 2 && layer == NLAYER - 1);
    const int nl = mode == 2 ? layer + 1 : layer;
    const float* gpre = (mode == 1 ? PIN(8) : PIN(6)) + (donorm ? nl : 0) * 1024;
    const int shi = mode == 1 ? 3 : 0, sci = mode == 1 ? 4 : 1;
    for (int row = gw; row < R; row += NGW) {
        const int stream = row < LCTX ? 1 : 0;
        float* xp = row < LCTX ? xc + (size_t)row * 1024 : p.out + (size_t)(row - LCTX) * 1024;
        const float* src = mode == 0 ? (row < LCTX ? PIN(2) + (size_t)row * 1024 : PIN(0) + (size_t)(row - LCTX) * 1024) : xp;
        f32x4 v[4];
#pragma unroll
        for (int j = 0; j < 4; ++j) v[j] = *(const f32x4*)(src + j * 256 + lane * 4);
        if (mode != 0) {
            const float rs = rsqrtf(ss[row] * (1.0f / 1024.0f) + EPS);
            const float* mg = modv + (layer * 2 + stream) * 6144 + gi * 1024;
#pragma unroll
            for (int j = 0; j < 4; ++j) { const int col = j * 256 + lane * 4;
                const f32x4 g = *(const f32x4*)(mg + col) * *(const f32x4*)(gpost + col) * rs;
                const u32x2 o = *(const u32x2*)(OL + (size_t)row * 1024 + col);
                v[j] += g * (f32x4){bflo(o.x), bfhi(o.x), bflo(o.y), bfhi(o.y)}; }
        }
#pragma unroll
        for (int j = 0; j < 4; ++j) *(f32x4*)(xp + j * 256 + lane * 4) = v[j];
        if (donorm) {
            float s = 0.f;
#pragma unroll
            for (int j = 0; j < 4; ++j) s += (v[j][0] * v[j][0] + v[j][1] * v[j][1]) + (v[j][2] * v[j][2] + v[j][3] * v[j][3]);
            s = wave_sum(s);
            const float rstd = rsqrtf(s * (1.0f / 1024.0f) + EPS);
            const float* msh = modv + (nl * 2 + stream) * 6144 + shi * 1024; const float* msc = modv + (nl * 2 + stream) * 6144 + sci * 1024;
#pragma unroll
            for (int j = 0; j < 4; ++j) { const int col = j * 256 + lane * 4;
                const f32x4 y = v[j] * rstd * *(const f32x4*)(gpre + col) * (*(const f32x4*)(msc + col) + 1.0f) + *(const f32x4*)(msh + col);
                u32x2 w; w.x = pk2(y[0], y[1]); w.y = pk2(y[2], y[3]);
                *(u32x2*)(H + (size_t)row * 1024 + col) = w; }
        }
    }
}
__device__ __forceinline__ void transpose_item(const float* W, int K, int N, bf16_t* WT, int ldo, LAS float* scr, int item, int lane) {
    const int nblk = N / 32, kb = item / nblk, nb = item % nblk, k0 = 64 * kb, n0 = 32 * nb;
#pragma unroll 8
    for (int i = 0; i < 32; ++i) { const int kk = 2 * i + (lane >> 5); scr[kk * 33 + (lane & 31)] = W[(size_t)(k0 + kk) * N + n0 + (lane & 31)]; }
    asm volatile("s_waitcnt lgkmcnt(0)" ::: "memory");
    const int c = lane & 7;
#pragma unroll
    for (int j = 0; j < 4; ++j) { const int n = (lane >> 3) + 8 * j; const LAS float* s = scr + (8 * c) * 33 + n;
        u32x4 o; o.x = pk2(s[0 * 33], s[1 * 33]); o.y = pk2(s[2 * 33], s[3 * 33]); o.z = pk2(s[4 * 33], s[5 * 33]); o.w = pk2(s[6 * 33], s[7 * 33]);
        *(u32x4*)(WT + (size_t)(n0 + n) * ldo + k0 + 8 * c) = o; }
    asm volatile("s_waitcnt lgkmcnt(0)" ::: "memory");
}
__device__ __forceinline__ void prep_layer(const int wave_s_, const P& p, int l, LAS unsigned char* lds) { unsigned char* const wsb = lndp(p.ws); const int tidx_ = tid_of(wave_s_); const int bidx_ = lnds((int)blockIdx.x);
    const int tid = tidx_, lane = tid & 63, wave = tid >> 6;
    const int gt = bidx_ * 512 + tid, GT = gridDim.x * 512;
    bf16_t* WIN = (bf16_t*)(wsb + WS_WIN); bf16_t* WOUT = (bf16_t*)(wsb + WS_WOUT); bf16_t* W1 = (bf16_t*)(wsb + WS_W1); bf16_t* W2 = (bf16_t*)(wsb + WS_W2);
    bf16_t* W3T = (bf16_t*)(wsb + WS_W3T); bf16_t* GLUT = (bf16_t*)(wsb + WS_GLUT); bf16_t* H2L = (bf16_t*)(wsb + WS_H2L); float* H2C = (float*)(wsb + WS_H2C);
    {
        const u32x4 z4 = {0u, 0u, 0u, 0u};
        for (int i = gt; i < 1024 * 8; i += GT) *(u32x4*)(W3T + (size_t)(i >> 3) * 128 + 64 + (i & 7) * 8) = z4;
        for (int i = gt; i < 16384 * 8; i += GT) *(u32x4*)(H2L + (size_t)(i >> 3) * 128 + 64 + (i & 7) * 8) = z4;
    }
    constexpr int I_IN = 16 * 56, I_OUT = 16 * 32, I_1 = 16 * 128, I_2 = 64 * 32, I_3 = 1 * 32, I_G = 4 * 8;
    constexpr int NTILE = I_IN + I_OUT + I_1 + I_2 + I_3 + I_G;
    constexpr int N_S5 = 32, N_H2 = 130, N_TR = (NTILE + 7) / 8, N_ITEMS = N_S5 + N_H2 + N_TR;
    const bool split_ = gridDim.x >= 128;
    const int item0_ = !split_ ? bidx_ : (bidx_ < N_S5 ? bidx_ : N_S5 + bidx_ - N_S5), step_ = !split_ ? (int)gridDim.x : (bidx_ < N_S5 ? N_ITEMS : (int)gridDim.x - N_S5);
    for (int item = item0_; item < N_ITEMS; item += step_) {
        __syncthreads();
        if (item < N_S5) {
            LAS f32x2* pw = (LAS f32x2*)lds;
            LAS f32x2* bb = pw + 17 * 64;
            LAS f32x2* cc = bb + 64 * 16;
            LAS f32x2* crci = cc + 16 * 64;
            LAS float* kt = (LAS float*)(crci + 64);
            float* lamT = (float*)(wsb + WS_LAMT);
            const int dg = item, dir = dg >> 4, g = dg & 15; const int pb = ((l * 2 + dir) * 16 + g);
            if (tid < 64) {
                const float are = PIN(21)[pb * 64 + tid], aim = PIN(22)[pb * 64 + tid]; const float dt = expf(PIN(23)[pb]);
                const float mag = expf(are * dt), ang = aim * dt; const float lr = mag * cosf(ang), li = mag * sinf(ang);
                const float den = are * are + aim * aim, nr = lr - 1.0f, ni = li;
                crci[tid] = (f32x2){(nr * are + ni * aim) / den, (ni * are - nr * aim) / den};
                f32x2 w = {1.f, 0.f}; const f32x2 lam = {lr, li};
                for (int k = 0; k <= 16; ++k) { pw[k * 64 + tid] = w; w = cmul(w, lam); }
                const f32x2 l16 = pw[16 * 64 + tid]; lamT[dg * 128 + tid] = l16.x; lamT[dg * 128 + 64 + tid] = l16.y;
            }
            __syncthreads();
            for (int idx = tid; idx < 1024; idx += 512) {
                { const int pp = idx >> 4, h = idx & 15; const float bre = PIN(24)[(size_t)(pb * 64 + pp) * 16 + h], bim = PIN(25)[(size_t)(pb * 64 + pp) * 16 + h]; const f32x2 cr = crci[pp];
                  bb[idx] = (f32x2){cr.x * bre - cr.y * bim, cr.x * bim + cr.y * bre}; }
                { cc[idx] = (f32x2){PIN(26)[(size_t)pb * 1024 + idx], PIN(27)[(size_t)pb * 1024 + idx]}; }
            }
            __syncthreads();
            for (int idx = tid; idx < 4096; idx += 512) { const int k = idx >> 8, hp = (idx >> 4) & 15, h = idx & 15; float s = 0.f;
                for (int pp = 0; pp < 64; ++pp) { const f32x2 t = cmul(cc[hp * 64 + pp], pw[k * 64 + pp]); const f32x2 b = bb[pp * 16 + h]; s += t.x * b.x - t.y * b.y; }
                kt[idx] = s; }
            __syncthreads();
            unsigned* KI = (unsigned*)(wsb + WS_S5M + (size_t)dg * 256 * KiB); unsigned* BB = KI + 32768; unsigned* CC = BB + 16384;
            const float* dsk = PIN(28) + l * 256 + g * 16;
            for (int i2 = tid; i2 < 32768; i2 += 512) { const int n = i2 >> 7, kp = i2 & 127, kk = 2 * kp, s = kk >> 4, h = kk & 15, t = n >> 4, hp = n & 15;
                const int lag = dir == 0 ? t - s : s - t; float v0 = 0.f, v1 = 0.f;
                if (lag >= 0) { v0 = kt[(lag * 16 + hp) * 16 + h]; v1 = kt[(lag * 16 + hp) * 16 + h + 1]; }
                if (dir == 0 && lag == 0) { if (h == hp) v0 += dsk[hp]; if (h + 1 == hp) v1 += dsk[hp]; }
                KI[i2] = pk2(v0, v1); }
            for (int i2 = tid; i2 < 16384; i2 += 512) { const int col = i2 >> 7, kp = i2 & 127, kk = 2 * kp, s = kk >> 4, h = kk & 15, ri = col >> 6, pp = col & 63;
                const int e = dir == 0 ? 15 - s : s; const f32x2 w = pw[e * 64 + pp]; const f32x2 a = cmul(w, bb[pp * 16 + h]), b = cmul(w, bb[pp * 16 + h + 1]);
                BB[i2] = ri == 0 ? pk2(a.x, b.x) : pk2(a.y, b.y); }
            for (int i2 = tid; i2 < 16384; i2 += 512) { const int n = i2 >> 6, cp = i2 & 63, col = 2 * cp, ri = col >> 6, pp = col & 63, t = n >> 4, hp = n & 15;
                const int e = dir == 0 ? t + 1 : 16 - t; const f32x2 a = cmul(cc[hp * 64 + pp], pw[e * 64 + pp]), b = cmul(cc[hp * 64 + pp + 1], pw[e * 64 + pp + 1]);
                CC[i2] = ri == 0 ? pk2(a.x, b.x) : pk2(-a.y, -b.y); }
        } else if (item < N_S5 + N_H2) {
            LAS float* w1s = (LAS float*)lds; LAS float* b1s = w1s + 33 * 64; LAS float* w2s = b1s + 64; LAS float* b2s = w2s + 4096;
            for (int i = tid; i < 33 * 64; i += 512) w1s[i] = PIN(14)[l * 33 * 64 + i];
            for (int i = tid; i < 4096; i += 512) w2s[i] = PIN(16)[l * 4096 + i];
            if (tid < 64) { b1s[tid] = PIN(15)[l * 64 + tid]; b2s[tid] = PIN(17)[l * 64 + tid]; }
            __syncthreads();
            const int rr = (item - N_S5) * 128 + (tid >> 2), part = tid & 3; const bool isctx = rr >= LSEQ; const int n = isctx ? rr - LSEQ : rr;
            const float t = (float)n / (isctx ? 256.0f : 16384.0f);
            float h1[64];
#pragma unroll
            for (int j = 0; j < 64; ++j) h1[j] = b1s[j] + t * w1s[j];
            _Pragma("nounroll") for (int f = 1; f <= 16; ++f) { float cs, sn; sincospif(2.0f * t * (float)f, &sn, &cs);
#pragma unroll
                for (int j = 0; j < 64; ++j) h1[j] += cs * w1s[f * 64 + j] + sn * w1s[(16 + f) * 64 + j]; }
#pragma unroll
            for (int j = 0; j < 64; ++j) h1[j] = sinpif(h1[j] * 0.3183098861837907f);
            _Pragma("nounroll") for (int jj = 0; jj < 16; jj += 2) { const int j = part * 16 + jj; float a0 = b2s[j], a1 = b2s[j + 1];
#pragma unroll
                for (int i = 0; i < 64; ++i) { a0 += h1[i] * w2s[i * 64 + j]; a1 += h1[i] * w2s[i * 64 + j + 1]; }
                a0 = sinpif(a0 * 0.3183098861837907f); a1 = sinpif(a1 * 0.3183098861837907f);
                if (isctx) { H2C[n * 64 + j] = a0; H2C[n * 64 + j + 1] = a1; } else *(unsigned*)(H2L + (size_t)n * 128 + j) = pk2(a0, a1); }
        } else {
            LAS float* scr = (LAS float*)(lds + wave * 16384);
            int r = (item - N_S5 - N_H2) * 8 + wave;
            if (r < NTILE) {
                if (r < I_IN) transpose_item(PIN(10) + (size_t)l * DM * NIN, DM, NIN, WIN, DM, scr, r, lane);
                else if ((r -= I_IN) < I_OUT) transpose_item(PIN(11) + (size_t)l * DM * DM, DM, DM, WOUT, DM, scr, r, lane);
                else if ((r -= I_OUT) < I_1) transpose_item(PIN(35) + (size_t)l * DM * FF, DM, FF, W1, DM, scr, r, lane);
                else if ((r -= I_1) < I_2) transpose_item(PIN(36) + (size_t)l * FF * DM, FF, DM, W2, FF, scr, r, lane);
                else if ((r -= I_2) < I_3) transpose_item(PIN(18) + (size_t)l * 64 * 1024, 64, 1024, W3T, 128, scr, r, lane);
                else { r -= I_3; transpose_item(PIN(29) + (size_t)l * 256 * 256, 256, 256, GLUT, 256, scr, r, lane); }
            }
        }
    }
    __syncthreads();
}

template <int EPI> __device__ __forceinline__ void ctx_gemm16(const bf16_t* A, int lda, const bf16_t* Bt, int N, int K, bf16_t* O, int ldo, float* ss, const bf16_t* aux, const float* bias, int gw, int NGW, int lane) {
    const int m = lane & 15, kq = lane >> 4; const int ntile = 16 * (N >> 4);
    for (int it = gw; it < ntile; it += NGW) {
        const int rt = it & 15, ctile = it >> 4;
        f32x4 acc = {0.f, 0.f, 0.f, 0.f};
        const bf16_t* ap = A + (size_t)(rt * 16 + m) * lda + 8 * kq; const bf16_t* bp = Bt + (size_t)(ctile * 16 + m) * K + 8 * kq;
#pragma unroll 8
        for (int ks = 0; ks < (K >> 5); ++ks) { const bf16x8 a = *(const bf16x8*)(ap + ks * 32); const bf16x8 b = *(const bf16x8*)(bp + ks * 32); acc = __builtin_amdgcn_mfma_f32_16x16x32_bf16(a, b, acc, 0, 0, 0); }
        const int col = ctile * 16 + m;
#pragma unroll
        for (int i = 0; i < 4; ++i) { const int row = rt * 16 + 4 * kq + i; float v = acc[i];
            if (EPI == 0) { float s = v * v; s += __shfl_xor(s, 1); s += __shfl_xor(s, 2); s += __shfl_xor(s, 4); s += __shfl_xor(s, 8); if (m == 0) atomicAdd(ss + row, s); }
            if (EPI == 1) { v = v > 0.f ? v * v : 0.f; }
            if (EPI == 2) { const float gv = bf1(aux[(size_t)row * 256 + col]); v = gv / (1.0f + expf(-(v + bias[col]))); }
            O[(size_t)row * ldo + col] = (bf16_t)f2bf(v); }
    }
}
__device__ __forceinline__ void pb_attprep(const int wave_s_, const P& p, int l) { unsigned char* const wsb = lndp(p.ws); const int tidx_ = tid_of(wave_s_); const int bidx_ = lnds((int)blockIdx.x);
    const int gt = bidx_ * 512 + tidx_, GT = gridDim.x * 512;
    const bf16_t* U = (const bf16_t*)(wsb + WS_U); bf16_t* QN = (bf16_t*)(wsb + WS_QN); bf16_t* KN = (bf16_t*)(wsb + WS_KN);
    const f32x2* rope = (const f32x2*)(wsb + WS_ROPE);
    for (int idx = gt; idx < R * 6; idx += GT) {
        const int row = idx / 6, slot = idx - row * 6;
        const bf16_t* src = U + (size_t)row * NIN + (slot < 4 ? 1280 + slot * 64 : 1536 + (slot - 4) * 64);
        const float* gain = (slot < 4 ? PIN(33) : PIN(34)) + l * 64;
        float x[64]; float ms = 0.f;
#pragma unroll
        for (int c = 0; c < 8; ++c) { const u32x4 w = *(const u32x4*)(src + c * 8);
            x[c * 8 + 0] = bflo(w.x); x[c * 8 + 1] = bfhi(w.x); x[c * 8 + 2] = bflo(w.y); x[c * 8 + 3] = bfhi(w.y); x[c * 8 + 4] = bflo(w.z); x[c * 8 + 5] = bfhi(w.z); x[c * 8 + 6] = bflo(w.w); x[c * 8 + 7] = bfhi(w.w); }
#pragma unroll
        for (int d = 0; d < 64; ++d) ms += x[d] * x[d];
        const float rs = rsqrtf(ms * (1.0f / 64.0f) + EPS);
#pragma unroll
        for (int d = 0; d < 64; ++d) x[d] = x[d] * rs * gain[d];
        if (row >= LCTX) { const f32x2* rp = rope + (size_t)(row - LCTX) * 32;
#pragma unroll
            for (int i = 0; i < 32; ++i) { const f32x2 cs = rp[i]; const float x0 = x[2 * i], x1 = x[2 * i + 1]; x[2 * i] = x0 * cs.x - x1 * cs.y; x[2 * i + 1] = x0 * cs.y + x1 * cs.x; } }
        const float sc = slot < 4 ? QSCALE : 1.0f;
        bf16_t* dst = slot < 4 ? QN + (size_t)row * 256 + slot * 64 : KN + (size_t)row * 128 + (slot - 4) * 64;
#pragma unroll
        for (int c = 0; c < 8; ++c) { u32x4 w; w.x = pk2(x[c * 8] * sc, x[c * 8 + 1] * sc); w.y = pk2(x[c * 8 + 2] * sc, x[c * 8 + 3] * sc); w.z = pk2(x[c * 8 + 4] * sc, x[c * 8 + 5] * sc); w.w = pk2(x[c * 8 + 6] * sc, x[c * 8 + 7] * sc);
            *(u32x4*)(dst + c * 8) = w; }
    }
}
template <int NT> __device__ __forceinline__ void s5local_item(unsigned char* wsb, int dg, int ct, int n0, int lane) {
    const bf16_t* U = (const bf16_t*)(wsb + WS_U); float* SC = (float*)(wsb + WS_SC);
    const int m = lane & 15, kq = lane >> 4, g = dg & 15;
    const bf16_t* BB = (const bf16_t*)(wsb + WS_S5M + (size_t)dg * 256 * KiB + 128 * KiB) + (size_t)n0 * 16 * 256;
    f32x4 acc[NT];
#pragma unroll
    for (int n = 0; n < NT; ++n) acc[n] = (f32x4){0.f, 0.f, 0.f, 0.f};
    const int chunk = ct * 16 + m;
#pragma unroll 2
    for (int ks = 0; ks < 8; ++ks) {
        const int k0 = ks * 32 + 8 * kq;
        const bf16x8 a = *(const bf16x8*)(U + (size_t)(chunk * 16 + (k0 >> 4)) * NIN + 768 + g * 16 + (k0 & 15));
#pragma unroll
        for (int n = 0; n < NT; ++n) { const bf16x8 b = *(const bf16x8*)(BB + (size_t)(n * 16 + m) * 256 + k0);
            acc[n] = __builtin_amdgcn_mfma_f32_16x16x32_bf16(a, b, acc[n], 0, 0, 0); }
    }
#pragma unroll
    for (int n = 0; n < NT; ++n)
#pragma unroll
        for (int i = 0; i < 4; ++i) SC[((size_t)dg * NCH + ct * 16 + 4 * kq + i) * 128 + (n0 + n) * 16 + m] = acc[n][i];
}
__device__ __forceinline__ void pb_s5local(const int wave_s_, const P& p) { unsigned char* const wsb = lndp(p.ws); const int tidx_ = tid_of(wave_s_); const int bidx_ = lnds((int)blockIdx.x);
    const int lane = tidx_ & 63, wave = tidx_ >> 6, gw = bidx_ * 8 + wave, NGW = gridDim.x * 8;
    for (int it = gw; it < 32 * 64; it += NGW) s5local_item<8>(wsb, it >> 6, 1 + (it & 63), 0, lane);
    if (wave == 0) for (int it = bidx_; it < 32 * 8; it += gridDim.x) s5local_item<1>(wsb, it >> 3, 0, it & 7, lane);
}
__device__ __forceinline__ void pb_pool(const int wave_s_, const P& p, int l, LAS unsigned char* lds) { unsigned char* const wsb = lndp(p.ws); const int tidx_ = tid_of(wave_s_); const int bidx_ = lnds((int)blockIdx.x);
    const int tid = tidx_;
    const bf16_t* U = (const bf16_t*)(wsb + WS_U); bf16_t* MG = (bf16_t*)(wsb + WS_MERGED);
    LAS float* ut = (LAS float*)lds;
    LAS float* pt = ut + 80 * 64;
    LAS float* wt = pt + 64 * 65;
    for (int item = bidx_; item < 260 * 4; item += gridDim.x) {
        const int g = item & 3, r0 = (item >> 2) * 64; const int win = 2 << g, hw = win >> 1;
        const int seg0 = r0 < LCTX ? 0 : LCTX, seg1 = r0 < LCTX ? LCTX : R;
        __syncthreads();
        for (int i = tid; i < 80 * 8; i += 512) { const int rr = i >> 3, c8 = (i & 7) * 8; const int row = r0 - 8 + rr; f32x4 a = {0.f, 0.f, 0.f, 0.f}, b = a;
            if (row >= seg0 && row < seg1) { const u32x4 w = *(const u32x4*)(U + (size_t)row * NIN + 1024 + g * 64 + c8); a = (f32x4){bflo(w.x), bfhi(w.x), bflo(w.y), bfhi(w.y)}; b = (f32x4){bflo(w.z), bfhi(w.z), bflo(w.w), bfhi(w.w)}; }
            *(LAS f32x4*)(ut + rr * 64 + c8) = a; *(LAS f32x4*)(ut + rr * 64 + c8 + 4) = b; }
        for (int i = tid; i < 4096; i += 512) wt[i] = PIN(31)[(size_t)(l * 4 + g) * 4096 + i];
        __syncthreads();
        { const int t = tid >> 3, c8 = (tid & 7) * 8; const int row = r0 + t;
          int lo = row - hw; if (lo < seg0) lo = seg0; int hi = row + hw; if (hi > seg1) hi = seg1; const float inv = 1.0f / (float)(hi - lo);
#pragma unroll
          for (int c = 0; c < 8; ++c) { float s = 0.f; for (int rr = lo; rr < hi; ++rr) s += ut[(rr - r0 + 8) * 64 + c8 + c]; pt[t * 65 + c8 + c] = s * inv - ut[(t + 8) * 64 + c8 + c]; } }
        __syncthreads();
        { const int t = tid >> 3, d8 = (tid & 7) * 8; float acc[8];
#pragma unroll
          for (int d = 0; d < 8; ++d) acc[d] = 0.f;
          for (int c = 0; c < 64; ++c) { const float pv = pt[t * 65 + c]; const f32x4 w0 = *(const LAS f32x4*)(wt + c * 64 + d8), w1 = *(const LAS f32x4*)(wt + c * 64 + d8 + 4);
              acc[0] += pv * w0[0]; acc[1] += pv * w0[1]; acc[2] += pv * w0[2]; acc[3] += pv * w0[3]; acc[4] += pv * w1[0]; acc[5] += pv * w1[1]; acc[6] += pv * w1[2]; acc[7] += pv * w1[3]; }
          const float* sc = PIN(32) + l * 256 + g * 64 + d8;
          u32x4 w; w.x = pk2(acc[0] * sc[0], acc[1] * sc[1]); w.y = pk2(acc[2] * sc[2], acc[3] * sc[3]); w.z = pk2(acc[4] * sc[4], acc[5] * sc[5]); w.w = pk2(acc[6] * sc[6], acc[7] * sc[7]);
          *(u32x4*)(MG + (size_t)(r0 + t) * 1024 + 512 + g * 64 + d8) = w; }
    }
    __syncthreads();
}
__device__ __forceinline__ void pb_shortconv(const int wave_s_, const P& p, int l, LAS unsigned char* lds) { unsigned char* const wsb = lndp(p.ws); const int tidx_ = tid_of(wave_s_); const int bidx_ = lnds((int)blockIdx.x);
    const int tid = tidx_;
    const bf16_t* U = (const bf16_t*)(wsb + WS_U); bf16_t* VXT = (bf16_t*)(wsb + WS_VXT);
    LAS float* ut = (LAS float*)lds;
    const float* cw = PIN(12) + (size_t)l * 3 * 768; const float* cb = PIN(13) + l * 768;
    for (int item = bidx_; item < 256 * 12; item += gridDim.x) {
        const int cbk = item % 12, t0 = (item / 12) * 64, c0 = cbk * 64;
        __syncthreads();
        for (int i = tid; i < 66 * 8; i += 512) { const int rr = i >> 3, c8 = (i & 7) * 8; const int t = t0 - 1 + rr; f32x4 a = {0.f, 0.f, 0.f, 0.f}, b = a;
            if (t >= 0 && t < LSEQ) { const u32x4 w = *(const u32x4*)(U + (size_t)(LCTX + t) * NIN + c0 + c8); a = (f32x4){bflo(w.x), bfhi(w.x), bflo(w.y), bfhi(w.y)}; b = (f32x4){bflo(w.z), bfhi(w.z), bflo(w.w), bfhi(w.w)}; }
            LAS float* d = ut + rr * 65 + c8; d[0] = a[0]; d[1] = a[1]; d[2] = a[2]; d[3] = a[3]; d[4] = b[0]; d[5] = b[1]; d[6] = b[2]; d[7] = b[3]; }
        __syncthreads();
        { const int c = tid >> 3, t8 = (tid & 7) * 8; const int col = c0 + c; const float w0 = cw[col], w1 = cw[768 + col], w2 = cw[1536 + col], b = cb[col]; float y[8];
#pragma unroll
          for (int i = 0; i < 8; ++i) y[i] = b + w0 * ut[(t8 + i) * 65 + c] + w1 * ut[(t8 + i + 1) * 65 + c] + w2 * ut[(t8 + i + 2) * 65 + c];
          u32x4 w; w.x = pk2(y[0], y[1]); w.y = pk2(y[2], y[3]); w.z = pk2(y[4], y[5]); w.w = pk2(y[6], y[7]);
          *(u32x4*)(VXT + (size_t)col * LSEQ + t0 + t8) = w; }
    }
    __syncthreads();
}
__device__ __forceinline__ void pa_ctxtaps(const int wave_s_, const P& p, int l) { unsigned char* const wsb = lndp(p.ws); const int tidx_ = tid_of(wave_s_); const int bidx_ = lnds((int)blockIdx.x);
    const float* H2C = (const float*)(wsb + WS_H2C); float* KCT = (float*)(wsb + WS_KCT);
    const float* w3 = PIN(18) + (size_t)l * 64 * 1024; const float* dec = PIN(19) + l * 1024;
    for (int idx = bidx_ * 512 + tidx_; idx < 2 * 256 * 256; idx += gridDim.x * 512) {
        const int ch = idx & 255, n = (idx >> 8) & 255, o = idx >> 16;
        float af = 0.f, ab = 0.f;
#pragma unroll 8
        for (int j = 0; j < 64; ++j) { const float hv = H2C[n * 64 + j]; af += hv * w3[j * 1024 + o * 512 + ch]; ab += hv * w3[j * 1024 + o * 512 + 256 + ch]; }
        const float t = (float)n * (1.0f / 256.0f);
        float* kc = KCT + (size_t)(o * 256 + ch) * 512;
        kc[255 + n] = af * expf(-t * __builtin_fabsf(dec[o * 512 + ch])); if (n < 255) kc[254 - n] = ab * expf(-t * __builtin_fabsf(dec[o * 512 + 256 + ch])); else kc[511] = 0.f;
    }
}
__device__ __forceinline__ void pb_ctxhyena(const int wave_s_, const P& p, int l, LAS unsigned char* lds) { unsigned char* const wsb = lndp(p.ws); const int tidx_ = tid_of(wave_s_); const int bidx_ = lnds((int)blockIdx.x);
    const int tid = tidx_;
    const bf16_t* U = (const bf16_t*)(wsb + WS_U); bf16_t* MG = (bf16_t*)(wsb + WS_MERGED); const float* KCT = (const float*)(wsb + WS_KCT);
    LAS float* zc = (LAS float*)lds; LAS float* x1c = zc + 256; LAS float* x2c = zc + 512; LAS float* kc = zc + 768; LAS float* part = zc + 1280;
    const float* cw = PIN(12) + (size_t)l * 3 * 768; const float* cb = PIN(13) + l * 768;
    for (int ch = (l + 1 < NLAYER ? bidx_ : 256); ch < 256; ch += gridDim.x) {
        __syncthreads();
        if (tid < 256) { const int t = tid;
#pragma unroll
            for (int s = 0; s < 3; ++s) { const int col = s * 256 + ch; const float w0 = cw[col], w1 = cw[768 + col], w2 = cw[1536 + col], b = cb[col];
                const float um = t > 0 ? bf1(U[(size_t)(t - 1) * NIN + col]) : 0.f, u0 = bf1(U[(size_t)t * NIN + col]), up = t < 255 ? bf1(U[(size_t)(t + 1) * NIN + col]) : 0.f;
                (s == 0 ? zc : s == 1 ? x1c : x2c)[t] = b + w0 * um + w1 * u0 + w2 * up; } }
        for (int o = 0; o < 2; ++o) {
            kc[tid] = KCT[(size_t)(o * 256 + ch) * 512 + tid];
            __syncthreads();
            const int t = tid & 255, s0 = (tid >> 8) * 128; float y = 0.f;
#pragma unroll 8
            for (int s = 0; s < 128; ++s) y += zc[s0 + s] * kc[255 + t - s0 - s];
            part[tid] = y;
            __syncthreads();
            float zn = 0.f;
            if (tid < 256) zn = (o == 0 ? x1c[t] : x2c[t]) * (part[t] + part[256 + t] + PIN(20)[(l * 2 + o) * 256 + ch] * zc[t]);
            __syncthreads();
            if (tid < 256) zc[t] = zn;
            __syncthreads();
        }
        if (tid < 256) MG[(size_t)tid * 1024 + ch] = (bf16_t)f2bf(zc[tid]);
    }
    __syncthreads();
}

__device__ __forceinline__ void pc_s5carry(const int wave_s_, const P& p, LAS unsigned char* lds) { unsigned char* const wsb = lndp(p.ws); const int tidx_ = tid_of(wave_s_); const int bidx_ = lnds((int)blockIdx.x);
    const float* SC = (const float*)(wsb + WS_SC); float* HIN = (float*)(wsb + WS_HIN); const float* lamT = (const float*)(wsb + WS_LAMT);
    LAS f32x2* ex = (LAS f32x2*)lds;
    const int pl = tidx_ & 31, seg = tidx_ >> 5;
    for (int wb = bidx_; wb < 64; wb += gridDim.x) {
        const int chain = wb * 32 + pl, dg = chain >> 6, pp = chain & 63, dir = dg >> 4;
        const f32x2 lam = {lamT[dg * 128 + pp], lamT[dg * 128 + 64 + pp]};
        const float* sb = SC + (size_t)dg * NCH * 128 + pp; float* hb = HIN + (size_t)dg * NCH * 128 + pp;
        f32x2 h = {0.f, 0.f};
        for (int b0 = 0; b0 < 65; b0 += 13) {
            f32x2 sv[13];
#pragma unroll
            for (int j = 0; j < 13; ++j) { const int q = seg * 65 + b0 + j; const int c = dir == 0 ? q : (q < 16 ? 15 - q : NCH + 15 - q); sv[j] = (f32x2){sb[(size_t)c * 128], sb[(size_t)c * 128 + 64]}; }
#pragma unroll
            for (int j = 0; j < 13; ++j) h = cmul(lam, h) + sv[j];
        }
        __syncthreads();
        ex[seg * 32 + pl] = h;
        __syncthreads();
        f32x2 l65 = {1.f, 0.f};
        for (int k = 0; k < 65; ++k) l65 = cmul(l65, lam);
        f32x2 cin = {0.f, 0.f};
        for (int s2 = 0; s2 < seg; ++s2) cin = cmul(l65, cin) + ex[s2 * 32 + pl];
        h = cin;
        for (int b0 = 0; b0 < 65; b0 += 13) {
            f32x2 sv[13]; int cidx[13];
#pragma unroll
            for (int j = 0; j < 13; ++j) { const int q = seg * 65 + b0 + j; const int c = dir == 0 ? q : (q < 16 ? 15 - q : NCH + 15 - q); cidx[j] = c; sv[j] = (f32x2){sb[(size_t)c * 128], sb[(size_t)c * 128 + 64]}; }
#pragma unroll
            for (int j = 0; j < 13; ++j) { hb[(size_t)cidx[j] * 128] = h.x; hb[(size_t)cidx[j] * 128 + 64] = h.y; h = cmul(lam, h) + sv[j]; }
        }
    }
    __syncthreads();
}
namespace attn_body {
using bf16=unsigned short;
using bf16x8=__attribute__((ext_vector_type(8)))short;
using s16x4=__attribute__((ext_vector_type(4)))short;
using f32x16=__attribute__((ext_vector_type(16)))float;
using u32x4=__attribute__((ext_vector_type(4)))unsigned;
constexpr int D=64, QP=256, KP=128, VP=1792, OP=1024;
constexpr int NW=8,QBLK=32,QB=QBLK*NW,KVBLK=64;
constexpr int ATTN_UNIT_ROWS=QB;
__device__ __forceinline__ int crow(int r,int hi){return (r&3)+8*(r>>2)+4*hi;}
#define SBAR() __builtin_amdgcn_sched_barrier(0)
__device__ __forceinline__ void cmask(f32x16&p0,f32x16&p1,int jb,int qrel,int hi){
  const float NEG=-INFINITY; int kb=64*jb+4*hi;
  #pragma unroll
  for(int r=0;r<16;++r){int kv=kb+(r&3)+8*(r>>2); if(kv>qrel)p0[r]=NEG; if(kv+32>qrel)p1[r]=NEG;}
}

constexpr int NSLOT=3, SLOTB=8192;
constexpr int LDS_K=0, LDS_V=NSLOT*SLOTB, LDS_WS=2*NSLOT*SLOTB, LDS_OST=LDS_WS+NW*64*4, LDS_BYTES=LDS_OST+NW*4096;
constexpr float C2=0.125f*1.4426950408889634f;
__device__ __forceinline__ void glds16(const void*gsrc,unsigned lds_dst){unsigned keep;
  asm volatile("s_mov_b32 %0, m0\n\ts_mov_b32 m0, %2\n\ts_nop 0\n\tglobal_load_lds_dwordx4 %1, off\n\ts_mov_b32 m0, %0":"=&s"(keep):"v"(gsrc),"s"(lds_dst):"memory");}
__device__ __forceinline__ float max3f(float a,float b,float c){float r;asm("v_max3_f32 %0, %1, %2, %3":"=v"(r):"v"(a),"v"(b),"v"(c));return r;}
__device__ __forceinline__ float max2f(float a,float b){float r;asm("v_max_f32_e32 %0, %1, %2":"=v"(r):"v"(a),"v"(b));return r;}
__device__ __forceinline__ float fadd_s(float a,float b){float r;asm("v_add_f32_e32 %0, %1, %2":"=v"(r):"v"(a),"v"(b));return r;}
__device__ __forceinline__ float fsub_s(float a,float b){float r;asm("v_sub_f32_e32 %0, %1, %2":"=v"(r):"v"(a),"v"(b));return r;}
typedef float f32x2_t __attribute__((ext_vector_type(2))); typedef __bf16 bf16x2_t __attribute__((ext_vector_type(2)));
__device__ __forceinline__ unsigned cvtpk_s(float lo,float hi){f32x2_t v={lo,hi};bf16x2_t b=__builtin_convertvector(v,bf16x2_t);return __builtin_bit_cast(unsigned,b);}
#define WAIT_BAR(N) asm volatile("s_waitcnt vmcnt(" #N ") lgkmcnt(0)\n\ts_barrier":::"memory")

__device__ __forceinline__ void qkt(f32x16&p0,f32x16&p1,const char*Kslot,const bf16x8*qr,const f32x16&negm,int r32,int hi){
  const char*kb=Kslot+hi*1024+r32*16;
  #pragma unroll
  for(int d0=0;d0<4;++d0){
    const bf16x8 b0=*reinterpret_cast<const bf16x8*>(kb+d0*2048);
    const bf16x8 b1=*reinterpret_cast<const bf16x8*>(kb+d0*2048+512);
    if(d0==0){p0=__builtin_amdgcn_mfma_f32_32x32x16_bf16(b0,qr[0],negm,0,0,0);p1=__builtin_amdgcn_mfma_f32_32x32x16_bf16(b1,qr[0],negm,0,0,0);}
    else{p0=__builtin_amdgcn_mfma_f32_32x32x16_bf16(b0,qr[d0],p0,0,0,0);p1=__builtin_amdgcn_mfma_f32_32x32x16_bf16(b1,qr[d0],p1,0,0,0);}}
}
typedef __attribute__((address_space(3))) const char* lds_cptr;
typedef short v4i16_t __attribute__((ext_vector_type(4)));
__device__ __forceinline__ void kload8(bf16x8*kf,lds_cptr kp){
  kf[0]=*(const __attribute__((address_space(3))) bf16x8*)(kp);      kf[1]=*(const __attribute__((address_space(3))) bf16x8*)(kp+512);
  kf[2]=*(const __attribute__((address_space(3))) bf16x8*)(kp+2048); kf[3]=*(const __attribute__((address_space(3))) bf16x8*)(kp+2560);
  kf[4]=*(const __attribute__((address_space(3))) bf16x8*)(kp+4096); kf[5]=*(const __attribute__((address_space(3))) bf16x8*)(kp+4608);
  kf[6]=*(const __attribute__((address_space(3))) bf16x8*)(kp+6144); kf[7]=*(const __attribute__((address_space(3))) bf16x8*)(kp+6656);
}
__device__ __forceinline__ void kload2(bf16x8*kf,lds_cptr kp,int j){ kf[2*j]=*(const __attribute__((address_space(3))) bf16x8*)(kp+j*2048); kf[2*j+1]=*(const __attribute__((address_space(3))) bf16x8*)(kp+j*2048+512); }
__device__ __forceinline__ s16x4 vtr(lds_cptr p){ return __builtin_bit_cast(s16x4,__builtin_amdgcn_ds_read_tr16_b64_v4i16((__attribute__((address_space(3))) v4i16_t*)p)); }
__device__ __forceinline__ float rowmax(const f32x16&p0,const f32x16&p1){
  float a=max3f(p0[0],p0[1],p1[0]),b=max3f(p0[2],p0[3],p1[1]);a=max3f(a,p1[2],p1[3]);
  #pragma unroll
  for(int r=4;r<16;r+=4){a=max3f(a,p0[r],p0[r+1]);b=max3f(b,p0[r+2],p0[r+3]);a=max3f(a,p1[r],p1[r+1]);b=max3f(b,p1[r+2],p1[r+3]);}
  const float m=max2f(a,b);
  auto rr=__builtin_amdgcn_permlane32_swap(__float_as_uint(m),__float_as_uint(m),false,false);
  return max2f(__uint_as_float(rr[0]),__uint_as_float(rr[1]));
}
__device__ __forceinline__ void pv(f32x16*o,int vb,bf16x8 pa0,bf16x8 pa1,bf16x8 pa2,bf16x8 pa3){
  #pragma unroll
  for(int d0=0;d0<2;++d0){s16x4 lo[4],hi[4];
    #pragma unroll
    for(int ks=0;ks<4;++ks){
      asm volatile("ds_read_b64_tr_b16 %0,%1 offset:%c2":"=&v"(lo[ks]):"v"(vb),"i"(d0*4096+ks*1024):"memory");
      asm volatile("ds_read_b64_tr_b16 %0,%1 offset:%c2":"=&v"(hi[ks]):"v"(vb),"i"(d0*4096+ks*1024+512):"memory");}
    asm volatile("s_waitcnt lgkmcnt(0)":::"memory");SBAR();
    #define PK(k) (bf16x8){lo[k][0],lo[k][1],lo[k][2],lo[k][3],hi[k][0],hi[k][1],hi[k][2],hi[k][3]}
    o[d0]=__builtin_amdgcn_mfma_f32_32x32x16_bf16(pa0,PK(0),o[d0],0,0,0);
    o[d0]=__builtin_amdgcn_mfma_f32_32x32x16_bf16(pa1,PK(1),o[d0],0,0,0);
    o[d0]=__builtin_amdgcn_mfma_f32_32x32x16_bf16(pa2,PK(2),o[d0],0,0,0);
    o[d0]=__builtin_amdgcn_mfma_f32_32x32x16_bf16(pa3,PK(3),o[d0],0,0,0);
    #undef PK
  }
}

#ifndef ATTN_STORE16
#define ATTN_STORE16(p,v) (*(u32x4*)(p)=(v))
#endif
template<int THRL> __device__ __forceinline__ void attn_unit(const int tid,const int qrow0,const int NT,const bf16*Q,const bf16*__restrict__ K,const bf16*__restrict__ V,bf16*O,char*shm){
  const int lane=tid&63,r32=lane&31,hi=lane>>5; const int wid=__builtin_amdgcn_readfirstlane(tid>>6);
  const bf16*Qw=Q+(long)(qrow0+wid*QBLK)*QP;
  const bf16*Kh=K,*Vh=V;
  const unsigned lds0=(unsigned)(uintptr_t)shm;
  float*wsf=(float*)(shm+LDS_WS)+wid*64;
  const bf16*ksrc=Kh+(long)lane*KP+wid*8;
  const bf16*vsrc=Vh+(long)(16*(wid&3)+(lane>>2))*VP+(wid>>2)*32+(lane&3)*8;
  const unsigned kdst=lds0+LDS_K+wid*1024, vdst=lds0+LDS_V+wid*1024;
  #define DMA_K(t,slot) glds16(ksrc+(long)(t)*KVBLK*KP,(unsigned)__builtin_amdgcn_readfirstlane(kdst+(slot)))
  #define DMA_V(t,slot) glds16(vsrc+(long)(t)*KVBLK*VP,(unsigned)__builtin_amdgcn_readfirstlane(vdst+(slot)))
  const int vb0=(int)(lds0+LDS_V)+((lane>>4)&1)*32+(lane&3)*8+(4*hi+((lane&15)>>2))*64;
  const char*Kbase=shm+LDS_K; bf16x8 kf[8];
  const lds_cptr shm3=(lds_cptr)shm; const lds_cptr kp0=shm3+LDS_K+hi*1024+r32*16; const lds_cptr vp0=shm3+LDS_V+((lane>>4)&1)*32+(lane&3)*8+(4*hi+((lane&15)>>2))*64;
  DMA_K(0,0);DMA_V(0,0);DMA_K(1,SLOTB);
  bf16x8 qr[4];
  #pragma unroll
  for(int d0=0;d0<4;++d0)qr[d0]=*reinterpret_cast<const bf16x8*>(&Qw[(long)r32*QP+d0*16+hi*8]);
  float mhat=0.f,l_reg=0.f;f32x16 o[2];o[0]=f32x16{};o[1]=f32x16{};f32x16 negm=f32x16{};asm volatile("":"+v"(negm));
  #define CMASK(P0,P1,t) do{}while(0)
  bool resc=false;
  #define START(P0,P1) do{ const float rm=rowmax(P0,P1); resc=false; \
    { const float dl=rm; mhat=fadd_s(mhat,dl); \
      _Pragma("unroll") for(int r=0;r<16;++r){P0[r]=fsub_s(P0[r],dl);P1[r]=fsub_s(P1[r],dl);} \
      _Pragma("unroll") for(int r=0;r<16;++r)negm[r]=-mhat; asm volatile("":"+v"(negm)); } \
    _Pragma("unroll") for(int r=0;r<16;++r)P0[r]=__builtin_amdgcn_exp2f(P0[r]); }while(0)
  #define RESC() do{ if(resc){ asm volatile("s_waitcnt lgkmcnt(0)":::"memory"); \
      _Pragma("unroll") for(int d_=0;d_<2;++d_) _Pragma("unroll") for(int r=0;r<16;++r)o[d_][r]*=wsf[crow(r,hi)]; } }while(0)
  f32x16 pA0,pA1,pB0,pB1;
  int sl_prev=0,sl_cur=0,sl_next=SLOTB;
  #define ROT() do{sl_prev=sl_cur;sl_cur=sl_next;sl_next=(sl_next==(NSLOT-1)*SLOTB)?0:sl_next+SLOTB;}while(0)
  DMA_K(2,2*SLOTB);
  WAIT_BAR(3);
  qkt(pA0,pA1,Kbase,qr,negm,r32,hi);asm volatile("s_nop 15\n\ts_nop 7":"+v"(pA0),"+v"(pA1));CMASK(pA0,pA1,0);
  START(pA0,pA1);
  _Pragma("unroll") for(int r=0;r<16;++r)pA1[r]=__builtin_amdgcn_exp2f(pA1[r]);
  WAIT_BAR(0);
  DMA_K(3,0);DMA_V(1,SLOTB);
  ROT();
  kload8(kf,kp0+sl_cur);
  WAIT_BAR(2);
  s16x4 vlo[8],vhi[8]; u32x4 pw0,pw1,pw2,pw3;
  #define PKW(P,B) cvtpk_s(P[B],P[B+1])
  #define PAF(k) __builtin_bit_cast(bf16x8,pw##k)
  #define VFR(i) (bf16x8){vlo[i][0],vlo[i][1],vlo[i][2],vlo[i][3],vhi[i][0],vhi[i][1],vhi[i][2],vhi[i][3]}
  #define APIN(x) asm volatile("":"+v"(x))
  #define MX3(a,b,c) __builtin_fmaxf(__builtin_fmaxf((a),(b)),(c))
  #define GAPA(MF,A0,A1,A2,A3,W0,W1,PW) do{ MF; sacc+=A0; sacc+=A1; sacc+=A2; sacc+=A3; APIN(sacc); W0; W1; APIN(PW); SBAR(); }while(0)
  #define EX(v) __builtin_amdgcn_exp2f(v)
  #define GAPB(MF,X,B) do{ MF; X[B]=EX(X[B]); X[B+1]=EX(X[B+1]); X[B+2]=EX(X[B+2]); X[B+3]=EX(X[B+3]); APIN(X); SBAR(); }while(0)
  #define VRD(i) do{ vlo[i]=vtr(vp_+(((i)>>2)*4096+((i)&3)*1024)); vhi[i]=vtr(vp_+(((i)>>2)*4096+((i)&3)*1024+512)); }while(0)
  #define KRD(G,j) do{ if(G){ kload2(kf,kp0+sl_next,j); SBAR(); } }while(0)
  #define STEP(C0,C1,P0,P1,t,GK,GV,GL) do{ SBAR(); \
    const lds_cptr vp_=vp0+sl_prev; \
    VRD(0); SBAR(); float sacc=(P0[0]+P0[1]); \
    GAPA(C0=__builtin_amdgcn_mfma_f32_32x32x16_bf16(kf[0],qr[0],negm,0,0,0), P0[2],P0[3],P0[4],P0[5],     pw0[0]=PKW(P0,0), pw0[1]=PKW(P0,2), pw0); \
    VRD(4); SBAR(); GAPA(C1=__builtin_amdgcn_mfma_f32_32x32x16_bf16(kf[1],qr[0],negm,0,0,0), P0[6],P0[7],P0[8],P0[9],     pw0[2]=PKW(P0,4), pw0[3]=PKW(P0,6), pw0); \
    VRD(1); SBAR(); GAPA(C0=__builtin_amdgcn_mfma_f32_32x32x16_bf16(kf[2],qr[1],C0,0,0,0),   P0[10],P0[11],P0[12],P0[13], pw1[0]=PKW(P0,8), pw1[1]=PKW(P0,10), pw1); \
    VRD(5); SBAR(); GAPA(C1=__builtin_amdgcn_mfma_f32_32x32x16_bf16(kf[3],qr[1],C1,0,0,0),   P0[14],P0[15],P1[0],P1[1],   pw1[2]=PKW(P0,12),pw1[3]=PKW(P0,14), pw1); \
    VRD(2); SBAR(); GAPA(C0=__builtin_amdgcn_mfma_f32_32x32x16_bf16(kf[4],qr[2],C0,0,0,0),   P1[2],P1[3],P1[4],P1[5],     pw2[0]=PKW(P1,0), pw2[1]=PKW(P1,2), pw2); \
    VRD(6); SBAR(); GAPA(C1=__builtin_amdgcn_mfma_f32_32x32x16_bf16(kf[5],qr[2],C1,0,0,0),   P1[6],P1[7],P1[8],P1[9],     pw2[2]=PKW(P1,4), pw2[3]=PKW(P1,6), pw2); \
    VRD(3); SBAR(); GAPA(C0=__builtin_amdgcn_mfma_f32_32x32x16_bf16(kf[6],qr[3],C0,0,0,0),   P1[10],P1[11],P1[12],P1[13], pw3[0]=PKW(P1,8), pw3[1]=PKW(P1,10), pw3); \
    VRD(7); SBAR(); GAPA(C1=__builtin_amdgcn_mfma_f32_32x32x16_bf16(kf[7],qr[3],C1,0,0,0),   P1[14],P1[15],0.f,0.f,       pw3[2]=PKW(P1,12),pw3[3]=PKW(P1,14), pw3); \
    l_reg+=sacc; \
    if(GK){DMA_K((t)+3,sl_cur);} if(GV){DMA_V((t)+1,sl_next);} \
    CMASK(C0,C1,t); \
    { float a=MX3(C0[0],C0[1],C1[0]),b=MX3(C0[2],C0[3],C1[1]); a=MX3(a,C1[2],C1[3]); \
      _Pragma("unroll") for(int r=4;r<16;r+=4){a=MX3(a,C0[r],C0[r+1]);b=MX3(b,C0[r+2],C0[r+3]);a=MX3(a,C1[r],C1[r+1]);b=MX3(b,C1[r+2],C1[r+3]);} \
      float rm=__builtin_fmaxf(a,b); { auto rr=__builtin_amdgcn_permlane32_swap(__float_as_uint(rm),__float_as_uint(rm),false,false); rm=__builtin_fmaxf(__uint_as_float(rr[0]),__uint_as_float(rr[1])); } \
      resc=false; \
      if(__builtin_expect(__any(rm>(float)THRL),0)){ const float dl=__builtin_fmaxf(rm,0.f); mhat+=dl; \
        _Pragma("unroll") for(int r=0;r<16;++r){C0[r]-=dl;C1[r]-=dl;} \
        _Pragma("unroll") for(int r=0;r<16;++r)negm[r]=-mhat; asm volatile("":"+v"(negm)); \
        const float f=__builtin_amdgcn_exp2f(-dl); l_reg*=f; if(hi==0)wsf[r32]=f; resc=true; } } \
    SBAR(); \
    GAPB(o[0]=__builtin_amdgcn_mfma_f32_32x32x16_bf16(PAF(0),VFR(0),o[0],0,0,0), C0,0); \
    GAPB(o[1]=__builtin_amdgcn_mfma_f32_32x32x16_bf16(PAF(0),VFR(4),o[1],0,0,0), C0,4); \
    KRD(GL,0); GAPB(o[0]=__builtin_amdgcn_mfma_f32_32x32x16_bf16(PAF(1),VFR(1),o[0],0,0,0), C0,8); \
    KRD(GL,1); GAPB(o[1]=__builtin_amdgcn_mfma_f32_32x32x16_bf16(PAF(1),VFR(5),o[1],0,0,0), C0,12); \
    KRD(GL,2); GAPB(o[0]=__builtin_amdgcn_mfma_f32_32x32x16_bf16(PAF(2),VFR(2),o[0],0,0,0), C1,0); \
    KRD(GL,3); GAPB(o[1]=__builtin_amdgcn_mfma_f32_32x32x16_bf16(PAF(2),VFR(6),o[1],0,0,0), C1,4); \
    GAPB(o[0]=__builtin_amdgcn_mfma_f32_32x32x16_bf16(PAF(3),VFR(3),o[0],0,0,0), C1,8); \
    GAPB(o[1]=__builtin_amdgcn_mfma_f32_32x32x16_bf16(PAF(3),VFR(7),o[1],0,0,0), C1,12); \
    }while(0)
  int t=1;
  #undef CMASK
  #define CMASK(P0,P1,t) do{}while(0)
  for(;t+5<NT;t+=2){
    STEP(pB0,pB1,pA0,pA1,t,true,true,true);     WAIT_BAR(2); RESC(); ROT();
    STEP(pA0,pA1,pB0,pB1,t+1,true,true,true);   WAIT_BAR(2); RESC(); ROT();
  }
  #undef CMASK
  #define CMASK(P0,P1,t) do{}while(0)
  #define ENDW(tt) do{ if((tt)+3<NT){WAIT_BAR(2);} else if((tt)+2<NT){WAIT_BAR(1);} else {WAIT_BAR(0);} }while(0)
  for(;t+1<NT;t+=2){
    STEP(pB0,pB1,pA0,pA1,t,(t+3<NT),(t+1<NT),(t+1<NT));       ENDW(t);   RESC(); ROT();
    STEP(pA0,pA1,pB0,pB1,t+1,(t+4<NT),(t+2<NT),(t+2<NT));     ENDW(t+1); RESC(); ROT();
  }
  STEP(pB0,pB1,pA0,pA1,NT-1,false,false,false); RESC();
  { float sacc=pB0[0]+pB0[1]; _Pragma("unroll") for(int r=2;r<16;++r)sacc+=pB0[r]; _Pragma("unroll") for(int r=0;r<16;++r)sacc+=pB1[r]; l_reg+=sacc;
    pw0=(u32x4){PKW(pB0,0),PKW(pB0,2),PKW(pB0,4),PKW(pB0,6)};pw1=(u32x4){PKW(pB0,8),PKW(pB0,10),PKW(pB0,12),PKW(pB0,14)};pw2=(u32x4){PKW(pB1,0),PKW(pB1,2),PKW(pB1,4),PKW(pB1,6)};pw3=(u32x4){PKW(pB1,8),PKW(pB1,10),PKW(pB1,12),PKW(pB1,14)};
    SBAR(); pv(o,vb0+sl_cur,PAF(0),PAF(1),PAF(2),PAF(3)); }
  #undef PKW
  #undef PAF
  #undef VFR
  #undef APIN
  #undef MX3
  #undef GAPA
  #undef GAPB
  #undef EX
  #undef VRD
  #undef KRD
  #undef STEP
  #undef ENDW
  {auto rr=__builtin_amdgcn_permlane32_swap(__float_as_uint(l_reg),__float_as_uint(l_reg),false,false);l_reg=__uint_as_float(rr[0])+__uint_as_float(rr[1]);}
  if(hi==0)wsf[32+r32]=l_reg;asm volatile("s_waitcnt lgkmcnt(0)":::"memory");
  float rli[16];
  #pragma unroll
  for(int r=0;r<16;++r)rli[r]=__builtin_amdgcn_rcpf(wsf[32+crow(r,hi)]);
  bf16*Ow=O+(long)(qrow0+wid*QBLK)*OP;
  { bf16*stg=(bf16*)(shm+LDS_OST)+wid*2048;
    #pragma unroll
    for(int r=0;r<16;++r){const int orow=crow(r,hi);
      #pragma unroll
      for(int d0=0;d0<2;++d0)stg[orow*64+d0*32+r32]=(bf16)::f2bf(o[d0][r]*rli[r]);}
    asm volatile("s_waitcnt lgkmcnt(0)":::"memory");
    #pragma unroll
    for(int i=0;i<4;++i){const int row=i*8+(lane>>3),ch=lane&7; const u32x4 v=*(const u32x4*)(stg+row*64+ch*8); ATTN_STORE16(Ow+(long)row*OP+ch*8,v);} }
  asm volatile("s_waitcnt lgkmcnt(0)\n\ts_barrier":::"memory");
  #undef DMA_K
  #undef DMA_V
  #undef CMASK
  #undef START
  #undef RESC
  #undef ROT
}
constexpr int ATTN_LDS_BYTES=LDS_BYTES;
#undef SBAR
#undef WAIT_BAR
}

__device__ __forceinline__ void pc_attention(const int wave_s_, const P& p, int l, char* ldsg) { unsigned char* const wsb = lndp(p.ws); const int tidx_ = tid_of(wave_s_); const int bidx_ = lnds((int)blockIdx.x);
    const unsigned short* U = (const unsigned short*)(wsb + WS_U); const unsigned short* QN = (const unsigned short*)(wsb + WS_QN); const unsigned short* KN = (const unsigned short*)(wsb + WS_KN); unsigned short* MG = (unsigned short*)(wsb + WS_MERGED);
    const int nunit = l + 1 < NLAYER ? 260 : 256;
    __syncthreads();
    for (int unit = bidx_; unit < nunit; unit += gridDim.x) {
        int hq, qrow0, nt; if (unit < 256) { hq = unit & 3; qrow0 = LCTX + 256 * (unit >> 2); nt = R / 64; } else { hq = unit - 256; qrow0 = 0; nt = LCTX / 64; }
        const int kh = hq >> 1;
        attn_body::attn_unit<8>(tidx_, qrow0, nt, QN + hq * 64, KN + kh * 64, U + 1664 + kh * 64, MG + 768 + hq * 64, ldsg);
    }
    __syncthreads();
}
#define FIDX(i) ((i) ^ ((((i) >> 5) & 3) * 5) ^ ((((i) >> 6) & 1) << 4))
constexpr int FFT_BUF_BYTES = NFFT * 8, FFT_WHI_OFF = FFT_BUF_BYTES, FFT_WLO_OFF = FFT_WHI_OFF + 128 * 8;
__device__ __forceinline__ f32x2 fft_tw(const LAS f32x2* whi, const LAS f32x2* wlo, int t) { return cmul(whi[t >> 6], wlo[t & 63]); }
#define FFT_IDX4(i0, lq, q, x0, x1, x2, x3) int x0 = FIDX(i0), x1, x2, x3; \
    if ((lq) >= 7) { x1 = x0 + (q); x2 = x0 + 2 * (q); x3 = x0 + 3 * (q); } \
    else if ((lq) == 6) { x1 = FIDX((i0) + 64); x2 = x0 + 128; x3 = x1 + 128; } \
    else { x1 = FIDX((i0) + (q)); x2 = FIDX((i0) + 2 * (q)); x3 = FIDX((i0) + 3 * (q)); }
__device__ __forceinline__ void fft_fwd(LAS f32x2* buf, const LAS f32x2* whi, const LAS f32x2* wlo, int tid) {
#pragma unroll
    for (int s = 0; s < 7; ++s) {
        const int lq = 12 - 2 * s, q = 1 << lq;
        __syncthreads();
#pragma unroll 4
        for (int i = 0; i < 8; ++i) { const int id = tid + 512 * i; const int j = id & (q - 1), blk = id >> lq; const int i0 = (blk << (lq + 2)) + j;
            FFT_IDX4(i0, lq, q, x0, x1, x2, x3)
            const f32x2 a0 = buf[x0], a1 = buf[x1], a2 = buf[x2], a3 = buf[x3];
            const f32x2 w1 = fft_tw(whi, wlo, j << (2 * s)); const f32x2 w2 = cmul(w1, w1);
            const f32x2 b0 = a0 + a2, b2 = cmul(a0 - a2, w1), b1 = a1 + a3; const f32x2 t3 = cmul(a1 - a3, w1); const f32x2 b3 = {t3.y, -t3.x};
            buf[x0] = b0 + b1; buf[x1] = cmul(b0 - b1, w2); buf[x2] = b2 + b3; buf[x3] = cmul(b2 - b3, w2); }
    }
    __syncthreads();
}
__device__ __forceinline__ void fft_inv(LAS f32x2* buf, const LAS f32x2* whi, const LAS f32x2* wlo, int tid) {
#pragma unroll
    for (int s = 6; s >= 0; --s) {
        const int lq = 12 - 2 * s, q = 1 << lq;
        __syncthreads();
#pragma unroll 4
        for (int i = 0; i < 8; ++i) { const int id = tid + 512 * i; const int j = id & (q - 1), blk = id >> lq; const int i0 = (blk << (lq + 2)) + j;
            FFT_IDX4(i0, lq, q, x0, x1, x2, x3)
            const f32x2 c0 = buf[x0], c1 = buf[x1], c2 = buf[x2], c3 = buf[x3];
            const f32x2 w1 = fft_tw(whi, wlo, j << (2 * s)); const f32x2 w2 = cmul(w1, w1);
            const f32x2 t1 = cmulc(c1, w2), t3 = cmulc(c3, w2);
            const f32x2 b0 = c0 + t1, b1 = c0 - t1, b2 = c2 + t3, b3 = c2 - t3;
            const f32x2 u2 = cmulc(b2, w1); const f32x2 u3c = cmulc(b3, w1); const f32x2 u3 = {-u3c.y, u3c.x};
            buf[x0] = b0 + u2; buf[x2] = b0 - u2; buf[x1] = b1 + u3; buf[x3] = b1 - u3; }
    }
    __syncthreads();
}
__device__ __forceinline__ int brev14(int k) { return (int)(__builtin_bitreverse32((unsigned)k) >> 18); }
__device__ __forceinline__ void pc_hyena(const int wave_s_, const P& p, int l, LAS unsigned char* lds) { unsigned char* const wsb = lndp(p.ws); const int tidx_ = tid_of(wave_s_); const int bidx_ = lnds((int)blockIdx.x);
    const int tid = tidx_;
    LAS f32x2* buf = (LAS f32x2*)lds; LAS f32x2* whi = (LAS f32x2*)(lds + FFT_WHI_OFF); LAS f32x2* wlo = (LAS f32x2*)(lds + FFT_WLO_OFF);
    const f32x2* tw = (const f32x2*)(wsb + WS_TW);
    __syncthreads();
    if (tid < 128) whi[tid] = tw[tid * 64]; else if (tid < 192) wlo[tid - 128] = tw[tid - 128];
    const bf16_t* VXT = (const bf16_t*)(wsb + WS_VXT); float* Z1 = (float*)(wsb + WS_Z1); bf16_t* Z2T = (bf16_t*)(wsb + WS_Z2T);
    for (int ch = bidx_; ch < 256; ch += gridDim.x) {
        for (int o = 0; o < 2; ++o) {
            float* filt = (float*)(wsb + WS_FILT) + (size_t)(ch * 2 + o) * 2 * LSEQ;
            const float* hf = filt; const float* hb = filt + LSEQ;
            __syncthreads();
            for (int m = tid; m < NFFT; m += 512) { f32x2 v;
                if (m < NFFT / 2) v = *(const f32x2*)(hf + 2 * m);
                else { const int r = 2 * LSEQ - 2 * m - 2; const f32x2 t = *(const f32x2*)(hb + r); v = (f32x2){m == NFFT / 2 ? 0.f : t.y, t.x}; }
                buf[FIDX(m)] = v; }
            fft_fwd(buf, whi, wlo, tid);
            f32x4* ksp = (f32x4*)filt;
            const float sc = 1.0f / (float)NFFT;
            for (int ph2 = tid; ph2 < NFFT / 2; ph2 += 512) {
                if (ph2 == 0) { const f32x2 a = buf[0], b = buf[1]; ksp[0] = (f32x4){a.x * sc, a.y * sc, b.x * sc, b.y * sc}; }
                else { const int k = brev14(2 * ph2); const int q1 = 2 * ph2, q2 = brev14(NFFT - k); const f32x2 A = buf[FIDX(q1)], B = cconj(buf[FIDX(q2)]);
                    const f32x2 E = (A + B) * (0.5f * sc), D = (A - B) * (0.5f * sc); ksp[ph2] = (f32x4){E.x, E.y, D.y, -D.x}; }
            }
            __syncthreads();
            const bf16_t* zb = VXT + (size_t)ch * LSEQ; const float* z1 = Z1 + (size_t)ch * LSEQ;
            for (int m = tid; m < NFFT; m += 512) { f32x2 v = {0.f, 0.f};
                if (m < NFFT / 2) { if (o == 0) { const unsigned w = *(const unsigned*)(zb + 2 * m); v = (f32x2){bflo(w), bfhi(w)}; } else v = *(const f32x2*)(z1 + 2 * m); }
                buf[FIDX(m)] = v; }
            fft_fwd(buf, whi, wlo, tid);
            for (int ph2 = tid; ph2 < NFFT / 2; ph2 += 512) {
                const f32x4 ks = ksp[ph2];
                if (ph2 == 0) { const f32x2 a = buf[0], b = buf[1];
                    buf[0] = (f32x2){a.x * ks[0] + a.y * ks[1], a.x * ks[1] + a.y * ks[0]};
                    buf[1] = (f32x2){b.x * ks[2] - b.y * ks[3], b.x * ks[3] + b.y * ks[2]}; }
                else { const int k = brev14(2 * ph2); const int p1 = FIDX(2 * ph2), p2 = FIDX(brev14(NFFT - k)); const f32x2 A = buf[p1], B = cconj(buf[p2]);
                    const f32x2 Ez = (A + B) * 0.5f, Dz = (A - B) * 0.5f; const f32x2 Oz = {Dz.y, -Dz.x};
                    const f32x2 Ek = {ks[0], ks[1]}, Ok = {ks[2], ks[3]};
                    const f32x2 Ey = cmul(Ez, Ek) + cmul(fft_tw(whi, wlo, k), cmul(Oz, Ok)); const f32x2 Oy = cmul(Ez, Ok) + cmul(Oz, Ek);
                    buf[p1] = (f32x2){Ey.x - Oy.y, Ey.y + Oy.x};
                    buf[p2] = (f32x2){Ey.x + Oy.y, Oy.x - Ey.y}; }
            }
            fft_inv(buf, whi, wlo, tid);
            const float fb = PIN(20)[(l * 2 + o) * 256 + ch];
            const bf16_t* gt = VXT + (size_t)((o + 1) * 256 + ch) * LSEQ;
            for (int m = tid; m < NFFT / 2; m += 512) { const f32x2 y = buf[FIDX(m)]; f32x2 zp;
                if (o == 0) { const unsigned w = *(const unsigned*)(zb + 2 * m); zp = (f32x2){bflo(w), bfhi(w)}; } else zp = *(const f32x2*)(z1 + 2 * m);
                const unsigned gw = *(const unsigned*)(gt + 2 * m);
                const f32x2 zn = {bflo(gw) * (y.x + fb * zp.x), bfhi(gw) * (y.y + fb * zp.y)};
                if (o == 0) *(f32x2*)(Z1 + (size_t)ch * LSEQ + 2 * m) = zn; else *(unsigned*)(Z2T + (size_t)ch * LSEQ + 2 * m) = pk2(zn.x, zn.y); }
            __syncthreads();
        }
    }
}

__device__ __forceinline__ float gelu_tanh(float x) { const float u = 0.7978845608028654f * (x + 0.044715f * x * x * x); return 0.5f * x * (1.0f + tanhf(u)); }
template <int NT> __device__ __forceinline__ void s5out_item(unsigned char* wsb, int g, int ct, int n0, int lane) {
    const bf16_t* U = (const bf16_t*)(wsb + WS_U); const float* HIN = (const float*)(wsb + WS_HIN); bf16_t* GB = (bf16_t*)(wsb + WS_GBUF);
    const int m = lane & 15, kq = lane >> 4;
    f32x4 acc[NT];
#pragma unroll
    for (int n = 0; n < NT; ++n) acc[n] = (f32x4){0.f, 0.f, 0.f, 0.f};
    const int chunk = ct * 16 + m;
    for (int dir = 0; dir < 2; ++dir) {
        const int dg = dir * 16 + g;
        const bf16_t* KI = (const bf16_t*)(wsb + WS_S5M + (size_t)dg * 256 * KiB) + (size_t)n0 * 16 * 256; const bf16_t* CC = (const bf16_t*)(wsb + WS_S5M + (size_t)dg * 256 * KiB) + 65536 + 32768 + (size_t)n0 * 16 * 128;
#pragma unroll 2
        for (int ks = 0; ks < 8; ++ks) { const int k0 = ks * 32 + 8 * kq;
            const bf16x8 a = *(const bf16x8*)(U + (size_t)(chunk * 16 + (k0 >> 4)) * NIN + 768 + g * 16 + (k0 & 15));
#pragma unroll
            for (int n = 0; n < NT; ++n) { const bf16x8 b = *(const bf16x8*)(KI + (size_t)(n * 16 + m) * 256 + k0); acc[n] = __builtin_amdgcn_mfma_f32_16x16x32_bf16(a, b, acc[n], 0, 0, 0); } }
#pragma unroll 2
        for (int ks = 0; ks < 4; ++ks) { const int k0 = ks * 32 + 8 * kq;
            const float* hp = HIN + ((size_t)dg * NCH + chunk) * 128 + k0; const f32x4 h0 = *(const f32x4*)hp, h1 = *(const f32x4*)(hp + 4);
            u32x4 aw; aw.x = pk2(h0[0], h0[1]); aw.y = pk2(h0[2], h0[3]); aw.z = pk2(h1[0], h1[1]); aw.w = pk2(h1[2], h1[3]);
            const bf16x8 a = __builtin_bit_cast(bf16x8, aw);
#pragma unroll
            for (int n = 0; n < NT; ++n) { const bf16x8 b = *(const bf16x8*)(CC + (size_t)(n * 16 + m) * 128 + k0); acc[n] = __builtin_amdgcn_mfma_f32_16x16x32_bf16(a, b, acc[n], 0, 0, 0); } }
    }
#pragma unroll
    for (int n = 0; n < NT; ++n)
#pragma unroll
        for (int i = 0; i < 4; ++i) { const int row = (ct * 16 + 4 * kq + i) * 16 + n0 + n; GB[(size_t)row * 256 + g * 16 + m] = (bf16_t)f2bf(gelu_tanh(acc[n][i])); }
}
__device__ __forceinline__ void pd_s5out(const int wave_s_, const P& p, int l) { unsigned char* const wsb = lndp(p.ws); const int tidx_ = tid_of(wave_s_); const int bidx_ = lnds((int)blockIdx.x);
    const int lane = tidx_ & 63, wave = tidx_ >> 6, gw = bidx_ * 8 + wave, NGW = gridDim.x * 8;
    for (int it = gw; it < 16 * 64 * 2; it += NGW) s5out_item<8>(wsb, it >> 7, 1 + ((it >> 1) & 63), (it & 1) * 8, lane);
    if (wave == 0 && l + 1 < NLAYER) for (int it = bidx_; it < 16 * 16; it += gridDim.x) s5out_item<1>(wsb, it >> 4, 0, it & 15, lane);
}
__device__ __forceinline__ void pd_hytrans(const int wave_s_, const P& p, LAS unsigned char* lds) { unsigned char* const wsb = lndp(p.ws); const int tidx_ = tid_of(wave_s_); const int bidx_ = lnds((int)blockIdx.x);
    const int tid = tidx_;
    const bf16_t* Z2T = (const bf16_t*)(wsb + WS_Z2T); bf16_t* MG = (bf16_t*)(wsb + WS_MERGED);
    LAS bf16_t* tile = (LAS bf16_t*)lds;
    for (int item = bidx_; item < 256 * 4; item += gridDim.x) {
        const int c0 = (item & 3) * 64, t0 = (item >> 2) * 64;
        __syncthreads();
        { const int c = tid >> 3, t8 = (tid & 7) * 8; const u32x4 w = *(const u32x4*)(Z2T + (size_t)(c0 + c) * LSEQ + t0 + t8);
          LAS unsigned* d = (LAS unsigned*)(tile + c * 66 + t8); d[0] = w.x; d[1] = w.y; d[2] = w.z; d[3] = w.w; }
        __syncthreads();
        { const int t = tid >> 3, c8 = (tid & 7) * 8; unsigned short e[8];
#pragma unroll
          for (int i = 0; i < 8; ++i) e[i] = tile[(c8 + i) * 66 + t];
          u32x4 w; w.x = e[0] | ((unsigned)e[1] << 16); w.y = e[2] | ((unsigned)e[3] << 16); w.z = e[4] | ((unsigned)e[5] << 16); w.w = e[6] | ((unsigned)e[7] << 16);
          *(u32x4*)(MG + (size_t)(LCTX + t0 + t) * 1024 + c0 + c8) = w; }
    }
    __syncthreads();
}
__device__ __forceinline__ void pd2_glu(const int wave_s_, const P& p, int l) { unsigned char* const wsb = lndp(p.ws); const int tidx_ = tid_of(wave_s_); const int bidx_ = lnds((int)blockIdx.x);
    const int lane = tidx_ & 63, wave = tidx_ >> 6, gw = bidx_ * 8 + wave, NGW = gridDim.x * 8, r32 = lane & 31, hi = lane >> 5;
    const bf16_t* GB = (const bf16_t*)(wsb + WS_GBUF); const bf16_t* GLUT = (const bf16_t*)(wsb + WS_GLUT); bf16_t* MG = (bf16_t*)(wsb + WS_MERGED);
    const float* gb = PIN(30) + l * 256;
    if (l + 1 < NLAYER) ctx_gemm16<2>(GB, 256, GLUT, 256, 256, MG + 256, 1024, nullptr, GB, gb, (wave == 1 ? bidx_ : 1 << 30), gridDim.x, lane);
    for (int it = gw; it < 512 * 8; it += NGW) {
        const int rt = 8 + (it >> 3), ct = it & 7;
        f32x16 acc;
#pragma unroll
        for (int i = 0; i < 16; ++i) acc[i] = 0.f;
#pragma unroll 8
        for (int ks = 0; ks < 16; ++ks) { const int k0 = ks * 16 + 8 * hi;
            const bf16x8 a = *(const bf16x8*)(GB + (size_t)(rt * 32 + r32) * 256 + k0); const bf16x8 b = *(const bf16x8*)(GLUT + (size_t)(ct * 32 + r32) * 256 + k0);
            acc = __builtin_amdgcn_mfma_f32_32x32x16_bf16(a, b, acc, 0, 0, 0); }
        const int col = ct * 32 + r32; const float bias = gb[col];
#pragma unroll
        for (int i = 0; i < 16; ++i) { const int row = rt * 32 + (i & 3) + 8 * (i >> 2) + 4 * hi; const float gv = bf1(GB[(size_t)row * 256 + col]);
            const float sg = 1.0f / (1.0f + expf(-(acc[i] + bias))); MG[(size_t)row * 1024 + 256 + col] = (bf16_t)f2bf(gv * sg); }
    }
}

#define XB_TMO      128
#define XB_XCNT(j)  (256  + 64 * (j))
#define XB_XSUB(j)  (1280 + 64 * (j))
#define XB_XGEN(j)  (2304 + 64 * (j))
#define XB_TOP      3328
#define XB_TOPGEN   3392
#define XCD_BAR_WORDS 3456
#define XB_SPIN_CAP (1u << 18)

__device__ __forceinline__ unsigned xb_ld(unsigned* p)              { return __hip_atomic_load(p, __ATOMIC_RELAXED, __HIP_MEMORY_SCOPE_AGENT); }
__device__ __forceinline__ unsigned xb_add(unsigned* p, unsigned v) { return __hip_atomic_fetch_add(p, v, __ATOMIC_RELAXED, __HIP_MEMORY_SCOPE_AGENT); }
__device__ __forceinline__ unsigned xb_xcc_id() { return (unsigned)__builtin_amdgcn_s_getreg((3 << 11) | 20) & 0xFu; }
#define XB_SPIN(cond, bar) do { unsigned _sp = 0; while (cond) { __builtin_amdgcn_s_sleep(1); \
    if ((++_sp & 255u) == 0u) { if (xb_ld(&(bar)[XB_TMO])) break; if (_sp > XB_SPIN_CAP) { atomicAdd(&(bar)[XB_TMO], 1u); break; } } } } while (0)

struct XcdBarrier {
    unsigned* bar; unsigned x;
    volatile LAS unsigned* st;
};

__device__ __forceinline__ XcdBarrier xcd_barrier_post(unsigned* bar, volatile LAS unsigned* st, int tid) {
    XcdBarrier b; b.bar = bar; b.x = xb_xcc_id(); b.st = st;
    if (tid == 0) (void)xb_add(&bar[XB_XCNT(b.x)], 1u);
    return b;
}
__device__ __forceinline__ void xcd_barrier_complete(unsigned* bar, unsigned x, unsigned& nloc, unsigned& nx) {
    const unsigned G = gridDim.x * gridDim.y * gridDim.z;
    unsigned sum, cnt, mine, sp = 0u;
    for (;;) {
        sum = 0u; cnt = 0u; mine = 0u;
#pragma unroll
        for (unsigned j = 0; j < 16; ++j) { const unsigned c = xb_ld(&bar[XB_XCNT(j)]); sum += c; cnt += (c > 0u) ? 1u : 0u; mine = (j == x) ? c : mine; }
        if (sum == G) break;
        __builtin_amdgcn_s_sleep(1);
        if ((++sp & 255u) == 0u) { if (xb_ld(&bar[XB_TMO])) break; if (sp > XB_SPIN_CAP) { atomicAdd(&bar[XB_TMO], 1u); break; } }
    }
    nloc = mine > 0u ? mine : 1u; nx = cnt > 0u ? cnt : 1u;
}

__device__ __forceinline__ void xcd_barrier(const XcdBarrier& b, int tid) {
    asm volatile("s_waitcnt vmcnt(0)" ::: "memory");
    __syncthreads();
    if (tid == 0) {
        unsigned* bar = b.bar;
        __builtin_amdgcn_s_waitcnt(0);
        unsigned nloc = b.st[0], nx = b.st[1];
        if (nloc == 0u) { xcd_barrier_complete(bar, b.x, nloc, nx); b.st[0] = nloc; b.st[1] = nx; }
        const unsigned old = xb_add(&bar[XB_XSUB(b.x)], 1u);
        const unsigned gen = old / nloc;
        if (old + 1u == (gen + 1u) * nloc) {
            __builtin_amdgcn_fence(__ATOMIC_RELEASE, "agent");
            asm volatile("s_waitcnt vmcnt(0)" ::: "memory");
            const unsigned og = xb_add(&bar[XB_TOP], 1u);
            const unsigned tg = og / nx;
            if (og + 1u == (tg + 1u) * nx) xb_add(&bar[XB_TOPGEN], 1u);
            else XB_SPIN(xb_ld(&bar[XB_TOPGEN]) == tg, bar);
            __builtin_amdgcn_fence(__ATOMIC_ACQUIRE, "agent");
            xb_add(&bar[XB_XGEN(b.x)], 1u);
            asm volatile("s_waitcnt vmcnt(0)" ::: "memory");
        } else {
            XB_SPIN(xb_ld(&bar[XB_XGEN(b.x)]) == gen, bar);
            __builtin_amdgcn_fence(__ATOMIC_ACQUIRE, "agent");
            asm volatile("s_waitcnt vmcnt(0)" ::: "memory");
        }
    }
    __syncthreads();
}

__device__ __forceinline__ void grid_bar(unsigned* ctr, unsigned target, int tid) {
    asm volatile("s_waitcnt vmcnt(0) lgkmcnt(0)" ::: "memory");
    __syncthreads();
    if (tid == 0) {
        __builtin_amdgcn_fence(__ATOMIC_RELEASE, "agent");
        asm volatile("s_waitcnt vmcnt(0)" ::: "memory");
        __hip_atomic_fetch_add(ctr, 1u, __ATOMIC_RELAXED, __HIP_MEMORY_SCOPE_AGENT);
        while (__hip_atomic_load(ctr, __ATOMIC_RELAXED, __HIP_MEMORY_SCOPE_AGENT) < target) __builtin_amdgcn_s_sleep(2);
        __builtin_amdgcn_fence(__ATOMIC_ACQUIRE, "agent");
        asm volatile("s_waitcnt vmcnt(0)" ::: "memory");
    }
    __syncthreads();
}
#define PH_BEGIN if (ph >= lo && ph < hi) { unsigned char* const wsb = lndp(p.ws); const int tidx_ = tid_of(wave_s_); const int bidx_ = lnds((int)blockIdx.x); (void)tidx_; (void)bidx_;
#define PH_END   if (ph + 1 < hi) { xcd_barrier(xb, tid_of(wave_s_)); } } ++ph;
#define PH_END0  if (ph + 1 < hi) grid.sync(); } ++ph;
template <int l> __device__ __forceinline__ void layer_phases(const int wave_s_, const P& p, LAS unsigned char* lds, char* ldsg, const int lo, const int hi, int& ph, const XcdBarrier& xb) {

        PH_BEGIN
            { float* ss1 = (float*)(wsb + WS_SS1); float* ss2 = (float*)(wsb + WS_SS2); const int t0_ = tid_of(wave_s_);
              for (int i = bidx_ * 512 + t0_; i < R; i += gridDim.x * 512) { ss1[i] = 0.f; ss2[i] = 0.f; } }
            { pg8::Gemm g{(const pg8::bf16_t*)(wsb + WS_H), (const pg8::bf16_t*)(wsb + WS_WIN), R, NIN, DM, tidx_}; pg8::StaticOrder S; S.init(R, NIN, gridDim.x, bidx_);
              pg8::EpiBf16<0> E{(pg8::bf16_t*)(wsb + WS_U), NIN};
              pg8::gemm_phase<pg8::EpiBf16<0>, pg8::StaticOrder, true, true>(lds, g, S, E); }
            __syncthreads();
            { pg8::Gemm g{(const pg8::bf16_t*)(wsb + WS_H2L), (const pg8::bf16_t*)(wsb + WS_W3T), LSEQ, 1024, 128, tid_of(wave_s_)}; pg8::StaticOrder S; S.init(LSEQ, 1024, gridDim.x, bidx_);
              pg8::EpiFilt E{(float*)(wsb + WS_FILT), PIN(19) + l * 1024};
              pg8::gemm_phase<pg8::EpiFilt, pg8::StaticOrder, false, false>(lds, g, S, E); }
            __syncthreads();
            pa_ctxtaps(wave_s_, p, l);
        PH_END
        PH_BEGIN
            pb_attprep(wave_s_, p, l); pb_s5local(wave_s_, p); pb_pool(wave_s_, p, l, lds); pb_shortconv(wave_s_, p, l, lds); pb_ctxhyena(wave_s_, p, l, lds);
        PH_END
        PH_BEGIN
            pc_s5carry(wave_s_, p, lds); pc_attention(wave_s_, p, l, ldsg); pc_hyena(wave_s_, p, l, lds);
        PH_END
        PH_BEGIN
            pd_s5out(wave_s_, p, l); pd_hytrans(wave_s_, p, lds);
        PH_END
        PH_BEGIN
            pd2_glu(wave_s_, p, l);
        PH_END
        PH_BEGIN
            { pg8::Gemm g{(const pg8::bf16_t*)(wsb + WS_MERGED) + (size_t)LCTX * DM, (const pg8::bf16_t*)(wsb + WS_WOUT), LSEQ, DM, DM, tidx_}; pg8::StaticOrder S; S.init(LSEQ, DM, gridDim.x, bidx_);
              pg8::EpiSumsq E{(pg8::bf16_t*)(wsb + WS_OL) + (size_t)LCTX * DM, DM, (float*)(wsb + WS_SS1) + LCTX};
              pg8::gemm_phase<pg8::EpiSumsq, pg8::StaticOrder, true, true>(lds, g, S, E); }
            __syncthreads();
            if (l + 1 < NLAYER) { const int t2_ = tid_of(wave_s_); unsigned char* const ws2 = lndp(p.ws);
              ctx_gemm16<0>((const bf16_t*)(ws2 + WS_MERGED), DM, (const bf16_t*)(ws2 + WS_WOUT), DM, DM, (bf16_t*)(ws2 + WS_OL), DM, (float*)(ws2 + WS_SS1), nullptr, nullptr, bidx_ * 8 + (t2_ >> 6), gridDim.x * 8, t2_ & 63); }
        PH_END
        PH_BEGIN
            ew_phase(wave_s_, p, 1, l);
        PH_END
        PH_BEGIN
            { pg8::Gemm g{(const pg8::bf16_t*)(wsb + WS_H) + (size_t)LCTX * DM, (const pg8::bf16_t*)(wsb + WS_W1), LSEQ, FF, DM, tidx_}; pg8::StaticOrder S; S.init(LSEQ, FF, gridDim.x, bidx_);
              pg8::EpiBf16<1> E{(pg8::bf16_t*)(wsb + WS_HID) + (size_t)LCTX * FF, FF};
              pg8::gemm_phase<pg8::EpiBf16<1>, pg8::StaticOrder, true, true>(lds, g, S, E); }
            __syncthreads();
            if (l + 1 < NLAYER) { const int t2_ = tid_of(wave_s_); unsigned char* const ws2 = lndp(p.ws);
              ctx_gemm16<1>((const bf16_t*)(ws2 + WS_H), DM, (const bf16_t*)(ws2 + WS_W1), FF, DM, (bf16_t*)(ws2 + WS_HID), FF, nullptr, nullptr, nullptr, bidx_ * 8 + (t2_ >> 6), gridDim.x * 8, t2_ & 63); }
        PH_END
        PH_BEGIN
            { pg8::Gemm g{(const pg8::bf16_t*)(wsb + WS_HID) + (size_t)LCTX * FF, (const pg8::bf16_t*)(wsb + WS_W2), LSEQ, DM, FF, tidx_}; pg8::StaticOrder S; S.init(LSEQ, DM, gridDim.x, bidx_);
              pg8::EpiSumsq E{(pg8::bf16_t*)(wsb + WS_OL) + (size_t)LCTX * DM, DM, (float*)(wsb + WS_SS2) + LCTX};
              pg8::gemm_phase<pg8::EpiSumsq, pg8::StaticOrder, true, true>(lds, g, S, E); }
            __syncthreads();
            if (l + 1 < NLAYER) { const int t2_ = tid_of(wave_s_); unsigned char* const ws2 = lndp(p.ws);
              ctx_gemm16<0>((const bf16_t*)(ws2 + WS_HID), FF, (const bf16_t*)(ws2 + WS_W2), DM, FF, (bf16_t*)(ws2 + WS_OL), DM, (float*)(ws2 + WS_SS2), nullptr, nullptr, bidx_ * 8 + (t2_ >> 6), gridDim.x * 8, t2_ & 63); }
        PH_END
        PH_BEGIN
            ew_phase(wave_s_, p, 2, l);
            if (l + 1 < NLAYER) prep_layer(wave_s_, p, l + 1, lds);
        PH_END
    }
__global__ void __launch_bounds__(512) mega_fwd(P p) {
    extern __shared__ __attribute__((aligned(16))) unsigned char lds_raw[];
    LAS unsigned char* lds = (LAS unsigned char*)lds_raw;
    cg::grid_group grid = cg::this_grid();
    const int wave_s_ = __builtin_amdgcn_readfirstlane((int)threadIdx.x >> 6);
    const int lo = p.lo, hi = p.hi;
    int ph = 0;
    { volatile LAS unsigned* st0 = (volatile LAS unsigned*)(lds + XB_LDS_OFF); if (threadIdx.x < 2) st0[threadIdx.x] = 0u; }
    __syncthreads();
    const XcdBarrier xb = xcd_barrier_post((unsigned*)(p.ws + WS_BAR), (volatile LAS unsigned*)(lds + XB_LDS_OFF), (int)threadIdx.x);
    PH_BEGIN
        pro_mod(wave_s_, p, lds); pro_tables(wave_s_, p); prep_layer(wave_s_, p, 0, lds);
    PH_END0
    PH_BEGIN
        ew_phase(wave_s_, p, 0, 0);
    PH_END
    layer_phases<0>(wave_s_, p, lds, (char*)lds_raw, lo, hi, ph, xb);
    layer_phases<1>(wave_s_, p, lds, (char*)lds_raw, lo, hi, ph, xb);
    layer_phases<2>(wave_s_, p, lds, (char*)lds_raw, lo, hi, ph, xb);
    layer_phases<3>(wave_s_, p, lds, (char*)lds_raw, lo, hi, ph, xb);
#undef PH_BEGIN
#undef PH_END
#undef PH_END0
}
constexpr int N_PHASES = 2 + NLAYER * 10;

#ifndef MK_MULTI
#define MK_MULTI 0
#endif
extern "C" void kernel_launch(void* const* d_in, const int* in_sizes, int n_in, void* d_out, int out_size, void* d_ws, size_t ws_size, hipStream_t stream) {
    static int grid = 0;
    if (grid == 0) {
        if (n_in != 37 || out_size != LSEQ * DM || ws_size < WS_END) { fprintf(stderr, "kernel_launch: unexpected shapes (n_in %d out %d ws %zu)\n", n_in, out_size, ws_size); grid = -1; return; }
        int dev = 0, cus = 0, per_cu = 0;
        (void)hipGetDevice(&dev); (void)hipDeviceGetAttribute(&cus, hipDeviceAttributeMultiprocessorCount, dev);
        if (hipFuncSetAttribute((const void*)mega_fwd, hipFuncAttributeMaxDynamicSharedMemorySize, LDS_BYTES) != hipSuccess) { fprintf(stderr, "kernel_launch: hipFuncSetAttribute failed\n"); grid = -1; return; }
        if (hipOccupancyMaxActiveBlocksPerMultiprocessor(&per_cu, (const void*)mega_fwd, 512, LDS_BYTES) != hipSuccess || per_cu < 1) { fprintf(stderr, "kernel_launch: occupancy query gave %d\n", per_cu); per_cu = 1; }
        (void)hipGetLastError();
        grid = cus * 1;
        if (grid <= 0) grid = 256;
    }
    if (grid < 0) return;
    (void)hipMemsetAsync((unsigned char*)d_ws + WS_BAR, 0, 16384, stream);
    P a{};
    for (int i = 0; i < 37; ++i) a.in[i] = (const float*)d_in[i];
    a.out = (float*)d_out; a.ws = (unsigned char*)d_ws;
#if MK_MULTI
    for (int ph = 0; ph < N_PHASES; ++ph) { a.lo = ph; a.hi = ph + 1; hipLaunchKernelGGL(mega_fwd, dim3(grid), dim3(512), LDS_BYTES, stream, a); }
#else
    a.lo = 0; a.hi = N_PHASES;
    void* args[] = {&a};
    hipError_t e = hipLaunchCooperativeKernel((const void*)mega_fwd, dim3(grid), dim3(512), args, LDS_BYTES, stream);
    if (e != hipSuccess) fprintf(stderr, "cooperative launch failed: %s (grid %d)\n", hipGetErrorString(e), grid);
#endif
}
```
